# Optimizing an MI355X kernel written in HIP

```python
import jax, jax.numpy as jnp
from jax import lax
import numpy as np

D_MODEL = 1024
BATCH = 8
SEQ = 4096
DEPTH = 2

W_A = 512
A_GROUPS = 8
A_CONV = 3
W_B = 1024
LRU_HEADS = 8
LRU_HEAD_DIM = W_B // LRU_HEADS
B_CONV = 4
LRU_C = 8.0
W_C = 512
POOL_WINDOWS = (2, 4, 8, 16)
POOL_GROUPS = len(POOL_WINDOWS)
POOL_GROUP_DIM = W_C // POOL_GROUPS
N_BRANCH = 3
SPLITS = [W_A, 2 * W_A, 3 * W_A, 3 * W_A + W_B, 3 * W_A + 2 * W_B,
          3 * W_A + 2 * W_B + W_C, 3 * W_A + 2 * W_B + W_C + D_MODEL,
          3 * W_A + 2 * W_B + W_C + 2 * D_MODEL]
IN_COLS = 3 * W_A + 2 * W_B + W_C + N_BRANCH * D_MODEL
N_GROUPS = 4
EXPERTS_PER_GROUP = 4
N_EXPERTS = N_GROUPS * EXPERTS_PER_GROUP
TOP_K = 2
D_EXPERT = 512
EPS = 1e-6

kernel_name = "hybrid_conv_lru_pool_hmoe"


def rmsnorm(x, g):
    xf = x.astype(jnp.float32)
    y = xf * lax.rsqrt(jnp.mean(xf * xf, axis=-1, keepdims=True) + EPS)
    return (y * g.astype(jnp.float32)).astype(x.dtype)


def causal_dwconv(x, w):
    k, c = w.shape
    return lax.conv_general_dilated(
        x, w[:, None, :].astype(x.dtype), window_strides=(1,), padding=[(k - 1, 0)],
        dimension_numbers=("NWC", "WIO", "NWC"), feature_group_count=c)


def rg_lru(x, w_a, b_a, w_x, b_x, lam):
    bsz, s, w = x.shape
    xh = x.reshape(bsz, s, LRU_HEADS, LRU_HEAD_DIM)
    r = jax.nn.sigmoid(jnp.einsum("bshi,hij->bshj", xh, w_a) + b_a).reshape(bsz, s, w)
    i = jax.nn.sigmoid(jnp.einsum("bshi,hij->bshj", xh, w_x) + b_x).reshape(bsz, s, w)
    log_a = -LRU_C * r.astype(jnp.float32) * jax.nn.softplus(-lam.astype(jnp.float32))
    a = jnp.exp(log_a)
    b = jnp.sqrt(-jnp.expm1(2.0 * log_a)) * (i * x).astype(jnp.float32)

    def combine(left, right):
        a_l, b_l = left
        a_r, b_r = right
        return a_r * a_l, a_r * b_l + b_r

    _, h = lax.associative_scan(combine, (a, b), axis=1)
    return h.astype(x.dtype)


def multiscale_pool(u):
    s = u.shape[1]
    cs = jnp.cumsum(u.astype(jnp.float32), axis=1)
    t = jnp.arange(1, s + 1, dtype=jnp.float32)
    outs = []
    for g, w in enumerate(POOL_WINDOWS):
        c = cs[..., g * POOL_GROUP_DIM:(g + 1) * POOL_GROUP_DIM]
        lag = jnp.pad(c, ((0, 0), (w, 0), (0, 0)))[:, :s]
        cnt = jnp.minimum(t, float(w))[None, :, None]
        outs.append((c - lag) / cnt)
    pooled = jnp.concatenate(outs, axis=-1)
    return (pooled - u.astype(jnp.float32)).astype(u.dtype)


def mixer_sublayer(h, w_in, conv_a_w, w_a_out, conv_b_w, conv_b_b, lru_wa, lru_ba,
                   lru_wx, lru_bx, lru_lambda, w_b_out, pool_w, pool_scale, w_c_out, w_o):
    bsz, s, _ = h.shape
    z = h @ w_in
    a_b, a_c, a_x, b_x, b_y, c_u, g_a, g_b, g_c = jnp.split(z, SPLITS, axis=-1)
    y_a = a_b * causal_dwconv(a_c * a_x, conv_a_w)
    xb = causal_dwconv(b_x, conv_b_w) + conv_b_b
    y_b = rg_lru(xb, lru_wa, lru_ba, lru_wx, lru_bx, lru_lambda) * jax.nn.gelu(b_y)
    pc = multiscale_pool(c_u).reshape(bsz, s, POOL_GROUPS, POOL_GROUP_DIM)
    y_c = jnp.einsum("bsgi,gij->bsgj", pc, pool_w).reshape(bsz, s, W_C) * pool_scale
    m = (jax.nn.sigmoid(g_a) * (y_a @ w_a_out)
         + jax.nn.sigmoid(g_b) * (y_b @ w_b_out)
         + jax.nn.sigmoid(g_c) * (y_c @ w_c_out))
    return m @ w_o


def hier_moe(h, w_grp, b_grp, w_exp, b_exp, w1, w3, w2):
    bsz, s, d = h.shape
    t = h.reshape(-1, d)
    n_tok = t.shape[0]
    grp_prob = jax.nn.softmax((t @ w_grp + b_grp).astype(jnp.float32), axis=-1)
    g_p, g_idx = lax.top_k(grp_prob, 1)
    exp_logits = (t @ w_exp + b_exp).astype(jnp.float32).reshape(n_tok, N_GROUPS, EXPERTS_PER_GROUP)
    sel = jnp.take_along_axis(exp_logits, g_idx[:, :, None], axis=1)[:, 0]
    e_val, e_idx = lax.top_k(sel, TOP_K)
    e_w = jax.nn.softmax(e_val, axis=-1) * g_p
    within = jnp.sum(jax.nn.one_hot(e_idx, EXPERTS_PER_GROUP, dtype=jnp.float32) * e_w[..., None], axis=1)
    gate = (jax.nn.one_hot(g_idx[:, 0], N_GROUPS, dtype=jnp.float32)[:, :, None]
            * within[:, None, :]).reshape(n_tok, N_EXPERTS).astype(h.dtype)
    out = jnp.zeros_like(t)
    for e in range(N_EXPERTS):
        hid = jax.nn.silu(t @ w1[e]) * (t @ w3[e])
        out = out + gate[:, e:e + 1] * (hid @ w2[e])
    return out.reshape(bsz, s, d)


def setup_inputs(seed: int = 0) -> dict:
    key = jax.random.key(seed)
    ks = jax.random.split(key, 32)

    def nrm(k, shape, scale):
        return jax.random.normal(k, shape, jnp.float32) * scale

    L, D = DEPTH, D_MODEL
    u = jax.random.uniform(ks[12], (L, W_B), jnp.float32, minval=0.9, maxval=0.999)
    sig = u ** (1.0 / LRU_C)
    lam = jnp.log(sig) - jnp.log1p(-sig)
    return {
        "x": nrm(ks[0], (BATCH, SEQ, D), 1.0),
        "norm1_g": 1.0 + nrm(ks[1], (L, D), 0.02),
        "w_in": nrm(ks[2], (L, D, IN_COLS), D ** -0.5),
        "conv_a_w": nrm(ks[3], (L, A_CONV, W_A), A_CONV ** -0.5),
        "w_a_out": nrm(ks[4], (L, W_A, D), W_A ** -0.5),
        "conv_b_w": nrm(ks[5], (L, B_CONV, W_B), B_CONV ** -0.5),
        "conv_b_b": nrm(ks[6], (L, W_B), 0.01),
        "lru_wa": nrm(ks[7], (L, LRU_HEADS, LRU_HEAD_DIM, LRU_HEAD_DIM), LRU_HEAD_DIM ** -0.5),
        "lru_ba": nrm(ks[8], (L, LRU_HEADS, LRU_HEAD_DIM), 0.01),
        "lru_wx": nrm(ks[9], (L, LRU_HEADS, LRU_HEAD_DIM, LRU_HEAD_DIM), LRU_HEAD_DIM ** -0.5),
        "lru_bx": nrm(ks[10], (L, LRU_HEADS, LRU_HEAD_DIM), 0.01),
        "lru_lambda": lam,
        "w_b_out": nrm(ks[11], (L, W_B, D), W_B ** -0.5),
        "pool_w": nrm(ks[13], (L, POOL_GROUPS, POOL_GROUP_DIM, POOL_GROUP_DIM), POOL_GROUP_DIM ** -0.5),
        "pool_scale": 1.0 + nrm(ks[14], (L, W_C), 0.02),
        "w_c_out": nrm(ks[15], (L, W_C, D), W_C ** -0.5),
        "w_o": nrm(ks[16], (L, D, D), D ** -0.5),
        "norm2_g": 1.0 + nrm(ks[17], (L, D), 0.02),
        "router_grp_w": nrm(ks[18], (L, D, N_GROUPS), D ** -0.5),
        "router_grp_b": nrm(ks[19], (L, N_GROUPS), 0.01),
        "router_exp_w": nrm(ks[20], (L, D, N_EXPERTS), D ** -0.5),
        "router_exp_b": nrm(ks[21], (L, N_EXPERTS), 0.01),
        "moe_w1": nrm(ks[22], (L, N_EXPERTS, D, D_EXPERT), D ** -0.5),
        "moe_w3": nrm(ks[23], (L, N_EXPERTS, D, D_EXPERT), D ** -0.5),
        "moe_w2": nrm(ks[24], (L, N_EXPERTS, D_EXPERT, D), D_EXPERT ** -0.5),
        "final_g": 1.0 + nrm(ks[25], (D,), 0.02),
    }


def reference(x, norm1_g, w_in, conv_a_w, w_a_out, conv_b_w, conv_b_b, lru_wa, lru_ba,
              lru_wx, lru_bx, lru_lambda, w_b_out, pool_w, pool_scale, w_c_out, w_o,
              norm2_g, router_grp_w, router_grp_b, router_exp_w, router_exp_b,
              moe_w1, moe_w3, moe_w2, final_g):
    for l in range(DEPTH):
        h = rmsnorm(x, norm1_g[l])
        x = x + mixer_sublayer(h, w_in[l], conv_a_w[l], w_a_out[l], conv_b_w[l], conv_b_b[l],
                               lru_wa[l], lru_ba[l], lru_wx[l], lru_bx[l], lru_lambda[l],
                               w_b_out[l], pool_w[l], pool_scale[l], w_c_out[l], w_o[l])
        h = rmsnorm(x, norm2_g[l])
        x = x + hier_moe(h, router_grp_w[l], router_grp_b[l], router_exp_w[l], router_exp_b[l],
                         moe_w1[l], moe_w3[l], moe_w2[l])
    return rmsnorm(x, final_g)
```

```cpp
#include <hip/hip_runtime.h>
#include <stdint.h>
#include <stdio.h>

#ifndef ONE_LAUNCH
#define ONE_LAUNCH 1
#endif
#ifndef PH_MASK
#define PH_MASK 1023
#endif
#ifndef DUP_MASK
#define DUP_MASK 0
#endif
#define REP(bit) for (int rep_ = 0; rep_ < ((DUP_MASK & (bit)) ? 2 : 1); ++rep_)

#define LAS __attribute__((address_space(3)))
typedef unsigned short bf16;
typedef short bf16x8 __attribute__((ext_vector_type(8)));
typedef float f32x4 __attribute__((ext_vector_type(4)));
typedef float f32x2 __attribute__((ext_vector_type(2)));
typedef unsigned u32x4 __attribute__((ext_vector_type(4)));
typedef unsigned u32x2 __attribute__((ext_vector_type(2)));
typedef int i32x4 __attribute__((ext_vector_type(4)));
typedef int i32x8 __attribute__((ext_vector_type(8)));

constexpr int D = 1024, BATCH = 8, SEQ = 4096, T = BATCH * SEQ, DEPTH = 2;
constexpr int W_A = 512, W_B = 1024, W_C = 512, INC = 7168;
constexpr int C_AB = 0, C_AC = 512, C_AX = 1024, C_BX = 1536, C_BY = 2560, C_CU = 3584, C_GA = 4096, C_GB = 5120, C_GC = 6144;
constexpr int TH = T / 2;
constexpr int NG = 4, EPG = 4, NE = 16, DE = 512, NCLS = 24, CAP = 32768;
constexpr float EPS = 1e-6f;
constexpr int NWAVES = 8, NTHR = 512;

constexpr size_t MiB = 1u << 20;
constexpr size_t WS_CTL = 0, CTL_BYTES = 1 * MiB;
constexpr size_t WS_WINT = 1 * MiB;
constexpr size_t WS_WCAT = WS_WINT + 14 * MiB;
constexpr size_t WS_WOT = WS_WCAT + 4 * MiB;
constexpr size_t WS_BAT = WS_WOT + 2 * MiB;
constexpr size_t WS_W2T = WS_BAT + 32 * MiB;
constexpr size_t WS_WAT = WS_W2T + 16 * MiB;
constexpr size_t WS_WXT = WS_WAT + 256 * 1024;
constexpr size_t WS_PLT = WS_WXT + 256 * 1024;
constexpr size_t WS_XB = 71 * MiB;
constexpr size_t WS_ZH = 135 * MiB;
constexpr size_t WS_YH = 359 * MiB;
constexpr size_t WS_MB = 423 * MiB;
constexpr size_t WS_CAR = 487 * MiB;
constexpr size_t WS_END = 504 * MiB;
constexpr size_t WS_WING8 = WS_WINT + (size_t)4096 * 1024 * 2;
constexpr size_t WS_XB8A = WS_BAT + 16 * MiB, WS_XB8B = 487 * MiB;
constexpr size_t WS_HID = WS_ZH;
constexpr size_t WS_RINFO = WS_ZH + 96 * MiB;
static_assert(WS_PLT + 128 * 1024 <= WS_XB, "weights fit");
constexpr int CW_BAR = 4096;
constexpr int CW_CNT = 16384;

constexpr int RING_BYTES = 131072, MISC_OFF = RING_BYTES, LDS_BYTES = 147456;
constexpr int MW_BAR = 8, MW_CNT = 16, MW_NPAN = 44, MW_PT = 48, MW_SCR = 256;

__device__ __forceinline__ float bf2f(bf16 v) { return __uint_as_float(((unsigned)v) << 16); }
__device__ __forceinline__ float bflo(unsigned w) { return __uint_as_float(w << 16); }
__device__ __forceinline__ float bfhi(unsigned w) { return __uint_as_float(w & 0xffff0000u); }
__device__ __forceinline__ bf16 f2bf(float f) { unsigned u = __float_as_uint(f); return (bf16)((u + 0x7fffu + ((u >> 16) & 1u)) >> 16); }
__device__ __forceinline__ unsigned cvt_pk_bf16(float lo, float hi) { unsigned r; asm volatile("v_cvt_pk_bf16_f32 %0, %1, %2" : "=v"(r) : "v"(lo), "v"(hi)); return r; }
__device__ __forceinline__ float dpp_mov(float v, int ctrl_sel) {
    int r; const int x = __builtin_bit_cast(int, v);
    switch (ctrl_sel) { case 0: r = __builtin_amdgcn_update_dpp(0, x, 0xB1, 0xf, 0xf, true); break;
                        case 1: r = __builtin_amdgcn_update_dpp(0, x, 0x4E, 0xf, 0xf, true); break;
                        case 2: r = __builtin_amdgcn_update_dpp(0, x, 0x141, 0xf, 0xf, true); break;
                        default: r = __builtin_amdgcn_update_dpp(0, x, 0x140, 0xf, 0xf, true); break; }
    return __builtin_bit_cast(float, r);
}
__device__ __forceinline__ float wave_sum(float v) {
    v += dpp_mov(v, 0); v += dpp_mov(v, 1); v += dpp_mov(v, 2); v += dpp_mov(v, 3);
    const int x = __builtin_bit_cast(int, v);
    return (__builtin_bit_cast(float, __builtin_amdgcn_readlane(x, 0)) + __builtin_bit_cast(float, __builtin_amdgcn_readlane(x, 16)))
         + (__builtin_bit_cast(float, __builtin_amdgcn_readlane(x, 32)) + __builtin_bit_cast(float, __builtin_amdgcn_readlane(x, 48)));
}
__device__ __forceinline__ float fexp(float x) { return __builtin_amdgcn_exp2f(x * 1.4426950408889634f); }
__device__ __forceinline__ float frcp(float x) { return __builtin_amdgcn_rcpf(x); }
__device__ __forceinline__ float sigmoidf_(float x) { return 1.0f / (1.0f + __expf(-x)); }
__device__ __forceinline__ float fsig(float x) { return frcp(1.0f + __builtin_amdgcn_exp2f(x * -1.4426950408889634f)); }
__device__ __forceinline__ float gelu_tanh(float x) { const float u = 0.7978845608028654f * (x + 0.044715f * x * x * x); return 0.5f * x * (1.0f + tanhf(u)); }
__device__ __forceinline__ float fgelu(float x) { const float u = 1.5957691216057308f * (x + 0.044715f * x * x * x); return x * fsig(u); }
#define LDS_WAIT() asm volatile("s_waitcnt lgkmcnt(0)" ::: "memory")
#define VM_WAIT() asm volatile("s_waitcnt vmcnt(0)" ::: "memory")

#define XB_TMO      128
#define XB_XCNT(j)  (256  + 64 * (j))
#define XB_XSUB(j)  (1280 + 64 * (j))
#define XB_XGEN(j)  (2304 + 64 * (j))
#define XB_TOP      3328
#define XB_TOPGEN   3392
#define XCD_BAR_WORDS 3456
#define XB_SPIN_CAP (1u << 20)
__device__ __forceinline__ unsigned xb_ld(unsigned* p)              { return __hip_atomic_load(p, __ATOMIC_RELAXED, __HIP_MEMORY_SCOPE_AGENT); }
__device__ __forceinline__ unsigned xb_add(unsigned* p, unsigned v) { return __hip_atomic_fetch_add(p, v, __ATOMIC_RELAXED, __HIP_MEMORY_SCOPE_AGENT); }
__device__ __forceinline__ unsigned xb_xcc_id() { return (unsigned)__builtin_amdgcn_s_getreg((3 << 11) | 20) & 0xFu; }
#define XB_SPIN(cond, bar) do { unsigned _sp = 0; while (cond) { __builtin_amdgcn_s_sleep(1); \
    if ((++_sp & 255u) == 0u) { if (xb_ld(&(bar)[XB_TMO])) break; if (_sp > XB_SPIN_CAP) { atomicAdd(&(bar)[XB_TMO], 1u); break; } } } } while (0)
struct XcdBarrier { unsigned* bar; unsigned x; volatile LAS unsigned* st; };
__device__ __forceinline__ XcdBarrier xcd_barrier_post(unsigned* bar, volatile LAS unsigned* st, bool is0) {
    XcdBarrier b; b.bar = bar; b.x = xb_xcc_id(); b.st = st;
    if (is0) (void)xb_add(&bar[XB_XCNT(b.x)], 1u);
    return b;
}
__device__ __forceinline__ void xcd_barrier_complete(unsigned* bar, unsigned x, unsigned& nloc, unsigned& nx) {
    const unsigned G = gridDim.x * gridDim.y * gridDim.z;
    unsigned sum, cnt, mine, sp = 0u;
    for (;;) {
        sum = 0u; cnt = 0u; mine = 0u;
#pragma unroll
        for (unsigned j = 0; j < 16; ++j) { const unsigned c = xb_ld(&bar[XB_XCNT(j)]); sum += c; cnt += (c > 0u) ? 1u : 0u; mine = (j == x) ? c : mine; }
        if (sum == G) break;
        __builtin_amdgcn_s_sleep(1);
        if ((++sp & 255u) == 0u) { if (xb_ld(&bar[XB_TMO])) break; if (sp > XB_SPIN_CAP) { atomicAdd(&bar[XB_TMO], 1u); break; } }
    }
    nloc = mine > 0u ? mine : 1u; nx = cnt > 0u ? cnt : 1u;
}
__device__ __forceinline__ void xcd_barrier(const XcdBarrier& b, bool is0) {
    asm volatile("s_waitcnt vmcnt(0)" ::: "memory");
    __syncthreads();
    if (is0) {
        unsigned* bar = b.bar;
        __builtin_amdgcn_s_waitcnt(0);
        unsigned nloc = b.st[0], nx = b.st[1];
        if (nloc == 0u) { xcd_barrier_complete(bar, b.x, nloc, nx); b.st[0] = nloc; b.st[1] = nx; }
        const unsigned old = xb_add(&bar[XB_XSUB(b.x)], 1u);
        const unsigned gen = old / nloc;
        if (old + 1u == (gen + 1u) * nloc) {
            __builtin_amdgcn_fence(__ATOMIC_RELEASE, "agent");
            asm volatile("s_waitcnt vmcnt(0)" ::: "memory");
            const unsigned og = xb_add(&bar[XB_TOP], 1u);
            const unsigned tg = og / nx;
            if (og + 1u == (tg + 1u) * nx) xb_add(&bar[XB_TOPGEN], 1u);
            else XB_SPIN(xb_ld(&bar[XB_TOPGEN]) == tg, bar);
            __builtin_amdgcn_fence(__ATOMIC_ACQUIRE, "agent");
            xb_add(&bar[XB_XGEN(b.x)], 1u);
            asm volatile("s_waitcnt vmcnt(0)" ::: "memory");
        } else {
            XB_SPIN(xb_ld(&bar[XB_XGEN(b.x)]) == gen, bar);
            __builtin_amdgcn_fence(__ATOMIC_ACQUIRE, "agent");
            asm volatile("s_waitcnt vmcnt(0)" ::: "memory");
        }
    }
    __syncthreads();
}

namespace pg8 {
constexpr int BM = 256, BK = 64, HALF = 128, HTB = HALF * BK * 2, STAGE_BYTES = 8 * HTB, NXCD = 8, WGM = 8;
__host__ __device__ __forceinline__ int lds_byte(int r, int c) { const int st = (r >> 4) * 2 + (c >> 5), rr = r & 15, cc = c & 31, ob = rr * 64 + cc * 2; return st * 1024 + (ob ^ (((ob >> 9) & 1) << 5)); }
__host__ __device__ __forceinline__ void stage_rc(int b, int& R, int& C) { const int st = b / 1024, sb = b % 1024, swz = sb ^ (((sb >> 9) & 1) << 5); R = (st >> 1) * 16 + swz / 64; C = (st & 1) * 32 + (swz % 64) / 2; }
__host__ __device__ __forceinline__ int perm32(int rho) { const int n = rho >> 4, i = rho & 15; return 8 * (i >> 2) + 4 * n + (i & 3); }
struct Unit { int pm, pn, rep; };
struct StaticOrder {
    int nM, nN, nwg, G, c, dupf;
    __host__ __device__ void init(int M, int N, int G_, int c_, int dupf_ = 1) { nM = M / BM; nN = N / BM; nwg = nM * nN; G = G_; c = c_; dupf = dupf_; }
    __host__ __device__ bool next(int i, Unit& u) const {
        const long L0 = (long)i * G + c; if (L0 >= (long)nwg * dupf) return false; const long L = L0 % nwg; u.rep = (int)(L0 / nwg);
        int wgid = (int)L; { const int q = nwg / NXCD, r = nwg % NXCD, xcd = wgid % NXCD, off = wgid / NXCD; wgid = (xcd < r ? xcd * (q + 1) : r * (q + 1) + (xcd - r) * q) + off; }
        const int nig = WGM * nN, gid = wgid / nig, fm = gid * WGM, gsz = (nM - fm) < WGM ? (nM - fm) : WGM;
        u.pm = fm + ((wgid % nig) % gsz); u.pn = (wgid % nig) / gsz; return true;
    }
};
template <class P>
__device__ __forceinline__ void gemm_phase(LAS unsigned char* lds, const P& p, const int tid) {
    const int wid = __builtin_amdgcn_readfirstlane(tid >> 6), lane = tid & 63, wr = wid >> 2, wc = wid & 3, fr = lane & 15, fq = lane >> 4;
    constexpr int nt = P::NT, lda = P::LDA, ldb = P::LDB;
    unsigned voffA[2], voffB[2]; int Rr[2], Cc[2];
#pragma unroll
    for (int i = 0; i < 2; ++i) { int R, C; stage_rc(tid * 16 + i * 8192, R, C); const int Rb = P::PERM ? ((R & ~31) + perm32(R & 31)) : R;
        voffA[i] = (unsigned)(R * lda + C) * 2u; voffB[i] = (unsigned)(Rb * ldb + C) * 2u; Rr[i] = R; Cc[i] = C; }
    constexpr size_t kstep = (size_t)(BK * 2), hstepA = (size_t)HALF * lda * 2, hstepB = (size_t)HALF * ldb * 2;
    const unsigned ldsw = (unsigned)wid * 1024u;
    const int aoff = lds_byte(wr * 64 + fr, fq * 8), boff = lds_byte(wc * 32 + fr, fq * 8);
#define PG8_SA(b, h) (((b) * 2 + (h)) * HTB)
#define PG8_SB(b, h) ((4 + (b) * 2 + (h)) * HTB)
#define PG8_GL(gp, off) __builtin_amdgcn_global_load_lds((const unsigned*)(gp), (LAS unsigned*)(lds + (off)), 16, 0, 0)
#define PG8_STAGE_B(bufoff, base, h) do { PG8_GL((base) + (h) * hstepB + voffB[0], (bufoff) + ldsw); PG8_GL((base) + (h) * hstepB + voffB[1], (bufoff) + ldsw + 8192); } while (0)
#define PG8_STAGE_A(bufoff, base, h, ro) do { if constexpr (P::GATHER) { PG8_GL((base) + ro[h][0], (bufoff) + ldsw); PG8_GL((base) + ro[h][1], (bufoff) + ldsw + 8192); } \
        else { PG8_GL((base) + (h) * hstepA + voffA[0], (bufoff) + ldsw); PG8_GL((base) + (h) * hstepA + voffA[1], (bufoff) + ldsw + 8192); } } while (0)
#define PG8_LDA(dst, b, h) do { if constexpr (P::F8) { _Pragma("unroll") for (int m = 0; m < 4; ++m) { const i32x4 lo_ = *(const LAS i32x4*)(lds + PG8_SA(b, h) + aoff + m * 2048), hi_ = *(const LAS i32x4*)(lds + PG8_SA(b, h) + aoff + m * 2048 + 1024); \
            dst##8[m] = __builtin_shufflevector(lo_, hi_, 0, 1, 2, 3, 4, 5, 6, 7); } } \
        else { _Pragma("unroll") for (int m = 0; m < 4; ++m) _Pragma("unroll") for (int k = 0; k < 2; ++k) dst[m][k] = *(const LAS bf16x8*)(lds + PG8_SA(b, h) + aoff + m * 2048 + k * 1024); } } while (0)
#define PG8_LDB(dst, b, h) do { if constexpr (P::F8) { _Pragma("unroll") for (int n = 0; n < 2; ++n) { const i32x4 lo_ = *(const LAS i32x4*)(lds + PG8_SB(b, h) + boff + n * 2048), hi_ = *(const LAS i32x4*)(lds + PG8_SB(b, h) + boff + n * 2048 + 1024); \
            dst##8[n] = __builtin_shufflevector(lo_, hi_, 0, 1, 2, 3, 4, 5, 6, 7); } } \
        else { _Pragma("unroll") for (int n = 0; n < 2; ++n) _Pragma("unroll") for (int k = 0; k < 2; ++k) dst[n][k] = *(const LAS bf16x8*)(lds + PG8_SB(b, h) + boff + n * 2048 + k * 1024); } } while (0)
#define PG8_MMA(ai, bj, At, Bt) do { __builtin_amdgcn_s_setprio(1); \
        if constexpr (P::F8) { _Pragma("unroll") for (int m = 0; m < 4; ++m) _Pragma("unroll") for (int n = 0; n < 2; ++n) \
            acc[ai][bj][m][n] = __builtin_amdgcn_mfma_scale_f32_16x16x128_f8f6f4(Bt##8[n], At##8[m], acc[ai][bj][m][n], 0, 0, 0, P::SCALE_B, 0, P::SCALE_A); } \
        else { _Pragma("unroll") for (int m = 0; m < 4; ++m) _Pragma("unroll") for (int n = 0; n < 2; ++n) _Pragma("unroll") for (int k = 0; k < 2; ++k) \
            acc[ai][bj][m][n] = __builtin_amdgcn_mfma_f32_16x16x32_bf16(Bt[n][k], At[m][k], acc[ai][bj][m][n], 0, 0, 0); } \
        __builtin_amdgcn_s_setprio(0); } while (0)
#define PG8_WAIT_V(n) asm volatile("s_waitcnt vmcnt(" #n ")" ::: "memory")
#define PG8_WAIT_L(n) asm volatile("s_waitcnt lgkmcnt(" #n ")" ::: "memory")
#define PG8_BAR __builtin_amdgcn_s_barrier()
#define PG8_SCHED __builtin_amdgcn_sched_barrier(0)
    Unit cur, nxt; int ui = 0;
    if (!p.next(0, cur)) return;
    f32x4 acc[2][2][4][2];
#pragma unroll
    for (int a = 0; a < 2; ++a)
#pragma unroll
        for (int b = 0; b < 2; ++b)
#pragma unroll
            for (int m = 0; m < 4; ++m)
#pragma unroll
                for (int n = 0; n < 2; ++n) acc[a][b][m][n] = (f32x4){0.f, 0.f, 0.f, 0.f};
    bf16x8 At[4][2], B0[2][2], B1[2][2]; i32x8 At8[4], B08[2], B18[2];
    unsigned roC[2][2] = {{0u, 0u}, {0u, 0u}};
    const char* cA; const char* cB = p.b_base(cur); long bdC = p.b_delta(cur);
    if constexpr (P::GATHER) { cA = p.a_gbase(); p.a_rows(cur, Rr, Cc, roC); } else { cA = p.a_base(cur); }
    PG8_STAGE_B(PG8_SB(0, 0), cB, 0); PG8_STAGE_B(PG8_SB(0, 1), cB, 1); PG8_STAGE_A(PG8_SA(0, 0), cA, 0, roC); PG8_STAGE_A(PG8_SA(0, 1), cA, 1, roC);
    if (wr == 1) PG8_BAR;
    PG8_WAIT_V(2); PG8_BAR;
    PG8_STAGE_B(PG8_SB(1, 0), cB + kstep, 0); PG8_STAGE_A(PG8_SA(1, 0), cA + kstep, 0, roC); PG8_STAGE_B(PG8_SB(1, 1), cB + kstep, 1);
    PG8_WAIT_V(6); PG8_BAR;
    for (;;) {
        const bool has_next = p.next(ui + 1, nxt);
        const char* nA = cA; const char* nB = cB; long bdN = bdC;
        if (has_next) { nB = p.b_base(nxt); bdN = p.b_delta(nxt); if constexpr (!P::GATHER) { nA = p.a_base(nxt); } }
#pragma unroll 1
        for (int t = 0; t < nt; t += 2) {
            const bool last = (t == nt - 2);
            if constexpr (P::HAS_MID) { if (t == P::MID0 || t == P::MID1) p.mid(acc, cur, t, wr, wc, fr, fq); }
            const char* a1 = cA + (size_t)(t + 1) * kstep;
            const char* a2 = last ? nA : cA + (size_t)(t + 2) * kstep;
            const char* b2 = last ? nB : cB + (size_t)(t + 2) * kstep + ((t + 2) >= P::BSEG ? bdC : 0l);
            const char* a3 = a2 + kstep; const char* b3 = b2 + kstep;
            PG8_LDB(B0, 0, 0); PG8_LDB(B1, 0, 1); PG8_SCHED; PG8_LDA(At, 0, 0); PG8_STAGE_A(PG8_SA(1, 1), a1, 1, roC);
            if constexpr (P::GATHER) { if (last && has_next) p.a_rows(nxt, Rr, Cc, roC); }
            PG8_WAIT_V(8); PG8_WAIT_L(0); PG8_BAR; PG8_MMA(0, 0, At, B0); PG8_MMA(0, 1, At, B1); PG8_BAR; PG8_SCHED;
            PG8_LDA(At, 0, 1); PG8_STAGE_B(PG8_SB(0, 0), b2, 0); PG8_STAGE_B(PG8_SB(0, 1), b2, 1); PG8_STAGE_A(PG8_SA(0, 0), a2, 0, roC);
            PG8_WAIT_V(8); PG8_WAIT_L(0); PG8_BAR; PG8_MMA(1, 0, At, B0); PG8_MMA(1, 1, At, B1); PG8_BAR; PG8_SCHED;
            PG8_LDB(B0, 1, 0); PG8_LDB(B1, 1, 1); PG8_SCHED; PG8_LDA(At, 1, 0); PG8_STAGE_A(PG8_SA(0, 1), a2, 1, roC);
            PG8_WAIT_V(8); PG8_WAIT_L(0); PG8_BAR; PG8_MMA(0, 0, At, B0); PG8_MMA(0, 1, At, B1); PG8_BAR; PG8_SCHED;
            PG8_LDA(At, 1, 1); PG8_STAGE_B(PG8_SB(1, 0), b3, 0); PG8_STAGE_B(PG8_SB(1, 1), b3, 1); PG8_STAGE_A(PG8_SA(1, 0), a3, 0, roC);
            PG8_WAIT_V(8); PG8_WAIT_L(0); PG8_BAR; PG8_MMA(1, 0, At, B0); PG8_MMA(1, 1, At, B1); PG8_BAR; PG8_SCHED;
        }
        if constexpr (P::ALIGN) { if (wr == 0) PG8_BAR; }
        p.epi(acc, cur, wr, wc, fr, fq);
        if (!has_next) break;
#pragma unroll
        for (int a = 0; a < 2; ++a)
#pragma unroll
            for (int b = 0; b < 2; ++b)
#pragma unroll
                for (int m = 0; m < 4; ++m)
#pragma unroll
                    for (int n = 0; n < 2; ++n) acc[a][b][m][n] = (f32x4){0.f, 0.f, 0.f, 0.f};
        cur = nxt; cA = nA; cB = nB; bdC = bdN; ++ui;
        if constexpr (P::ALIGN) { if (wr == 1) PG8_BAR; }
    }
    PG8_WAIT_V(0);
    if constexpr (!P::ALIGN) { if (wr == 0) PG8_BAR; }
    PG8_BAR;
#undef PG8_SA
#undef PG8_SB
#undef PG8_GL
#undef PG8_STAGE_A
#undef PG8_STAGE_B
#undef PG8_LDA
#undef PG8_LDB
#undef PG8_MMA
#undef PG8_WAIT_V
#undef PG8_WAIT_L
#undef PG8_BAR
#undef PG8_SCHED
}
}
using pg8::Unit;
typedef f32x4 AccT[2][2][4][2];

struct Args { const float* in[26]; float* out; unsigned char* ws; int ph_lo, ph_hi; };
struct Frame {
    LAS unsigned char* lds; volatile LAS unsigned* MISC; unsigned* ctl;
    int tid, lane, wave, G, c;
    const float* const* in; float* out; unsigned char* ws;
};

struct DenseBase {
    static constexpr bool GATHER = false, HAS_MID = false, F8 = false; static constexpr int SCALE_A = 0x7F7F7F7F, SCALE_B = 0x7F7F7F7F; static constexpr int MID0 = -1, MID1 = -1, BSEG = 1 << 20;
    pg8::StaticOrder S;
    __device__ __forceinline__ bool next(int i, Unit& u) const { return S.next(i, u); }
    __device__ __forceinline__ long b_delta(const Unit&) const { return 0l; }
    __device__ __forceinline__ const char* a_gbase() const { return nullptr; }
    __device__ __forceinline__ void a_rows(const Unit&, const int (&)[2], const int (&)[2], unsigned (&)[2][2]) const {}
    __device__ __forceinline__ void mid(AccT&, const Unit&, int, int, int, int, int) const {}
};
struct ProbG1 : DenseBase {
    static constexpr int NT = 16, LDA = 1024, LDB = 1024; static constexpr bool PERM = true, ALIGN = true;
    const char* A; const char* B; bf16* O; bf16* dummy;
    __device__ __forceinline__ const char* a_base(const Unit& u) const { return A + (size_t)u.pm * 256 * LDA * 2; }
    __device__ __forceinline__ const char* b_base(const Unit& u) const { return B + (size_t)u.pn * 256 * LDB * 2; }
    __device__ __forceinline__ void epi(AccT& acc, const Unit& u, int wr, int wc, int fr, int fq) const {
        int row0 = u.pm * 256 + wr * 64 + fr; const int col0 = u.pn * 256 + wc * 32 + 8 * fq; asm volatile("" : "+v"(row0));
#pragma unroll
        for (int ai = 0; ai < 2; ++ai)
#pragma unroll
            for (int m = 0; m < 4; ++m) { bf16* rowp = O + (size_t)(row0 + ai * 128 + m * 16) * INC + col0;
#pragma unroll
                for (int bj = 0; bj < 2; ++bj) { const f32x4 v0 = acc[ai][bj][m][0], v1 = acc[ai][bj][m][1];
                    u32x4 w; w.x = cvt_pk_bf16(v0[0], v0[1]); w.y = cvt_pk_bf16(v0[2], v0[3]); w.z = cvt_pk_bf16(v1[0], v1[1]); w.w = cvt_pk_bf16(v1[2], v1[3]);
                    *(u32x4*)(rowp + bj * 128) = w;
                    if (DUP_MASK & 8192) { const size_t off = ((size_t)((rowp + bj * 128) - O) * 2) & (size_t)(64 * MiB - 16); *(u32x4*)((char*)dummy + off) = w; } } }
    }
};
struct ProbG1g : DenseBase {
    static constexpr int NT = 8, LDA = 512, LDB = 512, SCALE_A = 0x7C7C7C7C, SCALE_B = 0x7C7C7C7C; static constexpr bool PERM = true, ALIGN = true, F8 = true, GATHER = true;
    const char* A; const char* B; bf16* O;
    __device__ __forceinline__ const char* a_gbase() const { return A; }
    __device__ __forceinline__ void a_rows(const Unit& u, const int (&R)[2], const int (&C)[2], unsigned (&ro)[2][2]) const {
#pragma unroll
        for (int h = 0; h < 2; ++h)
#pragma unroll
            for (int i = 0; i < 2; ++i) ro[h][i] = (unsigned)((u.pm * 256 + h * 128 + R[i]) * LDA + C[i]) * 2u; }
    __device__ __forceinline__ const char* a_base(const Unit& u) const { return A + (size_t)u.pm * 256 * LDA * 2; }
    __device__ __forceinline__ const char* b_base(const Unit& u) const { return B + (size_t)u.pn * 256 * LDB * 2; }
    __device__ __forceinline__ void epi(AccT& acc, const Unit& u, int wr, int wc, int fr, int fq) const {
        int row0 = u.pm * 256 + wr * 64 + fr; const int col0 = 4096 + u.pn * 256 + wc * 32 + 8 * fq; asm volatile("" : "+v"(row0));
#pragma unroll
        for (int ai = 0; ai < 2; ++ai)
#pragma unroll
            for (int m = 0; m < 4; ++m) { bf16* rowp = O + (size_t)(row0 + ai * 128 + m * 16) * INC + col0;
#pragma unroll
                for (int bj = 0; bj < 2; ++bj) { const f32x4 v0 = acc[ai][bj][m][0], v1 = acc[ai][bj][m][1];
                    u32x4 w; w.x = cvt_pk_bf16(v0[0], v0[1]); w.y = cvt_pk_bf16(v0[2], v0[3]); w.z = cvt_pk_bf16(v1[0], v1[1]); w.w = cvt_pk_bf16(v1[2], v1[3]);
                    *(u32x4*)(rowp + bj * 128) = w; } }
    }
};
struct ProbG2 : DenseBase {
    static constexpr int NT = 32, LDA = 2048, LDB = 2048, MID0 = 8, MID1 = 24; static constexpr bool PERM = true, ALIGN = false, HAS_MID = true;
    const char* A; const char* B; const bf16* zh; bf16* O;
    __device__ __forceinline__ const char* a_base(const Unit& u) const { return A + (size_t)u.pm * 256 * LDA * 2; }
    __device__ __forceinline__ const char* b_base(const Unit& u) const { return B + (size_t)u.pn * 256 * LDB * 2; }
    __device__ __forceinline__ void mid(AccT& acc, const Unit& u, int t, int wr, int wc, int fr, int fq) const {
        const int cn = (t == MID0) ? C_GA : C_GB;
        int row0 = u.pm * 256 + wr * 64 + fr; const int col0 = u.pn * 256 + wc * 32 + 8 * fq; asm volatile("" : "+v"(row0));
        u32x4 va[2][2][2], vb[2][2][2];
#define G2_LOAD(q, buf) do { _Pragma("unroll") for (int mm = 0; mm < 2; ++mm) { const bf16* zr = zh + (size_t)(row0 + ((q) >> 1) * 128 + (2 * ((q) & 1) + mm) * 16) * INC + col0 + cn; \
            _Pragma("unroll") for (int bj = 0; bj < 2; ++bj) { va[buf][mm][bj] = *(const u32x4*)(zr + bj * 128); vb[buf][mm][bj] = *(const u32x4*)(zr + 1024 + bj * 128); } } } while (0)
#define G2_APPLY(q, buf) do { _Pragma("unroll") for (int mm = 0; mm < 2; ++mm) _Pragma("unroll") for (int bj = 0; bj < 2; ++bj) _Pragma("unroll") for (int e = 0; e < 4; ++e) { \
            const unsigned wa = va[buf][mm][bj][e], wb = vb[buf][mm][bj][e]; const float L2E = -1.4426950408889634f; \
            const float r0 = (1.0f + __builtin_amdgcn_exp2f(bflo(wb) * L2E)) * frcp(1.0f + __builtin_amdgcn_exp2f(bflo(wa) * L2E)), r1 = (1.0f + __builtin_amdgcn_exp2f(bfhi(wb) * L2E)) * frcp(1.0f + __builtin_amdgcn_exp2f(bfhi(wa) * L2E)); \
            acc[(q) >> 1][bj][2 * ((q) & 1) + mm][e >> 1][(e & 1) * 2] *= r0; acc[(q) >> 1][bj][2 * ((q) & 1) + mm][e >> 1][(e & 1) * 2 + 1] *= r1; } } while (0)
        G2_LOAD(0, 0); G2_LOAD(1, 1); asm volatile("" ::: "memory");
        G2_APPLY(0, 0); G2_LOAD(2, 0); asm volatile("" ::: "memory");
        G2_APPLY(1, 1); G2_LOAD(3, 1); asm volatile("" ::: "memory");
        G2_APPLY(2, 0); G2_APPLY(3, 1);
#undef G2_LOAD
#undef G2_APPLY
    }
    __device__ __forceinline__ void epi(AccT& acc, const Unit& u, int wr, int wc, int fr, int fq) const {
        int row0 = u.pm * 256 + wr * 64 + fr; const int col0 = u.pn * 256 + wc * 32 + 8 * fq; asm volatile("" : "+v"(row0));
#pragma unroll
        for (int ai = 0; ai < 2; ++ai) {
            u32x4 vc[4][2];
#pragma unroll
            for (int m = 0; m < 4; ++m) { const bf16* zr = zh + (size_t)(row0 + ai * 128 + m * 16) * INC + col0 + C_GC;
#pragma unroll
                for (int bj = 0; bj < 2; ++bj) vc[m][bj] = *(const u32x4*)(zr + bj * 128); }
#pragma unroll
            for (int m = 0; m < 4; ++m) { bf16* rowp = O + (size_t)(row0 + ai * 128 + m * 16) * D + col0;
#pragma unroll
                for (int bj = 0; bj < 2; ++bj) { u32x4 w;
#pragma unroll
                    for (int e = 0; e < 4; ++e) { const float s0 = fsig(bflo(vc[m][bj][e])), s1 = fsig(bfhi(vc[m][bj][e]));
                        w[e] = cvt_pk_bf16(acc[ai][bj][m][e >> 1][(e & 1) * 2] * s0, acc[ai][bj][m][e >> 1][(e & 1) * 2 + 1] * s1); }
                    *(u32x4*)(rowp + bj * 128) = w; } }
            asm volatile("" ::: "memory"); }
    }
};
struct ProbG3 : DenseBase {
    static constexpr int NT = 16, LDA = 1024, LDB = 1024; static constexpr bool PERM = false, ALIGN = true;
    const char* A; const char* B; const float* xin; float* xout; float* xdummy;
    __device__ __forceinline__ const char* a_base(const Unit& u) const { return A + (size_t)u.pm * 256 * LDA * 2; }
    __device__ __forceinline__ const char* b_base(const Unit& u) const { return B + (size_t)u.pn * 256 * LDB * 2; }
    __device__ __forceinline__ void epi(AccT& acc, const Unit& u, int wr, int wc, int fr, int fq) const {
        int row0 = u.pm * 256 + wr * 64 + fr; const int col0 = u.pn * 256 + wc * 32 + 4 * fq; asm volatile("" : "+v"(row0));
        float* const xo = xout;
#pragma unroll
        for (int ai = 0; ai < 2; ++ai) {
            f32x4 xv[4][2][2];
#pragma unroll
            for (int m = 0; m < 4; ++m) { const size_t off = (size_t)(row0 + ai * 128 + m * 16) * D + col0;
#pragma unroll
                for (int bj = 0; bj < 2; ++bj)
#pragma unroll
                    for (int n = 0; n < 2; ++n) xv[m][bj][n] = *(const f32x4*)(xin + off + bj * 128 + n * 16); }
#pragma unroll
            for (int m = 0; m < 4; ++m) { const size_t off = (size_t)(row0 + ai * 128 + m * 16) * D + col0;
#pragma unroll
                for (int bj = 0; bj < 2; ++bj)
#pragma unroll
                    for (int n = 0; n < 2; ++n) *(f32x4*)(xo + off + bj * 128 + n * 16) = xv[m][bj][n] + acc[ai][bj][m][n]; }
            asm volatile("" ::: "memory"); }
    }
};
struct MoeBase {
    static constexpr bool HAS_MID = false; static constexpr int MID0 = -1, MID1 = -1;
    volatile LAS unsigned* MISC; const i32x4* rinfo; int G, c, nsh;
    __device__ __forceinline__ bool next(int i, Unit& u) const { const int L = i * G + c; const int np = (int)MISC[MW_NPAN]; if (L >= (np << nsh)) return false; u.rep = 0; u.pm = L >> nsh; u.pn = L & ((1 << nsh) - 1); return true; }
    __device__ __forceinline__ void mid(AccT&, const Unit&, int, int, int, int, int) const {}
    __device__ __forceinline__ void pinfo(const Unit& u, int& cls, int& lp, int& cnt) const { const unsigned pt = MISC[MW_PT + u.pm]; cls = (int)(pt >> 8); lp = (int)(pt & 255u); cnt = (int)MISC[MW_CNT + cls]; }
    static __device__ __forceinline__ int e_lo(int cls) { const int g = cls / 6, pi = cls - g * 6; return g * 4 + ((0x940 >> (2 * pi)) & 3); }
    static __device__ __forceinline__ int e_hi(int cls) { const int g = cls / 6, pi = cls - g * 6; return g * 4 + ((0xFB9 >> (2 * pi)) & 3); }
};
struct ProbMA : MoeBase {
    static constexpr int NT = 8, LDA = 512, LDB = 512, BSEG = 1 << 20, SCALE_A = 0x7C7C7C7C, SCALE_B = 0x7C7C7C7C; static constexpr bool PERM = true, ALIGN = true, GATHER = true, F8 = true;
    const char* A; const char* B; bf16* hid;
    __device__ __forceinline__ const char* a_gbase() const { return A; }
    __device__ __forceinline__ const char* a_base(const Unit&) const { return A; }
    __device__ __forceinline__ long b_delta(const Unit&) const { return 0l; }
    __device__ __forceinline__ void a_rows(const Unit& u, const int (&R)[2], const int (&C)[2], unsigned (&ro)[2][2]) const {
        int cls, lp, cnt; pinfo(u, cls, lp, cnt);
#pragma unroll
        for (int h = 0; h < 2; ++h)
#pragma unroll
            for (int i = 0; i < 2; ++i) { const int slot = lp * 256 + h * 128 + R[i]; int tok = 0; if (slot < cnt) tok = rinfo[(size_t)cls * CAP + slot].x; ro[h][i] = (unsigned)(tok * LDA + C[i]) * 2u; }
    }
    __device__ __forceinline__ const char* b_base(const Unit& u) const { int cls, lp, cnt; pinfo(u, cls, lp, cnt); const int e = (u.pn < 4) ? e_lo(cls) : e_hi(cls); return B + ((size_t)e * 1024 + (u.pn & 3) * 256) * LDB * 2; }
    __device__ __forceinline__ void epi(AccT& acc, const Unit& u, int wr, int wc, int fr, int fq) const {
        int cls, lp, cnt; pinfo(u, cls, lp, cnt);
        int r0 = wr * 64 + fr; const int colb = (u.pn >> 2) * 512 + (u.pn & 3) * 128 + wc * 32 + 8 * fq; asm volatile("" : "+v"(r0));
#pragma unroll
        for (int ai = 0; ai < 2; ++ai)
#pragma unroll
            for (int m = 0; m < 4; ++m) { const int rr = r0 + ai * 128 + m * 16, slot = lp * 256 + rr; float gate = 0.f;
                float rs = 0.f;
                if (slot < cnt) { const i32x4 inf = rinfo[(size_t)cls * CAP + slot]; gate = __int_as_float(u.pn < 4 ? inf.y : inf.z); rs = __int_as_float(inf.w); }
                gate *= rs;
                u32x4 w;
#pragma unroll
                for (int e = 0; e < 4; ++e) { const float a0 = rs * acc[ai][0][m][e >> 1][(e & 1) * 2], a1 = rs * acc[ai][0][m][e >> 1][(e & 1) * 2 + 1], b0 = acc[ai][1][m][e >> 1][(e & 1) * 2], b1 = acc[ai][1][m][e >> 1][(e & 1) * 2 + 1];
                    w[e] = cvt_pk_bf16(gate * a0 * fsig(a0) * b0, gate * a1 * fsig(a1) * b1); }
                *(u32x4*)(hid + (size_t)(u.pm * 256 + rr) * 1024 + colb) = w; }
    }
};
struct ProbMB : MoeBase {
    static constexpr int NT = 16, LDA = 1024, LDB = 512, BSEG = 8, SCALE_A = 0x7F7F7F7F, SCALE_B = 0x7F7F7F7F; static constexpr bool PERM = false, ALIGN = true, GATHER = false, F8 = false;
    const char* A; const char* B; float* x; float* xdummy;
    __device__ __forceinline__ const char* a_gbase() const { return A; }
    __device__ __forceinline__ void a_rows(const Unit&, const int (&)[2], const int (&)[2], unsigned (&)[2][2]) const {}
    __device__ __forceinline__ const char* a_base(const Unit& u) const { return A + (size_t)u.pm * 256 * LDA * 2; }
    __device__ __forceinline__ const char* b_base(const Unit& u) const { int cls, lp, cnt; pinfo(u, cls, lp, cnt); return B + ((size_t)e_lo(cls) * 1024 + u.pn * 256) * LDB * 2; }
    __device__ __forceinline__ long b_delta(const Unit& u) const { int cls, lp, cnt; pinfo(u, cls, lp, cnt); return (long)(e_hi(cls) - e_lo(cls)) * 1024 * LDB * 2 - 8 * 128; }
    __device__ __forceinline__ void epi(AccT& acc, const Unit& u, int wr, int wc, int fr, int fq) const {
        int cls, lp, cnt; pinfo(u, cls, lp, cnt);
        int r0 = wr * 64 + fr; const int col0 = u.pn * 256 + wc * 32 + 4 * fq; asm volatile("" : "+v"(r0));
        float* const xb_ = x;
#pragma unroll
        for (int ai = 0; ai < 2; ++ai)
#pragma unroll
            for (int mh = 0; mh < 2; ++mh) {
                int tok[2];
#pragma unroll
                for (int mm = 0; mm < 2; ++mm) { const int slot = lp * 256 + r0 + ai * 128 + (2 * mh + mm) * 16; tok[mm] = (slot < cnt) ? rinfo[(size_t)cls * CAP + slot].x : -1; }
                f32x4 xv[2][2][2];
#pragma unroll
                for (int mm = 0; mm < 2; ++mm) { const float* xr = xb_ + (size_t)(tok[mm] < 0 ? 0 : tok[mm]) * D + col0;
#pragma unroll
                    for (int bj = 0; bj < 2; ++bj)
#pragma unroll
                        for (int n = 0; n < 2; ++n) xv[mm][bj][n] = *(const f32x4*)(xr + bj * 128 + n * 16); }
#pragma unroll
                for (int mm = 0; mm < 2; ++mm) if (tok[mm] >= 0) { float* xr = xb_ + (size_t)tok[mm] * D + col0;
#pragma unroll
                    for (int bj = 0; bj < 2; ++bj)
#pragma unroll
                        for (int n = 0; n < 2; ++n) *(f32x4*)(xr + bj * 128 + n * 16) = xv[mm][bj][n] + acc[ai][bj][2 * mh + mm][n]; }
                asm volatile("" ::: "memory"); }
    }
};
__device__ __forceinline__ void moe_panel_table(const Frame& F, int l) {
    __syncthreads();
    if (F.tid == 0) { int np = 0; const unsigned* gc = F.ctl + CW_CNT + 64 * l;
        for (int cls = 0; cls < NCLS; ++cls) { const unsigned cnt = __hip_atomic_load(gc + cls, __ATOMIC_RELAXED, __HIP_MEMORY_SCOPE_AGENT); F.MISC[MW_CNT + cls] = cnt; const int k = (int)((cnt + 255u) >> 8);
            for (int j = 0; j < k; ++j) F.MISC[MW_PT + np + j] = ((unsigned)cls << 8) | (unsigned)j; np += k; }
        F.MISC[MW_NPAN] = (unsigned)np; }
    __syncthreads();
}

__device__ __forceinline__ void tr_item(const float* W, int N, int k0, int n0, const float* gain, bf16* dst, int ldd, int drow0, int kofs, LAS float* scr, int lane) {
    float tv[32];
#pragma unroll
    for (int i = 0; i < 32; ++i) { const int kk = 2 * i + (lane >> 5); tv[i] = W[(size_t)(k0 + kk) * N + n0 + (lane & 31)]; }
    if (gain) {
#pragma unroll
        for (int i = 0; i < 32; ++i) tv[i] *= gain[k0 + 2 * i + (lane >> 5)]; }
#pragma unroll
    for (int i = 0; i < 32; ++i) { const int kk = 2 * i + (lane >> 5); scr[kk * 33 + (lane & 31)] = tv[i]; }
    LDS_WAIT();
    const int c = lane & 7;
#pragma unroll
    for (int j = 0; j < 4; ++j) { const int n = (lane >> 3) + 8 * j; const LAS float* s = scr + (8 * c) * 33 + n;
        u32x4 o; o.x = cvt_pk_bf16(s[0 * 33], s[1 * 33]); o.y = cvt_pk_bf16(s[2 * 33], s[3 * 33]); o.z = cvt_pk_bf16(s[4 * 33], s[5 * 33]); o.w = cvt_pk_bf16(s[6 * 33], s[7 * 33]);
        *(u32x4*)(dst + (size_t)(drow0 + n) * ldd + kofs + k0 + 8 * c) = o; }
    LDS_WAIT();
}
__device__ __forceinline__ void tr_item_f8(const float* W, int N, int k0, int n0, const float* gain, float scale, unsigned char* dst, int ldd, int drow0, LAS float* scr, int lane) {
    float tv[32];
#pragma unroll
    for (int i = 0; i < 32; ++i) { const int kk = 2 * i + (lane >> 5); tv[i] = W[(size_t)(k0 + kk) * N + n0 + (lane & 31)] * scale; }
    if (gain) {
#pragma unroll
        for (int i = 0; i < 32; ++i) tv[i] *= gain[k0 + 2 * i + (lane >> 5)]; }
#pragma unroll
    for (int i = 0; i < 32; ++i) { const int kk = 2 * i + (lane >> 5); scr[kk * 33 + (lane & 31)] = fminf(fmaxf(tv[i], -448.f), 448.f); }
    LDS_WAIT();
    const int c = lane & 7;
#pragma unroll
    for (int j = 0; j < 4; ++j) { const int n = (lane >> 3) + 8 * j; const LAS float* s = scr + (8 * c) * 33 + n;
        int t0 = __builtin_amdgcn_cvt_pk_fp8_f32(s[0 * 33], s[1 * 33], 0, false); t0 = __builtin_amdgcn_cvt_pk_fp8_f32(s[2 * 33], s[3 * 33], t0, true);
        int t1 = __builtin_amdgcn_cvt_pk_fp8_f32(s[4 * 33], s[5 * 33], 0, false); t1 = __builtin_amdgcn_cvt_pk_fp8_f32(s[6 * 33], s[7 * 33], t1, true);
        u32x2 o; o.x = (unsigned)t0; o.y = (unsigned)t1;
        *(u32x2*)(dst + (size_t)(drow0 + n) * ldd + k0 + 8 * c) = o; }
    LDS_WAIT();
}
__device__ __forceinline__ void convert_weights(const Frame& F, int l, int which) {
    LAS float* scr = (LAS float*)(F.lds + F.wave * 8448);
    const int gw = F.c * NWAVES + F.wave, NGW = F.G * NWAVES;
    const float* const* in = F.in; unsigned char* ws = F.ws;
    constexpr int I_IN = 16 * 224, I_A = 8 * 32, I_B = 16 * 32, I_O = 16 * 32, I_W1 = 16 * 16 * 16, I_W2 = 16 * 8 * 32, I_LR = 8 * 2 * 4, I_PL = 4 * 2 * 4;
    if (which & 1) {
        for (int it = gw; it < I_PL; it += NGW) { const int r = it; const int g = r >> 3, q = r & 7, kb = q >> 2, nb = q & 3;
            tr_item(in[13] + ((size_t)l * 4 + g) * 128 * 128, 128, kb * 64, nb * 32, nullptr, (bf16*)(ws + WS_PLT) + (size_t)g * 128 * 128, 128, nb * 32, 0, scr, F.lane); }
    }
    if (which & 2) {
        for (int it = gw; it < I_IN + 2 * I_A + I_B + I_O; it += NGW) { int r = it;
            if (r < I_IN) { const int kb = r / 224, nb = r % 224;
                if (nb < 128) tr_item(in[2] + (size_t)l * D * INC, INC, kb * 64, nb * 32, in[1] + (size_t)l * D, (bf16*)(ws + WS_WINT), 1024, nb * 32, 0, scr, F.lane);
                else tr_item_f8(in[2] + (size_t)l * D * INC, INC, kb * 64, nb * 32, in[1] + (size_t)l * D, 32.0f, ws + WS_WING8, 1024, nb * 32 - 4096, scr, F.lane);
                continue; } r -= I_IN;
            if (r < I_A) { const int kb = r / 32, nb = r % 32; tr_item(in[4] + (size_t)l * W_A * D, D, kb * 64, nb * 32, nullptr, (bf16*)(ws + WS_WCAT), 2048, nb * 32, 0, scr, F.lane); continue; } r -= I_A;
            if (r < I_B) { const int kb = r / 32, nb = r % 32; tr_item(in[12] + (size_t)l * W_B * D, D, kb * 64, nb * 32, nullptr, (bf16*)(ws + WS_WCAT), 2048, nb * 32, 512, scr, F.lane); continue; } r -= I_B;
            if (r < I_A) { const int kb = r / 32, nb = r % 32; tr_item(in[15] + (size_t)l * W_C * D, D, kb * 64, nb * 32, nullptr, (bf16*)(ws + WS_WCAT), 2048, nb * 32, 1536, scr, F.lane); continue; } r -= I_A;
            { const int kb = r / 32, nb = r % 32; tr_item(in[16] + (size_t)l * D * D, D, kb * 64, nb * 32, nullptr, (bf16*)(ws + WS_WOT), 1024, nb * 32, 0, scr, F.lane); } }
    }
    if (which & 4) {
        for (int it = gw; it < 2 * I_W1 + I_W2; it += NGW) { int r = it;
            if (r < 2 * I_W1) { const int sel = r / I_W1; r -= sel * I_W1; const int e = r >> 8, q = r & 255, kb = q >> 4, nb = q & 15, n0 = nb * 32;
                tr_item_f8(in[sel ? 23 : 22] + ((size_t)l * NE + e) * D * DE, DE, kb * 64, n0, in[17] + (size_t)l * D, 64.0f, ws + WS_BAT + (size_t)e * 1024 * 1024, 1024, 256 * (n0 >> 7) + 128 * sel + (n0 & 127), scr, F.lane); continue; }
            r -= 2 * I_W1; { const int e = r >> 8, q = r & 255, kb = q >> 5, nb = q & 31;
                tr_item(in[24] + ((size_t)l * NE + e) * DE * D, D, kb * 64, nb * 32, nullptr, (bf16*)(ws + WS_W2T) + (size_t)e * 1024 * 512, 512, nb * 32, 0, scr, F.lane); } }
    }
}
__device__ __forceinline__ void norm_row_to_bf16(const float* xrow, bf16* orow, unsigned char* orow8, int lane) {
    const f32x4* xr = (const f32x4*)xrow + lane; f32x4 v[4]; float s = 0.f;
#pragma unroll
    for (int j = 0; j < 4; ++j) { v[j] = xr[64 * j]; s += (v[j].x * v[j].x + v[j].y * v[j].y) + (v[j].z * v[j].z + v[j].w * v[j].w); }
    const float rstd = rsqrtf(wave_sum(s) * (1.f / D) + EPS);
    u32x2* o8 = (u32x2*)orow + lane; unsigned* q8 = (unsigned*)orow8 + lane;
#pragma unroll
    for (int j = 0; j < 4; ++j) { const f32x4 t = v[j] * rstd; u32x2 w; w.x = cvt_pk_bf16(t.x, t.y); w.y = cvt_pk_bf16(t.z, t.w); o8[64 * j] = w;
        int p = __builtin_amdgcn_cvt_pk_fp8_f32(2.0f * t.x, 2.0f * t.y, 0, false); p = __builtin_amdgcn_cvt_pk_fp8_f32(2.0f * t.z, 2.0f * t.w, p, true); q8[64 * j] = (unsigned)p; }
}
__device__ __forceinline__ void phase_n1(const Frame& F, int l) {
    convert_weights(F, l, 7);
    const float* x = (l == 0) ? F.in[0] : F.out; bf16* xb = (bf16*)(F.ws + WS_XB);
    const int gw = F.c * NWAVES + F.wave, NGW = F.G * NWAVES;
    for (int m = gw; m < T; m += NGW) norm_row_to_bf16(x + (size_t)m * D, xb + (size_t)m * D, F.ws + (m < TH ? WS_XB8A : WS_XB8B) + (size_t)(m < TH ? m : m - TH) * D, F.lane);
}
__device__ __forceinline__ void phase_final(const Frame& F) {
    const float* g = F.in[25]; const int gw = F.c * NWAVES + F.wave, NGW = F.G * NWAVES;
    f32x4 gv[4];
#pragma unroll
    for (int j = 0; j < 4; ++j) gv[j] = ((const f32x4*)g)[F.lane + 64 * j];
    for (int m = gw; m < T; m += NGW) { f32x4* xr = (f32x4*)(F.out + (size_t)m * D) + F.lane; f32x4 v[4]; float s = 0.f;
#pragma unroll
        for (int j = 0; j < 4; ++j) { v[j] = xr[64 * j]; s += (v[j].x * v[j].x + v[j].y * v[j].y) + (v[j].z * v[j].z + v[j].w * v[j].w); }
        const float rstd = rsqrtf(wave_sum(s) * (1.f / D) + EPS);
#pragma unroll
        for (int j = 0; j < 4; ++j) xr[64 * j] = v[j] * rstd * gv[j]; }
}
constexpr int RT_ROWB = 2064;
constexpr int RT_HI = 0, RT_LO = 20 * RT_ROWB, RT_HIST = 2 * 20 * RT_ROWB, RT_GBASE = RT_HIST + 128, RT_RTMP = RT_HIST + 256, RT_LG = RT_RTMP + 2048, RT_RS = RT_LG + 8 * 16 * 32 * 4;
__device__ __forceinline__ void phase_router(const Frame& F, int l, int rep = 0) {
    LAS unsigned char* lds = F.lds;
    LAS unsigned* hist = (LAS unsigned*)(lds + RT_HIST); LAS unsigned* gbase = (LAS unsigned*)(lds + RT_GBASE); LAS i32x4* rtmp = (LAS i32x4*)(lds + RT_RTMP);
    LAS float* LG = (LAS float*)(lds + RT_LG) + F.wave * 16 * 32; LAS float* RS = (LAS float*)(lds + RT_RS) + F.wave * 16;
    const float* g2 = F.in[17] + (size_t)l * D; const float* wg = F.in[18] + (size_t)l * D * NG; const float* we = F.in[20] + (size_t)l * D * NE;
    const float* bg = F.in[19] + (size_t)l * NG; const float* be = F.in[21] + (size_t)l * NE;
    __syncthreads();
    for (int idx = F.tid; idx < 20 * 1024; idx += NTHR) { const int j = idx >> 10, k = idx & 1023; const float v = g2[k] * (j < 4 ? wg[k * NG + j] : we[k * NE + (j - 4)]);
        const bf16 hi = f2bf(v); const bf16 lo = f2bf(v - bf2f(hi)); *(LAS bf16*)(lds + RT_HI + j * RT_ROWB + k * 2) = hi; *(LAS bf16*)(lds + RT_LO + j * RT_ROWB + k * 2) = lo; }
    const float* x = F.out; bf16* h2 = (bf16*)(F.ws + WS_XB); i32x4* rinfo = (i32x4*)(F.ws + (rep ? WS_ZH + 112 * MiB : WS_RINFO)); unsigned* gcnt = F.ctl + CW_CNT + 64 * (l + 2 * rep);
    const int lane = F.lane, fr = lane & 15, fq = lane >> 4;
    for (int blk = F.c; blk < T / 128; blk += F.G) {
        if (F.tid < 32) hist[F.tid] = 0u;
        __syncthreads();
        const int row = blk * 128 + F.wave * 16 + fr;
        const float* xr = x + (size_t)row * D + 8 * fq; unsigned char* hr = (unsigned char*)h2 + (size_t)row * D + 8 * fq;
        f32x4 d0 = (f32x4){0.f, 0.f, 0.f, 0.f}, d1 = d0; float ss = 0.f;
        const bool n1ok = fr < 4;
#pragma unroll 8
        for (int ks = 0; ks < 32; ++ks) {
            const f32x4 v0 = *(const f32x4*)(xr + 32 * ks), v1 = *(const f32x4*)(xr + 32 * ks + 4);
            ss += (v0.x * v0.x + v0.y * v0.y) + (v0.z * v0.z + v0.w * v0.w) + (v1.x * v1.x + v1.y * v1.y) + (v1.z * v1.z + v1.w * v1.w);
            u32x4 hi; hi.x = cvt_pk_bf16(v0.x, v0.y); hi.y = cvt_pk_bf16(v0.z, v0.w); hi.z = cvt_pk_bf16(v1.x, v1.y); hi.w = cvt_pk_bf16(v1.z, v1.w);
            { int t0 = __builtin_amdgcn_cvt_pk_fp8_f32(v0.x, v0.y, 0, false); t0 = __builtin_amdgcn_cvt_pk_fp8_f32(v0.z, v0.w, t0, true);
              int t1 = __builtin_amdgcn_cvt_pk_fp8_f32(v1.x, v1.y, 0, false); t1 = __builtin_amdgcn_cvt_pk_fp8_f32(v1.z, v1.w, t1, true);
              u32x2 q; q.x = (unsigned)t0; q.y = (unsigned)t1; *(u32x2*)(hr + 32 * ks) = q; }
            u32x4 lo; lo.x = cvt_pk_bf16(v0.x - bflo(hi.x), v0.y - bfhi(hi.x)); lo.y = cvt_pk_bf16(v0.z - bflo(hi.y), v0.w - bfhi(hi.y));
            lo.z = cvt_pk_bf16(v1.x - bflo(hi.z), v1.y - bfhi(hi.z)); lo.w = cvt_pk_bf16(v1.z - bflo(hi.w), v1.w - bfhi(hi.w));
            const bf16x8 ah = __builtin_bit_cast(bf16x8, hi), al = __builtin_bit_cast(bf16x8, lo);
            const int bo = (32 * ks + 8 * fq) * 2;
            const bf16x8 bh0 = *(const LAS bf16x8*)(lds + RT_HI + fr * RT_ROWB + bo), bl0 = *(const LAS bf16x8*)(lds + RT_LO + fr * RT_ROWB + bo);
            bf16x8 bh1 = (bf16x8){0, 0, 0, 0, 0, 0, 0, 0}, bl1 = bh1;
            if (n1ok) { bh1 = *(const LAS bf16x8*)(lds + RT_HI + (16 + fr) * RT_ROWB + bo); bl1 = *(const LAS bf16x8*)(lds + RT_LO + (16 + fr) * RT_ROWB + bo); }
            d0 = __builtin_amdgcn_mfma_f32_16x16x32_bf16(ah, bh0, d0, 0, 0, 0); d0 = __builtin_amdgcn_mfma_f32_16x16x32_bf16(al, bh0, d0, 0, 0, 0); d0 = __builtin_amdgcn_mfma_f32_16x16x32_bf16(ah, bl0, d0, 0, 0, 0);
            d1 = __builtin_amdgcn_mfma_f32_16x16x32_bf16(ah, bh1, d1, 0, 0, 0); d1 = __builtin_amdgcn_mfma_f32_16x16x32_bf16(al, bh1, d1, 0, 0, 0); d1 = __builtin_amdgcn_mfma_f32_16x16x32_bf16(ah, bl1, d1, 0, 0, 0);
        }
        ss += __builtin_bit_cast(float, __builtin_amdgcn_ds_bpermute((lane ^ 16) << 2, __builtin_bit_cast(int, ss))); ss += __builtin_bit_cast(float, __builtin_amdgcn_ds_bpermute((lane ^ 32) << 2, __builtin_bit_cast(int, ss)));
        const float rstd = rsqrtf(ss * (1.f / D) + EPS);
        if (fq == 0) RS[fr] = rstd;
#pragma unroll
        for (int r = 0; r < 4; ++r) { LG[(4 * fq + r) * 32 + fr] = d0[r]; LG[(4 * fq + r) * 32 + 16 + fr] = d1[r]; }
        LDS_WAIT();
        if (lane < 16) {
            const float rs = RS[lane]; float lg[20];
#pragma unroll
            for (int q = 0; q < 20; ++q) lg[q] = LG[lane * 32 + q] * rs + (q < 4 ? bg[q] : be[q - 4]);
            int gi = 0; float mx = lg[0];
#pragma unroll
            for (int j = 1; j < 4; ++j) if (lg[j] > mx) { mx = lg[j]; gi = j; }
            float den = 0.f;
#pragma unroll
            for (int j = 0; j < 4; ++j) den += __expf(lg[j] - mx);
            const float gp = 1.0f / den;
            float el[4];
#pragma unroll
            for (int j = 0; j < 4; ++j) el[j] = (gi == 0) ? lg[4 + j] : (gi == 1) ? lg[8 + j] : (gi == 2) ? lg[12 + j] : lg[16 + j];
            int i1 = 0; float v1 = el[0];
#pragma unroll
            for (int j = 1; j < 4; ++j) if (el[j] > v1) { v1 = el[j]; i1 = j; }
            int i2 = -1; float v2 = 0.f;
#pragma unroll
            for (int j = 0; j < 4; ++j) if (j != i1 && (i2 < 0 || el[j] > v2)) { i2 = j; v2 = el[j]; }
            const float e2 = __expf(v2 - v1); const float p1 = gp / (1.0f + e2), p2 = gp * e2 / (1.0f + e2);
            const int lo_ = i1 < i2 ? i1 : i2, hi_ = i1 < i2 ? i2 : i1; const float glo = i1 < i2 ? p1 : p2, ghi = i1 < i2 ? p2 : p1;
            const int pidx = (lo_ == 0) ? hi_ - 1 : (lo_ == 1 ? hi_ + 1 : 5); const int cls = gi * 6 + pidx;
            const unsigned ls = atomicAdd((unsigned*)(hist + cls), 1u);
            rtmp[F.wave * 16 + lane] = (i32x4){cls | ((int)ls << 8), __float_as_int(glo), __float_as_int(ghi), __float_as_int(rs)};
        }
        __syncthreads();
        if (F.tid < NCLS) gbase[F.tid] = __hip_atomic_fetch_add(gcnt + F.tid, hist[F.tid], __ATOMIC_RELAXED, __HIP_MEMORY_SCOPE_AGENT);
        __syncthreads();
        if (F.tid < 128) { const i32x4 r = rtmp[F.tid]; const int cls = r.x & 255; const unsigned slot = gbase[cls] + (unsigned)(r.x >> 8); rinfo[(size_t)cls * CAP + slot] = (i32x4){blk * 128 + F.tid, r.y, r.z, r.w}; }
        __syncthreads();
    }
}

constexpr int L_CU = 0, L_PW = 38912, L_PC = 73728;
__device__ __forceinline__ void stage_pad128(const bf16* src, LAS unsigned char* dst, int tid) {
    for (int p = tid; p < 2048; p += NTHR) { const int r = p >> 4, c16 = p & 15; *(LAS u32x4*)(dst + r * 272 + c16 * 16) = *(const u32x4*)(src + r * 128 + c16 * 8); }
}
constexpr int L2_WR = 0, L2_WI = 17408, L2_WAGG = 34816, L2_OT = 36864, L2_CST = 40960, L2_XT = 45056, L2_XTB = 35840;
struct LruCtx { int w, fr, fq; bf16* yrow; };
__device__ __forceinline__ float dpp_shr(float oldv, float v, int d) {
    int r;
    switch (d) { case 1: r = __builtin_amdgcn_update_dpp(__builtin_bit_cast(int, oldv), __builtin_bit_cast(int, v), 0x111, 0xf, 0xf, false); break;
                 case 2: r = __builtin_amdgcn_update_dpp(__builtin_bit_cast(int, oldv), __builtin_bit_cast(int, v), 0x112, 0xf, 0xf, false); break;
                 case 4: r = __builtin_amdgcn_update_dpp(__builtin_bit_cast(int, oldv), __builtin_bit_cast(int, v), 0x114, 0xf, 0xf, false); break;
                 default: r = __builtin_amdgcn_update_dpp(__builtin_bit_cast(int, oldv), __builtin_bit_cast(int, v), 0x118, 0xf, 0xf, false); break; }
    return __builtin_bit_cast(float, r);
}
#define LRU_RD12(F, G, WADDR, XADDR, KK) asm volatile("ds_read_b128 %0, %12 offset:%14\n\tds_read_b128 %1, %12 offset:%15\n\tds_read_b128 %2, %12 offset:%16\n\tds_read_b128 %3, %12 offset:%17\n\t" \
        "ds_read_b128 %4, %12 offset:%18\n\tds_read_b128 %5, %12 offset:%19\n\tds_read_b128 %6, %12 offset:%20\n\tds_read_b128 %7, %12 offset:%21\n\t" \
        "ds_read_b128 %8, %13 offset:%22\n\tds_read_b128 %9, %13 offset:%23\n\tds_read_b128 %10, %13 offset:%24\n\tds_read_b128 %11, %13 offset:%25\n\ts_waitcnt lgkmcnt(0)" \
        : "=&v"(F[0]), "=&v"(F[1]), "=&v"(F[2]), "=&v"(F[3]), "=&v"(F[4]), "=&v"(F[5]), "=&v"(F[6]), "=&v"(F[7]), "=&v"(G[0]), "=&v"(G[1]), "=&v"(G[2]), "=&v"(G[3]) : "v"(WADDR), "v"(XADDR), \
          "n"(L2_WR + (KK) * 4352), "n"(L2_WR + (KK) * 4352 + 64), "n"(L2_WR + (KK) * 4352 + 128), "n"(L2_WR + (KK) * 4352 + 192), \
          "n"(L2_WI + (KK) * 4352), "n"(L2_WI + (KK) * 4352 + 64), "n"(L2_WI + (KK) * 4352 + 128), "n"(L2_WI + (KK) * 4352 + 192), \
          "n"((KK) * 272), "n"((KK) * 272 + 64), "n"((KK) * 272 + 128), "n"((KK) * 272 + 192) : "memory")
__device__ __forceinline__ void lru_chunk(const LruCtx& X, const bf16x8 (&Wr)[4][4], LAS unsigned char* lds, u32x2& byraw, int ch, float (&Hc)[4], const char* zdma, const unsigned (&doff)[5], const char* byn, unsigned loff8, unsigned xsub) {
    const int fr = X.fr, fq = X.fq, w = X.w;
    { LAS unsigned char* dst = lds + L2_XT + ((ch + 1) & 1) * L2_XTB + w * 1024;
#pragma unroll
      for (int j = 0; j < 5; ++j) if (w + 8 * j < 35) __builtin_amdgcn_global_load_lds((const unsigned*)(zdma + doff[j]), (LAS unsigned*)(dst + j * 8192), 16, 0, 0); }
    const u32x2 bynext = *(const u32x2*)(byn + loff8);
    const f32x4 z4 = (f32x4){0.f, 0.f, 0.f, 0.f};
    f32x4 ar = z4, ai = z4;
    const unsigned xaddr = (unsigned)(L2_XT + (ch & 1) * L2_XTB + (16 * w + fr) * 272 + 16 * fq);
    const unsigned waddr = (unsigned)(fr * 136 + 8 * fq) * 2u;
#define LRU_RD8(F, G, WADDR, XADDR, KK) asm volatile("ds_read_b128 %0, %8 offset:%10\n\tds_read_b128 %1, %8 offset:%11\n\tds_read_b128 %2, %8 offset:%12\n\tds_read_b128 %3, %8 offset:%13\n\t" \
        "ds_read_b128 %4, %9 offset:%14\n\tds_read_b128 %5, %9 offset:%15\n\tds_read_b128 %6, %9 offset:%16\n\tds_read_b128 %7, %9 offset:%17\n\ts_waitcnt lgkmcnt(0)" \
        : "=&v"(F[0]), "=&v"(F[1]), "=&v"(F[2]), "=&v"(F[3]), "=&v"(G[0]), "=&v"(G[1]), "=&v"(G[2]), "=&v"(G[3]) : "v"(WADDR), "v"(XADDR), \
          "n"(L2_WI + (KK) * 4352), "n"(L2_WI + (KK) * 4352 + 64), "n"(L2_WI + (KK) * 4352 + 128), "n"(L2_WI + (KK) * 4352 + 192), \
          "n"((KK) * 272), "n"((KK) * 272 + 64), "n"((KK) * 272 + 128), "n"((KK) * 272 + 192) : "memory")
#define LRU_TAPR(KK) do { bf16x8 f_[4], g_[4]; LRU_RD8(f_, g_, waddr, xaddr, KK); \
        _Pragma("unroll") for (int i = 0; i < 4; ++i) { ar = __builtin_amdgcn_mfma_f32_16x16x32_bf16(Wr[KK][i], g_[i], ar, 0, 0, 0); ai = __builtin_amdgcn_mfma_f32_16x16x32_bf16(f_[i], g_[i], ai, 0, 0, 0); } } while (0)
    LRU_TAPR(0); LRU_TAPR(1); LRU_TAPR(2); LRU_TAPR(3);
#undef LRU_TAPR
#undef LRU_RD8
#define LRU_TAP(KK)
#undef LRU_TAP
    u32x2 xv[4];
#pragma unroll
    for (int kk = 0; kk < 4; ++kk) xv[kk] = *(const LAS u32x2*)(lds + L2_XT + (ch & 1) * L2_XTB + (16 * w + fr + kk) * 272 + xsub);
    float A[4], H[4];
#pragma unroll
    for (int r = 0; r < 4; ++r) { const LAS float* cs = (const LAS float*)(lds + L2_CST) + (4 * fq + r) * 8; const f32x4 c0 = *(const LAS f32x4*)cs, c1 = *(const LAS f32x4*)(cs + 4);
        const float x0 = (r & 1) ? bfhi(r < 2 ? xv[0].x : xv[0].y) : bflo(r < 2 ? xv[0].x : xv[0].y), x1 = (r & 1) ? bfhi(r < 2 ? xv[1].x : xv[1].y) : bflo(r < 2 ? xv[1].x : xv[1].y);
        const float x2 = (r & 1) ? bfhi(r < 2 ? xv[2].x : xv[2].y) : bflo(r < 2 ? xv[2].x : xv[2].y), x3 = (r & 1) ? bfhi(r < 2 ? xv[3].x : xv[3].y) : bflo(r < 2 ? xv[3].x : xv[3].y);
        const float xbr = c0.z + c1.x * x0 + c1.y * x1 + c1.z * x2 + c1.w * x3;
        const float rr = fsig(ar[r] + c0.x), ii = fsig(ai[r] + c0.y); const float la = -c0.w * rr; const float a = fexp(la);
        const float t2 = 2.0f * la; const float om = (t2 > -0.02f) ? -(t2 * (1.0f + t2 * (0.5f + t2 * (1.0f / 6.0f + t2 * (1.0f / 24.0f))))) : 1.0f - a * a;
        A[r] = a; H[r] = sqrtf(fmaxf(om, 0.f)) * (ii * xbr); }
#pragma unroll
    for (int d = 1; d < 16; d <<= 1) {
#pragma unroll
        for (int r = 0; r < 4; ++r) { const float Ap = dpp_shr(1.0f, A[r], d), Hp = dpp_shr(0.0f, H[r], d); H[r] = A[r] * Hp + H[r]; A[r] = A[r] * Ap; } }
    LAS float* WAGG = (LAS float*)(lds + L2_WAGG) + (ch & 1) * 256;
    if (fr == 15) { *(LAS f32x4*)(WAGG + w * 32 + 8 * fq) = (f32x4){A[0], H[0], A[1], H[1]}; *(LAS f32x4*)(WAGG + w * 32 + 8 * fq + 4) = (f32x4){A[2], H[2], A[3], H[3]}; }
    asm volatile("s_waitcnt vmcnt(0) lgkmcnt(0)" ::: "memory");
    __builtin_amdgcn_s_barrier(); asm volatile("" ::: "memory");
    float Awp[4], Hwp[4], At[4], Ht[4];
#pragma unroll
    for (int r = 0; r < 4; ++r) { Awp[r] = 1.f; Hwp[r] = 0.f; At[r] = 1.f; Ht[r] = 0.f; }
#pragma unroll
    for (int q = 0; q < 8; ++q) { const f32x4 v0 = *(const LAS f32x4*)(WAGG + q * 32 + 8 * fq), v1 = *(const LAS f32x4*)(WAGG + q * 32 + 8 * fq + 4);
        Ht[0] = v0.x * Ht[0] + v0.y; At[0] *= v0.x; Ht[1] = v0.z * Ht[1] + v0.w; At[1] *= v0.z; Ht[2] = v1.x * Ht[2] + v1.y; At[2] *= v1.x; Ht[3] = v1.z * Ht[3] + v1.w; At[3] *= v1.z;
        if (q + 1 == w) {
#pragma unroll
            for (int r = 0; r < 4; ++r) { Awp[r] = At[r]; Hwp[r] = Ht[r]; } } }
    float y[4]; const float g0 = bflo(byraw.x), g1 = bfhi(byraw.x), g2 = bflo(byraw.y), g3 = bfhi(byraw.y);
#pragma unroll
    for (int r = 0; r < 4; ++r) { const float Hs = Hwp[r] + Awp[r] * Hc[r]; const float h = H[r] + A[r] * Hs; Hc[r] = Ht[r] + At[r] * Hc[r];
        y[r] = h * fgelu(r == 0 ? g0 : r == 1 ? g1 : r == 2 ? g2 : g3); }
    u32x2 o; o.x = cvt_pk_bf16(y[0], y[1]); o.y = cvt_pk_bf16(y[2], y[3]);
    *(u32x2*)(X.yrow + ((size_t)ch * 128 + fr) * 2048 + 4 * fq) = o;
    byraw = bynext;
}
__device__ __forceinline__ void lru_seq_unit(const Frame& F, int l, int bl, int hd, int ct, const bf16* zh, bf16* yh) {
    LAS unsigned char* lds = F.lds; const int tid = F.tid, lane = F.lane, w = F.wave, fr = lane & 15, fq = lane >> 4;
    const float* cw = F.in[5] + (size_t)l * 4 * W_B + hd * 128; const float* cb = F.in[6] + (size_t)l * W_B + hd * 128;
    const float* wa = F.in[7] + ((size_t)l * 8 + hd) * 128 * 128 + 16 * ct; const float* wx = F.in[9] + ((size_t)l * 8 + hd) * 128 * 128 + 16 * ct;
    LAS float* CST = (LAS float*)(lds + L2_CST);
    const int ks0 = ct >> 1;
    const size_t tl0 = (size_t)bl * SEQ;
    __syncthreads();
    const char* zt = (const char*)(zh + tl0 * INC + C_BX + hd * 128) - (size_t)3 * INC * 2;
    { LAS unsigned char* dst = lds + L2_XT + w * 1024;
#pragma unroll
      for (int j = 0; j < 5; ++j) if (w + 8 * j < 35) { int p = 64 * (w + 8 * j) + lane; if (p > 131 * 17 - 1) p = 131 * 17 - 1; const int row = p / 17; int c = p - row * 17; if (c > 15) c = 15; c = (c + 4 * ks0) & 15;
          __builtin_amdgcn_global_load_lds((const unsigned*)(zt + (unsigned)((row < 3 ? 3 : row) * INC + c * 8) * 2u), (LAS unsigned*)(dst + j * 8192), 16, 0, 0); } }
#pragma unroll 2
    for (int idx = tid; idx < 4 * 16 * 128; idx += NTHR) { const int n = idx & 15, k = (idx >> 4) & 127, kk = idx >> 11; const float c_ = cw[kk * W_B + k];
        const int slot = ((k >> 5) - ks0) & 3, off = ((kk * 16 + n) * 136 + 32 * slot + (k & 31)) * 2;
        *(LAS bf16*)(lds + L2_WR + off) = f2bf(c_ * wa[k * 128 + n]); *(LAS bf16*)(lds + L2_WI + off) = f2bf(c_ * wx[k * 128 + n]); }
    { LAS float* PART = (LAS float*)(lds + L2_OT);
      const int o = tid & 31, part = tid >> 5, g = o >> 4, n = o & 15; const float* W = g ? wx : wa; float cbv[8], wv[8];
#pragma unroll
      for (int i = 0; i < 8; ++i) { cbv[i] = cb[8 * part + i]; wv[i] = W[(8 * part + i) * 128 + n]; }
      float a = 0.f;
#pragma unroll
      for (int i = 0; i < 8; ++i) a += cbv[i] * wv[i];
      PART[part * 32 + o] = a; }
    asm volatile("s_waitcnt vmcnt(0)" ::: "memory");
    if (w == 0 && lane < 51) *(LAS u32x4*)(lds + L2_XT + lane * 16) = (u32x4){0u, 0u, 0u, 0u};
    __syncthreads();
    if (tid < 32) { const int g = tid >> 4, n = tid & 15; float a = (g ? F.in[10] : F.in[8])[(size_t)l * W_B + hd * 128 + 16 * ct + n];
        const LAS float* PART = (const LAS float*)(lds + L2_OT);
#pragma unroll
        for (int q = 0; q < 16; ++q) a += PART[q * 32 + tid];
        CST[n * 8 + g] = a; }
    else if (tid < 48) { const int n = tid - 32, c = 16 * ct + n; CST[n * 8 + 2] = cb[c];
#pragma unroll
        for (int kk = 0; kk < 4; ++kk) CST[n * 8 + 4 + kk] = cw[kk * W_B + c];
        const float lam = F.in[11][(size_t)l * W_B + hd * 128 + c]; const float ex = __expf(-lam); const float sp = (-lam > 20.f) ? -lam : (ex < 0.05f ? ex * (1.0f - ex * (0.5f - ex * (0.33333333f - 0.25f * ex))) : __logf(1.0f + ex)); CST[n * 8 + 3] = 8.0f * sp; }
    __syncthreads();
    LruCtx X; X.w = w; X.fr = fr; X.fq = fq;
    X.yrow = yh + (tl0 + 16 * w) * 2048 + 512 + hd * 128 + 16 * ct;
    const char* zby = (const char*)(zh + (tl0 + 16 * w) * INC + C_BY + hd * 128);
    const unsigned loff8 = (unsigned)(fr * INC + 16 * ct + 4 * fq) * 2u;
    const unsigned xsub = (unsigned)(16 * (ct & 1) + 4 * fq) * 2u;
    unsigned doff[5];
#pragma unroll
    for (int j = 0; j < 5; ++j) { int p = 64 * (w + 8 * j) + lane; if (p > 131 * 17 - 1) p = 131 * 17 - 1; const int row = p / 17; int c = p - row * 17; if (c > 15) c = 15; c = (c + 4 * ks0) & 15; doff[j] = (unsigned)(row * INC + c * 8) * 2u; }
    bf16x8 Wr[4][4];
#pragma unroll
    for (int kk = 0; kk < 4; ++kk)
#pragma unroll
        for (int i = 0; i < 4; ++i) { const int off = ((kk * 16 + fr) * 136 + 32 * i + 8 * fq) * 2; Wr[kk][i] = *(const LAS bf16x8*)(lds + L2_WR + off); }
    u32x2 by = *(const u32x2*)(zby + loff8); float Hc[4] = {0.f, 0.f, 0.f, 0.f};
#pragma unroll 1
    for (int ch = 0; ch < 32; ++ch) { const int cn = ch + 1 < 32 ? ch + 1 : 31;
        lru_chunk(X, Wr, lds, by, ch, Hc, zt + (size_t)cn * 128 * INC * 2, doff, zby + (size_t)cn * 128 * INC * 2, loff8, xsub); }
    __syncthreads();
}
__device__ __forceinline__ void pool_item(const Frame& F, int l, int bl, int ch, int g, const bf16* zh, bf16* yh) {
    LAS unsigned char* lds = F.lds; const int tid = F.tid, lane = F.lane, w = F.wave, fr = lane & 15, fq = lane >> 4;
    const int s0 = ch * 128, W = 2 << g;
    for (int p = tid; p < 143 * 16; p += NTHR) { const int r = p >> 4, c16 = p & 15, s = s0 - 15 + r; u32x4 v = (u32x4){0u, 0u, 0u, 0u};
        if (s >= 0) v = *(const u32x4*)(zh + ((size_t)bl * SEQ + s) * INC + C_CU + g * 128 + c16 * 8);
        *(LAS u32x4*)(lds + L_CU + r * 272 + c16 * 16) = v; }
    __syncthreads();
    LAS unsigned char* pc = lds + L_PC + w * 4352;
    { const int cg = lane & 15, tq = lane >> 4, t0 = 16 * w + 4 * tq;
        float sum[8];
#pragma unroll
        for (int j = 0; j < 8; ++j) sum[j] = 0.f;
        for (int d = 0; d < W; ++d) { const u32x4 v = *(const LAS u32x4*)(lds + L_CU + (15 + t0 - d) * 272 + cg * 16);
            sum[0] += bflo(v.x); sum[1] += bfhi(v.x); sum[2] += bflo(v.y); sum[3] += bfhi(v.y); sum[4] += bflo(v.z); sum[5] += bfhi(v.z); sum[6] += bflo(v.w); sum[7] += bfhi(v.w); }
#pragma unroll
        for (int i = 0; i < 4; ++i) { const int tr = 15 + t0 + i; const u32x4 cur = *(const LAS u32x4*)(lds + L_CU + tr * 272 + cg * 16);
            if (i > 0) { const u32x4 old = *(const LAS u32x4*)(lds + L_CU + (tr - W) * 272 + cg * 16);
                sum[0] += bflo(cur.x) - bflo(old.x); sum[1] += bfhi(cur.x) - bfhi(old.x); sum[2] += bflo(cur.y) - bflo(old.y); sum[3] += bfhi(cur.y) - bfhi(old.y);
                sum[4] += bflo(cur.z) - bflo(old.z); sum[5] += bfhi(cur.z) - bfhi(old.z); sum[6] += bflo(cur.w) - bflo(old.w); sum[7] += bfhi(cur.w) - bfhi(old.w); }
            const int sp1 = s0 + t0 + i + 1; const float inv = 1.0f / (float)(sp1 < W ? sp1 : W);
            u32x4 o; o.x = cvt_pk_bf16(sum[0] * inv - bflo(cur.x), sum[1] * inv - bfhi(cur.x)); o.y = cvt_pk_bf16(sum[2] * inv - bflo(cur.y), sum[3] * inv - bfhi(cur.y));
            o.z = cvt_pk_bf16(sum[4] * inv - bflo(cur.z), sum[5] * inv - bfhi(cur.z)); o.w = cvt_pk_bf16(sum[6] * inv - bflo(cur.w), sum[7] * inv - bfhi(cur.w));
            *(LAS u32x4*)(pc + (4 * tq + i) * 272 + cg * 16) = o; } }
    LDS_WAIT();
    bf16x8 Af[4];
#pragma unroll
    for (int ks = 0; ks < 4; ++ks) Af[ks] = *(const LAS bf16x8*)(pc + fr * 272 + (32 * ks + 8 * fq) * 2);
    LDS_WAIT();
    const float* psc = F.in[14] + (size_t)l * W_C + g * 128;
#pragma unroll
    for (int ct = 0; ct < 8; ++ct) { f32x4 a = (f32x4){0.f, 0.f, 0.f, 0.f};
#pragma unroll
        for (int ks = 0; ks < 4; ++ks) a = __builtin_amdgcn_mfma_f32_16x16x32_bf16(Af[ks], *(const LAS bf16x8*)(lds + L_PW + (16 * ct + fr) * 272 + (32 * ks + 8 * fq) * 2), a, 0, 0, 0);
        const float sc = psc[16 * ct + fr];
#pragma unroll
        for (int r = 0; r < 4; ++r) *(LAS bf16*)(pc + (4 * fq + r) * 272 + (16 * ct + fr) * 2) = f2bf(a[r] * sc); }
    LDS_WAIT();
    const size_t tlw = (size_t)bl * SEQ + s0 + 16 * w;
#pragma unroll
    for (int i = 0; i < 4; ++i) { const int p = lane + 64 * i, tk = p >> 4, c16 = p & 15;
        *(u32x4*)(yh + (tlw + tk) * 2048 + 1536 + g * 128 + c16 * 8) = *(const LAS u32x4*)(pc + tk * 272 + c16 * 16); }
    __syncthreads();
}
__device__ __forceinline__ void conva_item(const Frame& F, int l, int bl, int ch, int part, const bf16* zh, bf16* yh) {
    const int cg = F.tid & 31, strip = F.tid >> 5, c0 = part * 256 + cg * 8, s0 = ch * 128 + strip * 8;
    const float* cw = F.in[3] + (size_t)l * 3 * W_A + c0;
    float w0[8], w1[8], w2[8];
#pragma unroll
    for (int j = 0; j < 8; ++j) { w0[j] = cw[j]; w1[j] = cw[W_A + j]; w2[j] = cw[2 * W_A + j]; }
    float u2[8], u1[8];
    const bf16* zb = zh + (size_t)bl * SEQ * INC;
#pragma unroll
    for (int q = 0; q < 2; ++q) { const int s = s0 - 2 + q; float* dst = q ? u1 : u2;
        if (s >= 0) { const u32x4 a = *(const u32x4*)(zb + (size_t)s * INC + C_AC + c0), b = *(const u32x4*)(zb + (size_t)s * INC + C_AX + c0);
            dst[0] = bflo(a.x) * bflo(b.x); dst[1] = bfhi(a.x) * bfhi(b.x); dst[2] = bflo(a.y) * bflo(b.y); dst[3] = bfhi(a.y) * bfhi(b.y);
            dst[4] = bflo(a.z) * bflo(b.z); dst[5] = bfhi(a.z) * bfhi(b.z); dst[6] = bflo(a.w) * bflo(b.w); dst[7] = bfhi(a.w) * bfhi(b.w); }
        else {
#pragma unroll
            for (int j = 0; j < 8; ++j) dst[j] = 0.f; } }
#pragma unroll
    for (int i = 0; i < 8; ++i) { const int s = s0 + i; const bf16* zr = zb + (size_t)s * INC;
        const u32x4 a = *(const u32x4*)(zr + C_AC + c0), b = *(const u32x4*)(zr + C_AX + c0), g = *(const u32x4*)(zr + C_AB + c0);
        float u0[8]; u0[0] = bflo(a.x) * bflo(b.x); u0[1] = bfhi(a.x) * bfhi(b.x); u0[2] = bflo(a.y) * bflo(b.y); u0[3] = bfhi(a.y) * bfhi(b.y);
        u0[4] = bflo(a.z) * bflo(b.z); u0[5] = bfhi(a.z) * bfhi(b.z); u0[6] = bflo(a.w) * bflo(b.w); u0[7] = bfhi(a.w) * bfhi(b.w);
        float gb[8]; gb[0] = bflo(g.x); gb[1] = bfhi(g.x); gb[2] = bflo(g.y); gb[3] = bfhi(g.y); gb[4] = bflo(g.z); gb[5] = bfhi(g.z); gb[6] = bflo(g.w); gb[7] = bfhi(g.w);
        float y[8];
#pragma unroll
        for (int j = 0; j < 8; ++j) { y[j] = gb[j] * (w0[j] * u2[j] + w1[j] * u1[j] + w2[j] * u0[j]); u2[j] = u1[j]; u1[j] = u0[j]; }
        u32x4 o; o.x = cvt_pk_bf16(y[0], y[1]); o.y = cvt_pk_bf16(y[2], y[3]); o.z = cvt_pk_bf16(y[4], y[5]); o.w = cvt_pk_bf16(y[6], y[7]);
        *(u32x4*)(yh + ((size_t)bl * SEQ + s) * 2048 + c0) = o; }
}
__device__ __forceinline__ void phase_p2(const Frame& F0, int l, const bf16* zh, bf16* yh) {
    Frame F = F0;
#define REFRESH_LANE() do { int l_; asm volatile("v_mbcnt_lo_u32_b32 %0, -1, 0\n\tv_mbcnt_hi_u32_b32 %0, -1, %0" : "=v"(l_)); F.lane = l_; F.tid = F.wave * 64 + l_; } while (0)
    REP(1024) { for (int it = F.c; it < 256; it += F.G) { const int hd = it & 7, ct = (it >> 3) & 7, bl = it >> 6; lru_seq_unit(F, l, bl, hd, ct, zh, yh); } }
    REFRESH_LANE();
    REP(2048) { int cur_g = -1;
    for (int it = F.c; it < 512; it += F.G) { const int g = it & 3, rest = it >> 2, bl = rest >> 5, ch = rest & 31;
        if (g != cur_g) { __syncthreads(); stage_pad128((const bf16*)(F.ws + WS_PLT) + (size_t)g * 128 * 128, F.lds + L_PW, F.tid); cur_g = g; }
        pool_item(F, l, bl, ch, g, zh, yh); } }
    REFRESH_LANE();
    REP(4096) { for (int it = F.c; it < 256; it += F.G) { const int part = it & 1, rest = it >> 1, bl = rest >> 5, ch = rest & 31; conva_item(F, l, bl, ch, part, zh, yh); } }
}

constexpr int NPHASE = 23;
__global__ void __launch_bounds__(NTHR, 2) mega_fwd(Args args) {
    extern __shared__ __attribute__((aligned(16))) unsigned char lds_raw[];
    Frame F; F.lds = (LAS unsigned char*)lds_raw; F.MISC = (volatile LAS unsigned*)(F.lds + MISC_OFF);
    const int wave_s = __builtin_amdgcn_readfirstlane((int)threadIdx.x >> 6);
    F.wave = wave_s; F.lane = (int)__builtin_amdgcn_mbcnt_hi(~0u, __builtin_amdgcn_mbcnt_lo(~0u, 0u)); F.tid = wave_s * 64 + F.lane; F.G = gridDim.x; F.c = blockIdx.x;
    F.in = args.in; F.out = args.out; F.ws = args.ws; F.ctl = (unsigned*)(args.ws + WS_CTL);
    for (int u = F.tid; u < (LDS_BYTES - MISC_OFF) / 4; u += NTHR) F.MISC[u] = 0u;
    __syncthreads();
    const int lo = args.ph_lo, hi = args.ph_hi;
    XcdBarrier bar; bar.bar = F.ctl + CW_BAR; bar.x = 0; bar.st = nullptr;
    if (hi - lo > 1) bar = xcd_barrier_post(F.ctl + CW_BAR, F.MISC + MW_BAR, F.tid == 0);
    int pid = 0;
#define PH_BEGIN if (pid >= lo && pid < hi) { { int c_ = (int)blockIdx.x; asm volatile("" : "+s"(c_)); F.c = c_; int l_; asm volatile("v_mbcnt_lo_u32_b32 %0, -1, 0\n\tv_mbcnt_hi_u32_b32 %0, -1, %0" : "=v"(l_)); F.lane = l_; F.wave = wave_s; F.tid = wave_s * 64 + l_; }
#define PH_END if (pid + 1 < hi) xcd_barrier(bar, F.tid == 0); } ++pid;
    bf16* zh = (bf16*)(F.ws + WS_ZH); bf16* yh = (bf16*)(F.ws + WS_YH); bf16* xb = (bf16*)(F.ws + WS_XB); bf16* mb = (bf16*)(F.ws + WS_MB);
    for (int l = 0; l < DEPTH; ++l) {
        PH_BEGIN REP(1) { phase_n1(F, l); __syncthreads(); } PH_END
        for (int hf = 0; hf < 2; ++hf) {
            PH_BEGIN { { ProbG1 p; p.S.init(TH, 4096, F.G, F.c, (DUP_MASK & 2) ? 2 : 1); p.A = (const char*)(xb + (size_t)hf * TH * D); p.B = (const char*)(F.ws + WS_WINT); p.O = zh; p.dummy = yh; pg8::gemm_phase(F.lds, p, F.tid); }
                       { ProbG1g p; p.S.init(TH, 3072, F.G, F.c, (DUP_MASK & 2) ? 2 : 1); p.A = (const char*)(F.ws + (hf ? WS_XB8B : WS_XB8A)); p.B = (const char*)(F.ws + WS_WING8); p.O = zh; pg8::gemm_phase(F.lds, p, F.tid); } } PH_END
            PH_BEGIN REP(8) { if (PH_MASK & 8) phase_p2(F, l, zh, yh); __syncthreads(); } PH_END
            PH_BEGIN { ProbG2 p; p.S.init(TH, D, F.G, F.c, (DUP_MASK & 16) ? 2 : 1); p.A = (const char*)yh; p.B = (const char*)(F.ws + WS_WCAT); p.zh = zh; p.O = mb + (size_t)hf * TH * D; pg8::gemm_phase(F.lds, p, F.tid); } PH_END
        }
        PH_BEGIN { ProbG3 p; p.S.init(T, D, F.G, F.c, (DUP_MASK & 32) ? 2 : 1); p.xdummy = (float*)(F.ws + WS_ZH); p.A = (const char*)mb; p.B = (const char*)(F.ws + WS_WOT); p.xin = (l == 0) ? F.in[0] : F.out; p.xout = F.out; pg8::gemm_phase(F.lds, p, F.tid); } PH_END
        PH_BEGIN REP(64) { phase_router(F, l, rep_); __syncthreads(); } PH_END
        PH_BEGIN { moe_panel_table(F, l); ProbMA p; p.MISC = F.MISC; p.rinfo = (const i32x4*)(F.ws + WS_RINFO); p.G = F.G; p.c = F.c; p.nsh = 3;
                   p.A = (const char*)xb; p.B = (const char*)(F.ws + WS_BAT); p.hid = (bf16*)(F.ws + WS_HID); pg8::gemm_phase(F.lds, p, F.tid); } PH_END
        PH_BEGIN { moe_panel_table(F, l); ProbMB p; p.xdummy = nullptr; p.MISC = F.MISC; p.rinfo = (const i32x4*)(F.ws + WS_RINFO); p.G = F.G; p.c = F.c; p.nsh = 2;
                   p.A = (const char*)(F.ws + WS_HID); p.B = (const char*)(F.ws + WS_W2T); p.x = F.out; pg8::gemm_phase(F.lds, p, F.tid); } PH_END
    }
    PH_BEGIN phase_final(F); PH_END
#undef PH_BEGIN
#undef PH_END
}
static void launch_mega(const Args& base, int lo, int hi, int grid, hipStream_t stream) {
    Args a = base; a.ph_lo = lo; a.ph_hi = hi;
    hipLaunchKernelGGL(mega_fwd, dim3(grid), dim3(NTHR), LDS_BYTES, stream, a);
}
extern "C" void kernel_launch(void* const* d_in, const int* in_sizes, int n_in, void* d_out, int out_size, void* d_ws, size_t ws_size, hipStream_t stream) {
    static int grid = 0;
    if (grid == 0) {
        if (n_in != 26 || out_size != T * D || ws_size < WS_END) { fprintf(stderr, "kernel_launch: unexpected shapes (n_in %d out %d ws %zu)\n", n_in, out_size, ws_size); grid = -1; return; }
        int dev = 0, cus = 0;
        if (hipGetDevice(&dev) != hipSuccess || hipDeviceGetAttribute(&cus, hipDeviceAttributeMultiprocessorCount, dev) != hipSuccess) { grid = -1; return; }
        if (hipFuncSetAttribute((const void*)mega_fwd, hipFuncAttributeMaxDynamicSharedMemorySize, LDS_BYTES) != hipSuccess) { fprintf(stderr, "kernel_launch: hipFuncSetAttribute failed\n"); grid = -1; return; }
        int per_cu = 0; (void)hipOccupancyMaxActiveBlocksPerMultiprocessor(&per_cu, (const void*)mega_fwd, NTHR, LDS_BYTES); (void)hipGetLastError();
        if (per_cu < 1) fprintf(stderr, "kernel_launch: occupancy query says %d blocks per CU\n", per_cu);
        grid = cus;
    }
    if (grid < 0) return;
    (void)hipMemsetAsync((char*)d_ws + WS_CTL, 0, CTL_BYTES, stream);
    Args a{};
    for (int i = 0; i < 26; ++i) a.in[i] = (const float*)d_in[i];
    a.out = (float*)d_out; a.ws = (unsigned char*)d_ws; a.ph_lo = 0; a.ph_hi = 0;
#if ONE_LAUNCH
    launch_mega(a, 0, NPHASE, grid, stream);
#else
    for (int ph = 0; ph < NPHASE; ++ph) launch_mega(a, ph, ph + 1, grid, stream);
#endif
}
```

```cpp
#include <hip/hip_runtime.h>
#include <stdint.h>
#include <stdio.h>

#ifndef ONE_LAUNCH
#define ONE_LAUNCH 1
#endif
#ifndef PH_MASK
#define PH_MASK 1023
#endif
#ifndef DUP_MASK
#define DUP_MASK 0
#endif
#define REP(bit) for (int rep_ = 0; rep_ < ((DUP_MASK & (bit)) ? 2 : 1); ++rep_)

#define LAS __attribute__((address_space(3)))
typedef unsigned short bf16;
typedef short bf16x8 __attribute__((ext_vector_type(8)));
typedef float f32x4 __attribute__((ext_vector_type(4)));
typedef float f32x2 __attribute__((ext_vector_type(2)));
typedef unsigned u32x4 __attribute__((ext_vector_type(4)));
typedef unsigned u32x2 __attribute__((ext_vector_type(2)));
typedef int i32x4 __attribute__((ext_vector_type(4)));
typedef int i32x8 __attribute__((ext_vector_type(8)));

constexpr int D = 1024, BATCH = 8, SEQ = 4096, T = BATCH * SEQ, DEPTH = 2;
constexpr int W_A = 512, W_B = 1024, W_C = 512, INC = 7168;
constexpr int C_AB = 0, C_AC = 512, C_AX = 1024, C_BX = 1536, C_BY = 2560, C_CU = 3584, C_GA = 4096, C_GB = 5120, C_GC = 6144;
constexpr int TH = T / 2;
constexpr int NG = 4, EPG = 4, NE = 16, DE = 512, NCLS = 24, CAP = 32768;
constexpr float EPS = 1e-6f;
constexpr int NWAVES = 8, NTHR = 512;

constexpr size_t MiB = 1u << 20;
constexpr size_t WS_CTL = 0, CTL_BYTES = 1 * MiB;
constexpr size_t WS_WINT = 1 * MiB;
constexpr size_t WS_WCAT = WS_WINT + 14 * MiB;
constexpr size_t WS_WOT = WS_WCAT + 4 * MiB;
constexpr size_t WS_BAT = WS_WOT + 2 * MiB;
constexpr size_t WS_W2T = WS_BAT + 32 * MiB;
constexpr size_t WS_WAT = WS_W2T + 16 * MiB;
constexpr size_t WS_WXT = WS_WAT + 256 * 1024;
constexpr size_t WS_PLT = WS_WXT + 256 * 1024;
constexpr size_t WS_XB = 71 * MiB;
constexpr size_t WS_ZH = 135 * MiB;
constexpr size_t WS_YH = 359 * MiB;
constexpr size_t WS_MB = 423 * MiB;
constexpr size_t WS_CAR = 487 * MiB;
constexpr size_t WS_END = 504 * MiB;
constexpr size_t WS_WING8 = WS_WINT + (size_t)4096 * 1024 * 2;
constexpr size_t WS_XB8A = WS_BAT + 16 * MiB, WS_XB8B = 487 * MiB;
constexpr size_t WS_HID = WS_ZH;
constexpr size_t WS_RINFO = WS_ZH + 96 * MiB;
static_assert(WS_PLT + 128 * 1024 <= WS_XB, "weights fit");
constexpr int CW_BAR = 4096;
constexpr int CW_CNT = 16384;

constexpr int RING_BYTES = 131072, LDS_BYTES = 163840, MISC_OFF = LDS_BYTES - 2048;
constexpr int MW_BAR = 8, MW_CNT = 16, MW_NPAN = 44, MW_PT = 48, MW_SCR = 256;

__device__ __forceinline__ float bf2f(bf16 v) { return __uint_as_float(((unsigned)v) << 16); }
__device__ __forceinline__ float bflo(unsigned w) { return __uint_as_float(w << 16); }
__device__ __forceinline__ float bfhi(unsigned w) { return __uint_as_float(w & 0xffff0000u); }
__device__ __forceinline__ bf16 f2bf(float f) { unsigned u = __float_as_uint(f); return (bf16)((u + 0x7fffu + ((u >> 16) & 1u)) >> 16); }
__device__ __forceinline__ unsigned cvt_pk_bf16(float lo, float hi) { unsigned r; asm volatile("v_cvt_pk_bf16_f32 %0, %1, %2" : "=v"(r) : "v"(lo), "v"(hi)); return r; }
__device__ __forceinline__ float dpp_mov(float v, int ctrl_sel) {
    int r; const int x = __builtin_bit_cast(int, v);
    switch (ctrl_sel) { case 0: r = __builtin_amdgcn_update_dpp(0, x, 0xB1, 0xf, 0xf, true); break;
                        case 1: r = __builtin_amdgcn_update_dpp(0, x, 0x4E, 0xf, 0xf, true); break;
                        case 2: r = __builtin_amdgcn_update_dpp(0, x, 0x141, 0xf, 0xf, true); break;
                        default: r = __builtin_amdgcn_update_dpp(0, x, 0x140, 0xf, 0xf, true); break; }
    return __builtin_bit_cast(float, r);
}
__device__ __forceinline__ float wave_sum(float v) {
    v += dpp_mov(v, 0); v += dpp_mov(v, 1); v += dpp_mov(v, 2); v += dpp_mov(v, 3);
    const int x = __builtin_bit_cast(int, v);
    return (__builtin_bit_cast(float, __builtin_amdgcn_readlane(x, 0)) + __builtin_bit_cast(float, __builtin_amdgcn_readlane(x, 16)))
         + (__builtin_bit_cast(float, __builtin_amdgcn_readlane(x, 32)) + __builtin_bit_cast(float, __builtin_amdgcn_readlane(x, 48)));
}
__device__ __forceinline__ float fexp(float x) { return __builtin_amdgcn_exp2f(x * 1.4426950408889634f); }
__device__ __forceinline__ float frcp(float x) { return __builtin_amdgcn_rcpf(x); }
__device__ __forceinline__ float sigmoidf_(float x) { return 1.0f / (1.0f + __expf(-x)); }
__device__ __forceinline__ float fsig(float x) { return frcp(1.0f + __builtin_amdgcn_exp2f(x * -1.4426950408889634f)); }
__device__ __forceinline__ float gelu_tanh(float x) { const float u = 0.7978845608028654f * (x + 0.044715f * x * x * x); return 0.5f * x * (1.0f + tanhf(u)); }
__device__ __forceinline__ float fgelu(float x) { const float u = 1.5957691216057308f * (x + 0.044715f * x * x * x); return x * fsig(u); }
#define LDS_WAIT() asm volatile("s_waitcnt lgkmcnt(0)" ::: "memory")
#define VM_WAIT() asm volatile("s_waitcnt vmcnt(0)" ::: "memory")

#define XB_TMO      128
#define XB_XCNT(j)  (256  + 64 * (j))
#define XB_XSUB(j)  (1280 + 64 * (j))
#define XB_XGEN(j)  (2304 + 64 * (j))
#define XB_TOP      3328
#define XB_TOPGEN   3392
#define XCD_BAR_WORDS 3456
#define XB_SPIN_CAP (1u << 20)
__device__ __forceinline__ unsigned xb_ld(unsigned* p)              { return __hip_atomic_load(p, __ATOMIC_RELAXED, __HIP_MEMORY_SCOPE_AGENT); }
__device__ __forceinline__ unsigned xb_add(unsigned* p, unsigned v) { return __hip_atomic_fetch_add(p, v, __ATOMIC_RELAXED, __HIP_MEMORY_SCOPE_AGENT); }
__device__ __forceinline__ unsigned xb_xcc_id() { return (unsigned)__builtin_amdgcn_s_getreg((3 << 11) | 20) & 0xFu; }
#define XB_SPIN(cond, bar) do { unsigned _sp = 0; while (cond) { __builtin_amdgcn_s_sleep(1); \
    if ((++_sp & 255u) == 0u) { if (xb_ld(&(bar)[XB_TMO])) break; if (_sp > XB_SPIN_CAP) { atomicAdd(&(bar)[XB_TMO], 1u); break; } } } } while (0)
struct XcdBarrier { unsigned* bar; unsigned x; volatile LAS unsigned* st; };
__device__ __forceinline__ XcdBarrier xcd_barrier_post(unsigned* bar, volatile LAS unsigned* st, bool is0) {
    XcdBarrier b; b.bar = bar; b.x = xb_xcc_id(); b.st = st;
    if (is0) (void)xb_add(&bar[XB_XCNT(b.x)], 1u);
    return b;
}
__device__ __forceinline__ void xcd_barrier_complete(unsigned* bar, unsigned x, unsigned& nloc, unsigned& nx) {
    const unsigned G = gridDim.x * gridDim.y * gridDim.z;
    unsigned sum, cnt, mine, sp = 0u;
    for (;;) {
        sum = 0u; cnt = 0u; mine = 0u;
#pragma unroll
        for (unsigned j = 0; j < 16; ++j) { const unsigned c = xb_ld(&bar[XB_XCNT(j)]); sum += c; cnt += (c > 0u) ? 1u : 0u; mine = (j == x) ? c : mine; }
        if (sum == G) break;
        __builtin_amdgcn_s_sleep(1);
        if ((++sp & 255u) == 0u) { if (xb_ld(&bar[XB_TMO])) break; if (sp > XB_SPIN_CAP) { atomicAdd(&bar[XB_TMO], 1u); break; } }
    }
    nloc = mine > 0u ? mine : 1u; nx = cnt > 0u ? cnt : 1u;
}
__device__ __forceinline__ void xcd_barrier(const XcdBarrier& b, bool is0) {
    asm volatile("s_waitcnt vmcnt(0)" ::: "memory");
    __syncthreads();
    if (is0) {
        unsigned* bar = b.bar;
        __builtin_amdgcn_s_waitcnt(0);
        unsigned nloc = b.st[0], nx = b.st[1];
        if (nloc == 0u) { xcd_barrier_complete(bar, b.x, nloc, nx); b.st[0] = nloc; b.st[1] = nx; }
        const unsigned old = xb_add(&bar[XB_XSUB(b.x)], 1u);
        const unsigned gen = old / nloc;
        if (old + 1u == (gen + 1u) * nloc) {
            __builtin_amdgcn_fence(__ATOMIC_RELEASE, "agent");
            asm volatile("s_waitcnt vmcnt(0)" ::: "memory");
            const unsigned og = xb_add(&bar[XB_TOP], 1u);
            const unsigned tg = og / nx;
            if (og + 1u == (tg + 1u) * nx) xb_add(&bar[XB_TOPGEN], 1u);
            else XB_SPIN(xb_ld(&bar[XB_TOPGEN]) == tg, bar);
            __builtin_amdgcn_fence(__ATOMIC_ACQUIRE, "agent");
            xb_add(&bar[XB_XGEN(b.x)], 1u);
            asm volatile("s_waitcnt vmcnt(0)" ::: "memory");
        } else {
            XB_SPIN(xb_ld(&bar[XB_XGEN(b.x)]) == gen, bar);
            __builtin_amdgcn_fence(__ATOMIC_ACQUIRE, "agent");
            asm volatile("s_waitcnt vmcnt(0)" ::: "memory");
        }
    }
    __syncthreads();
}

namespace pg8 {
constexpr int BM = 256, BK = 64, HALF = 128, HTB = HALF * BK * 2, STAGE_BYTES = 8 * HTB, NXCD = 8, WGM = 8;
__host__ __device__ __forceinline__ int lds_byte(int r, int c) { const int st = (r >> 4) * 2 + (c >> 5), rr = r & 15, cc = c & 31, ob = rr * 64 + cc * 2; return st * 1024 + (ob ^ (((ob >> 9) & 1) << 5)); }
__host__ __device__ __forceinline__ void stage_rc(int b, int& R, int& C) { const int st = b / 1024, sb = b % 1024, swz = sb ^ (((sb >> 9) & 1) << 5); R = (st >> 1) * 16 + swz / 64; C = (st & 1) * 32 + (swz % 64) / 2; }
__host__ __device__ __forceinline__ int perm32(int rho) { const int n = rho >> 4, i = rho & 15; return 8 * (i >> 2) + 4 * n + (i & 3); }
struct Unit { int pm, pn, rep; };
struct StaticOrder {
    int nM, nN, nwg, G, c, dupf;
    __host__ __device__ void init(int M, int N, int G_, int c_, int dupf_ = 1) { nM = M / BM; nN = N / BM; nwg = nM * nN; G = G_; c = c_; dupf = dupf_; }
    __host__ __device__ bool next(int i, Unit& u) const {
        const long L0 = (long)i * G + c; if (L0 >= (long)nwg * dupf) return false; const long L = L0 % nwg; u.rep = (int)(L0 / nwg);
        int wgid = (int)L; { const int q = nwg / NXCD, r = nwg % NXCD, xcd = wgid % NXCD, off = wgid / NXCD; wgid = (xcd < r ? xcd * (q + 1) : r * (q + 1) + (xcd - r) * q) + off; }
        const int nig = WGM * nN, gid = wgid / nig, fm = gid * WGM, gsz = (nM - fm) < WGM ? (nM - fm) : WGM;
        u.pm = fm + ((wgid % nig) % gsz); u.pn = (wgid % nig) / gsz; return true;
    }
};
template <class P>
__device__ __forceinline__ void gemm_phase(LAS unsigned char* lds, const P& p, const int tid) {
    const int wid = __builtin_amdgcn_readfirstlane(tid >> 6), lane = tid & 63, wr = wid >> 2, wc = wid & 3, fr = lane & 15, fq = lane >> 4;
    constexpr int nt = P::NT, lda = P::LDA, ldb = P::LDB;
    unsigned voffA[2], voffB[2]; int Rr[2], Cc[2];
#pragma unroll
    for (int i = 0; i < 2; ++i) { int R, C; stage_rc(tid * 16 + i * 8192, R, C); const int Rb = P::PERM ? ((R & ~31) + perm32(R & 31)) : R;
        voffA[i] = (unsigned)(R * lda + C) * 2u; voffB[i] = (unsigned)(Rb * ldb + C) * 2u; Rr[i] = R; Cc[i] = C; }
    constexpr size_t kstep = (size_t)(BK * 2), hstepA = (size_t)HALF * lda * 2, hstepB = (size_t)HALF * ldb * 2;
    const unsigned ldsw = (unsigned)wid * 1024u;
    const int aoff = lds_byte(wr * 64 + fr, fq * 8), boff = lds_byte(wc * 32 + fr, fq * 8);
#define PG8_SA(b, h) (((b) * 2 + (h)) * HTB)
#define PG8_SB(b, h) ((4 + (b) * 2 + (h)) * HTB)
#define PG8_GL(gp, off) __builtin_amdgcn_global_load_lds((const unsigned*)(gp), (LAS unsigned*)(lds + (off)), 16, 0, 0)
#define PG8_STAGE_B(bufoff, base, h) do { PG8_GL((base) + (h) * hstepB + voffB[0], (bufoff) + ldsw); PG8_GL((base) + (h) * hstepB + voffB[1], (bufoff) + ldsw + 8192); } while (0)
#define PG8_STAGE_A(bufoff, base, h, ro) do { if constexpr (P::GATHER) { PG8_GL((base) + ro[h][0], (bufoff) + ldsw); PG8_GL((base) + ro[h][1], (bufoff) + ldsw + 8192); } \
        else { PG8_GL((base) + (h) * hstepA + voffA[0], (bufoff) + ldsw); PG8_GL((base) + (h) * hstepA + voffA[1], (bufoff) + ldsw + 8192); } } while (0)
#define PG8_LDA(dst, b, h) do { if constexpr (P::F8) { _Pragma("unroll") for (int m = 0; m < 4; ++m) { const i32x4 lo_ = *(const LAS i32x4*)(lds + PG8_SA(b, h) + aoff + m * 2048), hi_ = *(const LAS i32x4*)(lds + PG8_SA(b, h) + aoff + m * 2048 + 1024); \
            dst##8[m] = __builtin_shufflevector(lo_, hi_, 0, 1, 2, 3, 4, 5, 6, 7); } } \
        else { _Pragma("unroll") for (int m = 0; m < 4; ++m) _Pragma("unroll") for (int k = 0; k < 2; ++k) dst[m][k] = *(const LAS bf16x8*)(lds + PG8_SA(b, h) + aoff + m * 2048 + k * 1024); } } while (0)
#define PG8_LDB(dst, b, h) do { if constexpr (P::F8) { _Pragma("unroll") for (int n = 0; n < 2; ++n) { const i32x4 lo_ = *(const LAS i32x4*)(lds + PG8_SB(b, h) + boff + n * 2048), hi_ = *(const LAS i32x4*)(lds + PG8_SB(b, h) + boff + n * 2048 + 1024); \
            dst##8[n] = __builtin_shufflevector(lo_, hi_, 0, 1, 2, 3, 4, 5, 6, 7); } } \
        else { _Pragma("unroll") for (int n = 0; n < 2; ++n) _Pragma("unroll") for (int k = 0; k < 2; ++k) dst[n][k] = *(const LAS bf16x8*)(lds + PG8_SB(b, h) + boff + n * 2048 + k * 1024); } } while (0)
#define PG8_MMA(ai, bj, At, Bt) do { __builtin_amdgcn_s_setprio(1); \
        if constexpr (P::F8) { _Pragma("unroll") for (int m = 0; m < 4; ++m) _Pragma("unroll") for (int n = 0; n < 2; ++n) \
            acc[ai][bj][m][n] = __builtin_amdgcn_mfma_scale_f32_16x16x128_f8f6f4(Bt##8[n], At##8[m], acc[ai][bj][m][n], 0, 0, 0, P::SCALE_B, 0, P::SCALE_A); } \
        else { _Pragma("unroll") for (int m = 0; m < 4; ++m) _Pragma("unroll") for (int n = 0; n < 2; ++n) _Pragma("unroll") for (int k = 0; k < 2; ++k) \
            acc[ai][bj][m][n] = __builtin_amdgcn_mfma_f32_16x16x32_bf16(Bt[n][k], At[m][k], acc[ai][bj][m][n], 0, 0, 0); } \
        __builtin_amdgcn_s_setprio(0); } while (0)
#define PG8_WAIT_V(n) asm volatile("s_waitcnt vmcnt(" #n ")" ::: "memory")
#define PG8_WAIT_L(n) asm volatile("s_waitcnt lgkmcnt(" #n ")" ::: "memory")
#define PG8_BAR __builtin_amdgcn_s_barrier()
#define PG8_SCHED __builtin_amdgcn_sched_barrier(0)
    Unit cur, nxt; int ui = 0;
    if (!p.next(0, cur)) return;
    f32x4 acc[2][2][4][2];
#pragma unroll
    for (int a = 0; a < 2; ++a)
#pragma unroll
        for (int b = 0; b < 2; ++b)
#pragma unroll
            for (int m = 0; m < 4; ++m)
#pragma unroll
                for (int n = 0; n < 2; ++n) acc[a][b][m][n] = (f32x4){0.f, 0.f, 0.f, 0.f};
    bf16x8 At[4][2], B0[2][2], B1[2][2]; i32x8 At8[4], B08[2], B18[2];
    unsigned roC[2][2] = {{0u, 0u}, {0u, 0u}};
    const char* cA; const char* cB = p.b_base(cur); long bdC = p.b_delta(cur);
    if constexpr (P::GATHER) { cA = p.a_gbase(); p.a_rows(cur, Rr, Cc, roC); } else { cA = p.a_base(cur); }
    PG8_STAGE_B(PG8_SB(0, 0), cB, 0); PG8_STAGE_B(PG8_SB(0, 1), cB, 1); PG8_STAGE_A(PG8_SA(0, 0), cA, 0, roC); PG8_STAGE_A(PG8_SA(0, 1), cA, 1, roC);
    if (wr == 1) PG8_BAR;
    PG8_WAIT_V(2); PG8_BAR;
    PG8_STAGE_B(PG8_SB(1, 0), cB + kstep, 0); PG8_STAGE_A(PG8_SA(1, 0), cA + kstep, 0, roC); PG8_STAGE_B(PG8_SB(1, 1), cB + kstep, 1);
    PG8_WAIT_V(6); PG8_BAR;
    for (;;) {
        const bool has_next = p.next(ui + 1, nxt);
        const char* nA = cA; const char* nB = cB; long bdN = bdC;
        if (has_next) { nB = p.b_base(nxt); bdN = p.b_delta(nxt); if constexpr (!P::GATHER) { nA = p.a_base(nxt); } }
#pragma unroll 1
        for (int t = 0; t < nt; t += 2) {
            const bool last = (t == nt - 2);
            if constexpr (P::HAS_MID) { if (t == P::MID0 || t == P::MID1) p.mid(acc, cur, t, wr, wc, fr, fq); }
            const char* a1 = cA + (size_t)(t + 1) * kstep;
            const char* a2 = last ? nA : cA + (size_t)(t + 2) * kstep;
            const char* b2 = last ? nB : cB + (size_t)(t + 2) * kstep + ((t + 2) >= P::BSEG ? bdC : 0l);
            const char* a3 = a2 + kstep; const char* b3 = b2 + kstep;
            PG8_LDB(B0, 0, 0); PG8_LDB(B1, 0, 1); PG8_SCHED; PG8_LDA(At, 0, 0); PG8_STAGE_A(PG8_SA(1, 1), a1, 1, roC);
            if constexpr (P::GATHER) { if (last && has_next) p.a_rows(nxt, Rr, Cc, roC); }
            PG8_WAIT_V(8); PG8_WAIT_L(0); PG8_BAR; PG8_MMA(0, 0, At, B0); PG8_MMA(0, 1, At, B1); PG8_BAR; PG8_SCHED;
            PG8_LDA(At, 0, 1); PG8_STAGE_B(PG8_SB(0, 0), b2, 0); PG8_STAGE_B(PG8_SB(0, 1), b2, 1); PG8_STAGE_A(PG8_SA(0, 0), a2, 0, roC);
            PG8_WAIT_V(8); PG8_WAIT_L(0); PG8_BAR; PG8_MMA(1, 0, At, B0); PG8_MMA(1, 1, At, B1); PG8_BAR; PG8_SCHED;
            PG8_LDB(B0, 1, 0); PG8_LDB(B1, 1, 1); PG8_SCHED; PG8_LDA(At, 1, 0); PG8_STAGE_A(PG8_SA(0, 1), a2, 1, roC);
            PG8_WAIT_V(8); PG8_WAIT_L(0); PG8_BAR; PG8_MMA(0, 0, At, B0); PG8_MMA(0, 1, At, B1); PG8_BAR; PG8_SCHED;
            PG8_LDA(At, 1, 1); PG8_STAGE_B(PG8_SB(1, 0), b3, 0); PG8_STAGE_B(PG8_SB(1, 1), b3, 1); PG8_STAGE_A(PG8_SA(1, 0), a3, 0, roC);
            PG8_WAIT_V(8); PG8_WAIT_L(0); PG8_BAR; PG8_MMA(1, 0, At, B0); PG8_MMA(1, 1, At, B1); PG8_BAR; PG8_SCHED;
        }
        if constexpr (P::ALIGN) { if (wr == 0) PG8_BAR; }
        p.epi(acc, cur, wr, wc, fr, fq);
        if (!has_next) break;
#pragma unroll
        for (int a = 0; a < 2; ++a)
#pragma unroll
            for (int b = 0; b < 2; ++b)
#pragma unroll
                for (int m = 0; m < 4; ++m)
#pragma unroll
                    for (int n = 0; n < 2; ++n) acc[a][b][m][n] = (f32x4){0.f, 0.f, 0.f, 0.f};
        cur = nxt; cA = nA; cB = nB; bdC = bdN; ++ui;
        if constexpr (P::ALIGN) { if (wr == 1) PG8_BAR; }
    }
    PG8_WAIT_V(0);
    if constexpr (!P::ALIGN) { if (wr == 0) PG8_BAR; }
    PG8_BAR;
#undef PG8_SA
#undef PG8_SB
#undef PG8_GL
#undef PG8_STAGE_A
#undef PG8_STAGE_B
#undef PG8_LDA
#undef PG8_LDB
#undef PG8_MMA
#undef PG8_WAIT_V
#undef PG8_WAIT_L
#undef PG8_BAR
#undef PG8_SCHED
}
}
using pg8::Unit;
typedef f32x4 AccT[2][2][4][2];

struct Args { const float* in[26]; float* out; unsigned char* ws; int ph_lo, ph_hi; };
struct Frame {
    LAS unsigned char* lds; volatile LAS unsigned* MISC; unsigned* ctl;
    int tid, lane, wave, G, c;
    const float* const* in; float* out; unsigned char* ws;
};

struct DenseBase {
    static constexpr bool GATHER = false, HAS_MID = false, F8 = false; static constexpr int SCALE_A = 0x7F7F7F7F, SCALE_B = 0x7F7F7F7F; static constexpr int MID0 = -1, MID1 = -1, BSEG = 1 << 20;
    pg8::StaticOrder S;
    __device__ __forceinline__ bool next(int i, Unit& u) const { return S.next(i, u); }
    __device__ __forceinline__ long b_delta(const Unit&) const { return 0l; }
    __device__ __forceinline__ const char* a_gbase() const { return nullptr; }
    __device__ __forceinline__ void a_rows(const Unit&, const int (&)[2], const int (&)[2], unsigned (&)[2][2]) const {}
    __device__ __forceinline__ void mid(AccT&, const Unit&, int, int, int, int, int) const {}
};
struct ProbG1 : DenseBase {
    static constexpr int NT = 16, LDA = 1024, LDB = 1024; static constexpr bool PERM = true, ALIGN = true;
    const char* A; const char* B; bf16* O; bf16* dummy;
    __device__ __forceinline__ const char* a_base(const Unit& u) const { return A + (size_t)u.pm * 256 * LDA * 2; }
    __device__ __forceinline__ const char* b_base(const Unit& u) const { return B + (size_t)u.pn * 256 * LDB * 2; }
    __device__ __forceinline__ void epi(AccT& acc, const Unit& u, int wr, int wc, int fr, int fq) const {
        int row0 = u.pm * 256 + wr * 64 + fr; const int col0 = u.pn * 256 + wc * 32 + 8 * fq; asm volatile("" : "+v"(row0));
#pragma unroll
        for (int ai = 0; ai < 2; ++ai)
#pragma unroll
            for (int m = 0; m < 4; ++m) { bf16* rowp = O + (size_t)(row0 + ai * 128 + m * 16) * INC + col0;
#pragma unroll
                for (int bj = 0; bj < 2; ++bj) { const f32x4 v0 = acc[ai][bj][m][0], v1 = acc[ai][bj][m][1];
                    u32x4 w; w.x = cvt_pk_bf16(v0[0], v0[1]); w.y = cvt_pk_bf16(v0[2], v0[3]); w.z = cvt_pk_bf16(v1[0], v1[1]); w.w = cvt_pk_bf16(v1[2], v1[3]);
                    *(u32x4*)(rowp + bj * 128) = w;
                    if (DUP_MASK & 8192) { const size_t off = ((size_t)((rowp + bj * 128) - O) * 2) & (size_t)(64 * MiB - 16); *(u32x4*)((char*)dummy + off) = w; } } }
    }
};
struct ProbG1g : DenseBase {
    static constexpr int NT = 8, LDA = 512, LDB = 512, SCALE_A = 0x7C7C7C7C, SCALE_B = 0x7C7C7C7C; static constexpr bool PERM = true, ALIGN = true, F8 = true, GATHER = true;
    const char* A; const char* B; bf16* O;
    __device__ __forceinline__ const char* a_gbase() const { return A; }
    __device__ __forceinline__ void a_rows(const Unit& u, const int (&R)[2], const int (&C)[2], unsigned (&ro)[2][2]) const {
#pragma unroll
        for (int h = 0; h < 2; ++h)
#pragma unroll
            for (int i = 0; i < 2; ++i) ro[h][i] = (unsigned)((u.pm * 256 + h * 128 + R[i]) * LDA + C[i]) * 2u; }
    __device__ __forceinline__ const char* a_base(const Unit& u) const { return A + (size_t)u.pm * 256 * LDA * 2; }
    __device__ __forceinline__ const char* b_base(const Unit& u) const { return B + (size_t)u.pn * 256 * LDB * 2; }
    __device__ __forceinline__ void epi(AccT& acc, const Unit& u, int wr, int wc, int fr, int fq) const {
        int row0 = u.pm * 256 + wr * 64 + fr; const int col0 = 4096 + u.pn * 256 + wc * 32 + 8 * fq; asm volatile("" : "+v"(row0));
#pragma unroll
        for (int ai = 0; ai < 2; ++ai)
#pragma unroll
            for (int m = 0; m < 4; ++m) { bf16* rowp = O + (size_t)(row0 + ai * 128 + m * 16) * INC + col0;
#pragma unroll
                for (int bj = 0; bj < 2; ++bj) { const f32x4 v0 = acc[ai][bj][m][0], v1 = acc[ai][bj][m][1];
                    u32x4 w; w.x = cvt_pk_bf16(v0[0], v0[1]); w.y = cvt_pk_bf16(v0[2], v0[3]); w.z = cvt_pk_bf16(v1[0], v1[1]); w.w = cvt_pk_bf16(v1[2], v1[3]);
                    *(u32x4*)(rowp + bj * 128) = w; } }
    }
};
struct ProbG2 : DenseBase {
    static constexpr int NT = 32, LDA = 2048, LDB = 2048, MID0 = 8, MID1 = 24; static constexpr bool PERM = true, ALIGN = false, HAS_MID = true;
    const char* A; const char* B; const bf16* zh; bf16* O;
    __device__ __forceinline__ const char* a_base(const Unit& u) const { return A + (size_t)u.pm * 256 * LDA * 2; }
    __device__ __forceinline__ const char* b_base(const Unit& u) const { return B + (size_t)u.pn * 256 * LDB * 2; }
    __device__ __forceinline__ void mid(AccT& acc, const Unit& u, int t, int wr, int wc, int fr, int fq) const {
        const int cn = (t == MID0) ? C_GA : C_GB;
        int row0 = u.pm * 256 + wr * 64 + fr; const int col0 = u.pn * 256 + wc * 32 + 8 * fq; asm volatile("" : "+v"(row0));
        u32x4 va[2][2][2], vb[2][2][2];
#define G2_LOAD(q, buf) do { _Pragma("unroll") for (int mm = 0; mm < 2; ++mm) { const bf16* zr = zh + (size_t)(row0 + ((q) >> 1) * 128 + (2 * ((q) & 1) + mm) * 16) * INC + col0 + cn; \
            _Pragma("unroll") for (int bj = 0; bj < 2; ++bj) { va[buf][mm][bj] = *(const u32x4*)(zr + bj * 128); vb[buf][mm][bj] = *(const u32x4*)(zr + 1024 + bj * 128); } } } while (0)
#define G2_APPLY(q, buf) do { _Pragma("unroll") for (int mm = 0; mm < 2; ++mm) _Pragma("unroll") for (int bj = 0; bj < 2; ++bj) _Pragma("unroll") for (int e = 0; e < 4; ++e) { \
            const unsigned wa = va[buf][mm][bj][e], wb = vb[buf][mm][bj][e]; const float L2E = -1.4426950408889634f; \
            const float r0 = (1.0f + __builtin_amdgcn_exp2f(bflo(wb) * L2E)) * frcp(1.0f + __builtin_amdgcn_exp2f(bflo(wa) * L2E)), r1 = (1.0f + __builtin_amdgcn_exp2f(bfhi(wb) * L2E)) * frcp(1.0f + __builtin_amdgcn_exp2f(bfhi(wa) * L2E)); \
            acc[(q) >> 1][bj][2 * ((q) & 1) + mm][e >> 1][(e & 1) * 2] *= r0; acc[(q) >> 1][bj][2 * ((q) & 1) + mm][e >> 1][(e & 1) * 2 + 1] *= r1; } } while (0)
        G2_LOAD(0, 0); G2_LOAD(1, 1); asm volatile("" ::: "memory");
        G2_APPLY(0, 0); G2_LOAD(2, 0); asm volatile("" ::: "memory");
        G2_APPLY(1, 1); G2_LOAD(3, 1); asm volatile("" ::: "memory");
        G2_APPLY(2, 0); G2_APPLY(3, 1);
#undef G2_LOAD
#undef G2_APPLY
    }
    __device__ __forceinline__ void epi(AccT& acc, const Unit& u, int wr, int wc, int fr, int fq) const {
        int row0 = u.pm * 256 + wr * 64 + fr; const int col0 = u.pn * 256 + wc * 32 + 8 * fq; asm volatile("" : "+v"(row0));
#pragma unroll
        for (int ai = 0; ai < 2; ++ai) {
            u32x4 vc[4][2];
#pragma unroll
            for (int m = 0; m < 4; ++m) { const bf16* zr = zh + (size_t)(row0 + ai * 128 + m * 16) * INC + col0 + C_GC;
#pragma unroll
                for (int bj = 0; bj < 2; ++bj) vc[m][bj] = *(const u32x4*)(zr + bj * 128); }
#pragma unroll
            for (int m = 0; m < 4; ++m) { bf16* rowp = O + (size_t)(row0 + ai * 128 + m * 16) * D + col0;
#pragma unroll
                for (int bj = 0; bj < 2; ++bj) { u32x4 w;
#pragma unroll
                    for (int e = 0; e < 4; ++e) { const float s0 = fsig(bflo(vc[m][bj][e])), s1 = fsig(bfhi(vc[m][bj][e]));
                        w[e] = cvt_pk_bf16(acc[ai][bj][m][e >> 1][(e & 1) * 2] * s0, acc[ai][bj][m][e >> 1][(e & 1) * 2 + 1] * s1); }
                    *(u32x4*)(rowp + bj * 128) = w; } }
            asm volatile("" ::: "memory"); }
    }
};
struct ProbG3 : DenseBase {
    static constexpr int NT = 16, LDA = 1024, LDB = 1024; static constexpr bool PERM = false, ALIGN = true;
    const char* A; const char* B; const float* xin; float* xout; float* xdummy;
    __device__ __forceinline__ const char* a_base(const Unit& u) const { return A + (size_t)u.pm * 256 * LDA * 2; }
    __device__ __forceinline__ const char* b_base(const Unit& u) const { return B + (size_t)u.pn * 256 * LDB * 2; }
    __device__ __forceinline__ void epi(AccT& acc, const Unit& u, int wr, int wc, int fr, int fq) const {
        int row0 = u.pm * 256 + wr * 64 + fr; const int col0 = u.pn * 256 + wc * 32 + 4 * fq; asm volatile("" : "+v"(row0));
        float* const xo = xout;
#pragma unroll
        for (int ai = 0; ai < 2; ++ai) {
            f32x4 xv[4][2][2];
#pragma unroll
            for (int m = 0; m < 4; ++m) { const size_t off = (size_t)(row0 + ai * 128 + m * 16) * D + col0;
#pragma unroll
                for (int bj = 0; bj < 2; ++bj)
#pragma unroll
                    for (int n = 0; n < 2; ++n) xv[m][bj][n] = *(const f32x4*)(xin + off + bj * 128 + n * 16); }
#pragma unroll
            for (int m = 0; m < 4; ++m) { const size_t off = (size_t)(row0 + ai * 128 + m * 16) * D + col0;
#pragma unroll
                for (int bj = 0; bj < 2; ++bj)
#pragma unroll
                    for (int n = 0; n < 2; ++n) *(f32x4*)(xo + off + bj * 128 + n * 16) = xv[m][bj][n] + acc[ai][bj][m][n]; }
            asm volatile("" ::: "memory"); }
    }
};
struct MoeBase {
    static constexpr bool HAS_MID = false; static constexpr int MID0 = -1, MID1 = -1;
    volatile LAS unsigned* MISC; const i32x4* rinfo; int G, c, nsh;
    __device__ __forceinline__ bool next(int i, Unit& u) const { const int L = i * G + c; const int np = (int)MISC[MW_NPAN]; if (L >= (np << nsh)) return false; u.rep = 0; u.pm = L >> nsh; u.pn = L & ((1 << nsh) - 1); return true; }
    __device__ __forceinline__ void mid(AccT&, const Unit&, int, int, int, int, int) const {}
    __device__ __forceinline__ void pinfo(const Unit& u, int& cls, int& lp, int& cnt) const { const unsigned pt = MISC[MW_PT + u.pm]; cls = (int)(pt >> 8); lp = (int)(pt & 255u); cnt = (int)MISC[MW_CNT + cls]; }
    static __device__ __forceinline__ int e_lo(int cls) { const int g = cls / 6, pi = cls - g * 6; return g * 4 + ((0x940 >> (2 * pi)) & 3); }
    static __device__ __forceinline__ int e_hi(int cls) { const int g = cls / 6, pi = cls - g * 6; return g * 4 + ((0xFB9 >> (2 * pi)) & 3); }
};
struct ProbMA : MoeBase {
    static constexpr int NT = 8, LDA = 512, LDB = 512, BSEG = 1 << 20, SCALE_A = 0x7C7C7C7C, SCALE_B = 0x7C7C7C7C; static constexpr bool PERM = true, ALIGN = true, GATHER = true, F8 = true;
    const char* A; const char* B; bf16* hid;
    __device__ __forceinline__ const char* a_gbase() const { return A; }
    __device__ __forceinline__ const char* a_base(const Unit&) const { return A; }
    __device__ __forceinline__ long b_delta(const Unit&) const { return 0l; }
    __device__ __forceinline__ void a_rows(const Unit& u, const int (&R)[2], const int (&C)[2], unsigned (&ro)[2][2]) const {
        int cls, lp, cnt; pinfo(u, cls, lp, cnt);
#pragma unroll
        for (int h = 0; h < 2; ++h)
#pragma unroll
            for (int i = 0; i < 2; ++i) { const int slot = lp * 256 + h * 128 + R[i]; int tok = 0; if (slot < cnt) tok = rinfo[(size_t)cls * CAP + slot].x; ro[h][i] = (unsigned)(tok * LDA + C[i]) * 2u; }
    }
    __device__ __forceinline__ const char* b_base(const Unit& u) const { int cls, lp, cnt; pinfo(u, cls, lp, cnt); const int e = (u.pn < 4) ? e_lo(cls) : e_hi(cls); return B + ((size_t)e * 1024 + (u.pn & 3) * 256) * LDB * 2; }
    __device__ __forceinline__ void epi(AccT& acc, const Unit& u, int wr, int wc, int fr, int fq) const {
        int cls, lp, cnt; pinfo(u, cls, lp, cnt);
        int r0 = wr * 64 + fr; const int colb = (u.pn >> 2) * 512 + (u.pn & 3) * 128 + wc * 32 + 8 * fq; asm volatile("" : "+v"(r0));
#pragma unroll
        for (int ai = 0; ai < 2; ++ai)
#pragma unroll
            for (int m = 0; m < 4; ++m) { const int rr = r0 + ai * 128 + m * 16, slot = lp * 256 + rr; float gate = 0.f;
                float rs = 0.f;
                if (slot < cnt) { const i32x4 inf = rinfo[(size_t)cls * CAP + slot]; gate = __int_as_float(u.pn < 4 ? inf.y : inf.z); rs = __int_as_float(inf.w); }
                gate *= rs;
                u32x4 w;
#pragma unroll
                for (int e = 0; e < 4; ++e) { const float a0 = rs * acc[ai][0][m][e >> 1][(e & 1) * 2], a1 = rs * acc[ai][0][m][e >> 1][(e & 1) * 2 + 1], b0 = acc[ai][1][m][e >> 1][(e & 1) * 2], b1 = acc[ai][1][m][e >> 1][(e & 1) * 2 + 1];
                    w[e] = cvt_pk_bf16(gate * a0 * fsig(a0) * b0, gate * a1 * fsig(a1) * b1); }
                *(u32x4*)(hid + (size_t)(u.pm * 256 + rr) * 1024 + colb) = w; }
    }
};
struct ProbMB : MoeBase {
    static constexpr int NT = 16, LDA = 1024, LDB = 512, BSEG = 8, SCALE_A = 0x7F7F7F7F, SCALE_B = 0x7F7F7F7F; static constexpr bool PERM = false, ALIGN = true, GATHER = false, F8 = false;
    const char* A; const char* B; float* x; float* xdummy;
    __device__ __forceinline__ const char* a_gbase() const { return A; }
    __device__ __forceinline__ void a_rows(const Unit&, const int (&)[2], const int (&)[2], unsigned (&)[2][2]) const {}
    __device__ __forceinline__ const char* a_base(const Unit& u) const { return A + (size_t)u.pm * 256 * LDA * 2; }
    __device__ __forceinline__ const char* b_base(const Unit& u) const { int cls, lp, cnt; pinfo(u, cls, lp, cnt); return B + ((size_t)e_lo(cls) * 1024 + u.pn * 256) * LDB * 2; }
    __device__ __forceinline__ long b_delta(const Unit& u) const { int cls, lp, cnt; pinfo(u, cls, lp, cnt); return (long)(e_hi(cls) - e_lo(cls)) * 1024 * LDB * 2 - 8 * 128; }
    __device__ __forceinline__ void epi(AccT& acc, const Unit& u, int wr, int wc, int fr, int fq) const {
        int cls, lp, cnt; pinfo(u, cls, lp, cnt);
        int r0 = wr * 64 + fr; const int col0 = u.pn * 256 + wc * 32 + 4 * fq; asm volatile("" : "+v"(r0));
        float* const xb_ = x;
#pragma unroll
        for (int ai = 0; ai < 2; ++ai)
#pragma unroll
            for (int mh = 0; mh < 2; ++mh) {
                int tok[2];
#pragma unroll
                for (int mm = 0; mm < 2; ++mm) { const int slot = lp * 256 + r0 + ai * 128 + (2 * mh + mm) * 16; tok[mm] = (slot < cnt) ? rinfo[(size_t)cls * CAP + slot].x : -1; }
                f32x4 xv[2][2][2];
#pragma unroll
                for (int mm = 0; mm < 2; ++mm) { const float* xr = xb_ + (size_t)(tok[mm] < 0 ? 0 : tok[mm]) * D + col0;
#pragma unroll
                    for (int bj = 0; bj < 2; ++bj)
#pragma unroll
                        for (int n = 0; n < 2; ++n) xv[mm][bj][n] = *(const f32x4*)(xr + bj * 128 + n * 16); }
#pragma unroll
                for (int mm = 0; mm < 2; ++mm) if (tok[mm] >= 0) { float* xr = xb_ + (size_t)tok[mm] * D + col0;
#pragma unroll
                    for (int bj = 0; bj < 2; ++bj)
#pragma unroll
                        for (int n = 0; n < 2; ++n) *(f32x4*)(xr + bj * 128 + n * 16) = xv[mm][bj][n] + acc[ai][bj][2 * mh + mm][n]; }
                asm volatile("" ::: "memory"); }
    }
};
__device__ __forceinline__ void moe_panel_table(const Frame& F, int l) {
    __syncthreads();
    if (F.tid == 0) { int np = 0; const unsigned* gc = F.ctl + CW_CNT + 64 * l;
        for (int cls = 0; cls < NCLS; ++cls) { const unsigned cnt = __hip_atomic_load(gc + cls, __ATOMIC_RELAXED, __HIP_MEMORY_SCOPE_AGENT); F.MISC[MW_CNT + cls] = cnt; const int k = (int)((cnt + 255u) >> 8);
            for (int j = 0; j < k; ++j) F.MISC[MW_PT + np + j] = ((unsigned)cls << 8) | (unsigned)j; np += k; }
        F.MISC[MW_NPAN] = (unsigned)np; }
    __syncthreads();
}

__device__ __forceinline__ void tr_item(const float* W, int N, int k0, int n0, const float* gain, bf16* dst, int ldd, int drow0, int kofs, LAS float* scr, int lane) {
    float tv[32];
#pragma unroll
    for (int i = 0; i < 32; ++i) { const int kk = 2 * i + (lane >> 5); tv[i] = W[(size_t)(k0 + kk) * N + n0 + (lane & 31)]; }
    if (gain) {
#pragma unroll
        for (int i = 0; i < 32; ++i) tv[i] *= gain[k0 + 2 * i + (lane >> 5)]; }
#pragma unroll
    for (int i = 0; i < 32; ++i) { const int kk = 2 * i + (lane >> 5); scr[kk * 33 + (lane & 31)] = tv[i]; }
    LDS_WAIT();
    const int c = lane & 7;
#pragma unroll
    for (int j = 0; j < 4; ++j) { const int n = (lane >> 3) + 8 * j; const LAS float* s = scr + (8 * c) * 33 + n;
        u32x4 o; o.x = cvt_pk_bf16(s[0 * 33], s[1 * 33]); o.y = cvt_pk_bf16(s[2 * 33], s[3 * 33]); o.z = cvt_pk_bf16(s[4 * 33], s[5 * 33]); o.w = cvt_pk_bf16(s[6 * 33], s[7 * 33]);
        *(u32x4*)(dst + (size_t)(drow0 + n) * ldd + kofs + k0 + 8 * c) = o; }
    LDS_WAIT();
}
__device__ __forceinline__ void tr_item_f8(const float* W, int N, int k0, int n0, const float* gain, float scale, unsigned char* dst, int ldd, int drow0, LAS float* scr, int lane) {
    float tv[32];
#pragma unroll
    for (int i = 0; i < 32; ++i) { const int kk = 2 * i + (lane >> 5); tv[i] = W[(size_t)(k0 + kk) * N + n0 + (lane & 31)] * scale; }
    if (gain) {
#pragma unroll
        for (int i = 0; i < 32; ++i) tv[i] *= gain[k0 + 2 * i + (lane >> 5)]; }
#pragma unroll
    for (int i = 0; i < 32; ++i) { const int kk = 2 * i + (lane >> 5); scr[kk * 33 + (lane & 31)] = fminf(fmaxf(tv[i], -448.f), 448.f); }
    LDS_WAIT();
    const int c = lane & 7;
#pragma unroll
    for (int j = 0; j < 4; ++j) { const int n = (lane >> 3) + 8 * j; const LAS float* s = scr + (8 * c) * 33 + n;
        int t0 = __builtin_amdgcn_cvt_pk_fp8_f32(s[0 * 33], s[1 * 33], 0, false); t0 = __builtin_amdgcn_cvt_pk_fp8_f32(s[2 * 33], s[3 * 33], t0, true);
        int t1 = __builtin_amdgcn_cvt_pk_fp8_f32(s[4 * 33], s[5 * 33], 0, false); t1 = __builtin_amdgcn_cvt_pk_fp8_f32(s[6 * 33], s[7 * 33], t1, true);
        u32x2 o; o.x = (unsigned)t0; o.y = (unsigned)t1;
        *(u32x2*)(dst + (size_t)(drow0 + n) * ldd + k0 + 8 * c) = o; }
    LDS_WAIT();
}
__device__ __forceinline__ void convert_weights(const Frame& F, int l, int which) {
    LAS float* scr = (LAS float*)(F.lds + F.wave * 8448);
    const int gw = F.c * NWAVES + F.wave, NGW = F.G * NWAVES;
    const float* const* in = F.in; unsigned char* ws = F.ws;
    constexpr int I_IN = 16 * 224, I_A = 8 * 32, I_B = 16 * 32, I_O = 16 * 32, I_W1 = 16 * 16 * 16, I_W2 = 16 * 8 * 32, I_LR = 8 * 2 * 4, I_PL = 4 * 2 * 4;
    if (which & 1) {
        for (int it = gw; it < I_PL; it += NGW) { const int r = it; const int g = r >> 3, q = r & 7, kb = q >> 2, nb = q & 3;
            tr_item(in[13] + ((size_t)l * 4 + g) * 128 * 128, 128, kb * 64, nb * 32, nullptr, (bf16*)(ws + WS_PLT) + (size_t)g * 128 * 128, 128, nb * 32, 0, scr, F.lane); }
    }
    if (which & 2) {
        for (int it = gw; it < I_IN + 2 * I_A + I_B + I_O; it += NGW) { int r = it;
            if (r < I_IN) { const int kb = r / 224, nb = r % 224;
                if (nb < 128) tr_item(in[2] + (size_t)l * D * INC, INC, kb * 64, nb * 32, in[1] + (size_t)l * D, (bf16*)(ws + WS_WINT), 1024, nb * 32, 0, scr, F.lane);
                else tr_item_f8(in[2] + (size_t)l * D * INC, INC, kb * 64, nb * 32, in[1] + (size_t)l * D, 32.0f, ws + WS_WING8, 1024, nb * 32 - 4096, scr, F.lane);
                continue; } r -= I_IN;
            if (r < I_A) { const int kb = r / 32, nb = r % 32; tr_item(in[4] + (size_t)l * W_A * D, D, kb * 64, nb * 32, nullptr, (bf16*)(ws + WS_WCAT), 2048, nb * 32, 0, scr, F.lane); continue; } r -= I_A;
            if (r < I_B) { const int kb = r / 32, nb = r % 32; tr_item(in[12] + (size_t)l * W_B * D, D, kb * 64, nb * 32, nullptr, (bf16*)(ws + WS_WCAT), 2048, nb * 32, 512, scr, F.lane); continue; } r -= I_B;
            if (r < I_A) { const int kb = r / 32, nb = r % 32; tr_item(in[15] + (size_t)l * W_C * D, D, kb * 64, nb * 32, nullptr, (bf16*)(ws + WS_WCAT), 2048, nb * 32, 1536, scr, F.lane); continue; } r -= I_A;
            { const int kb = r / 32, nb = r % 32; tr_item(in[16] + (size_t)l * D * D, D, kb * 64, nb * 32, nullptr, (bf16*)(ws + WS_WOT), 1024, nb * 32, 0, scr, F.lane); } }
    }
    if (which & 4) {
        for (int it = gw; it < 2 * I_W1 + I_W2; it += NGW) { int r = it;
            if (r < 2 * I_W1) { const int sel = r / I_W1; r -= sel * I_W1; const int e = r >> 8, q = r & 255, kb = q >> 4, nb = q & 15, n0 = nb * 32;
                tr_item_f8(in[sel ? 23 : 22] + ((size_t)l * NE + e) * D * DE, DE, kb * 64, n0, in[17] + (size_t)l * D, 64.0f, ws + WS_BAT + (size_t)e * 1024 * 1024, 1024, 256 * (n0 >> 7) + 128 * sel + (n0 & 127), scr, F.lane); continue; }
            r -= 2 * I_W1; { const int e = r >> 8, q = r & 255, kb = q >> 5, nb = q & 31;
                tr_item(in[24] + ((size_t)l * NE + e) * DE * D, D, kb * 64, nb * 32, nullptr, (bf16*)(ws + WS_W2T) + (size_t)e * 1024 * 512, 512, nb * 32, 0, scr, F.lane); } }
    }
}
__device__ __forceinline__ void norm_row_to_bf16(const float* xrow, bf16* orow, unsigned char* orow8, int lane) {
    const f32x4* xr = (const f32x4*)xrow + lane; f32x4 v[4]; float s = 0.f;
#pragma unroll
    for (int j = 0; j < 4; ++j) { v[j] = xr[64 * j]; s += (v[j].x * v[j].x + v[j].y * v[j].y) + (v[j].z * v[j].z + v[j].w * v[j].w); }
    const float rstd = rsqrtf(wave_sum(s) * (1.f / D) + EPS);
    u32x2* o8 = (u32x2*)orow + lane; unsigned* q8 = (unsigned*)orow8 + lane;
#pragma unroll
    for (int j = 0; j < 4; ++j) { const f32x4 t = v[j] * rstd; u32x2 w; w.x = cvt_pk_bf16(t.x, t.y); w.y = cvt_pk_bf16(t.z, t.w); o8[64 * j] = w;
        int p = __builtin_amdgcn_cvt_pk_fp8_f32(2.0f * t.x, 2.0f * t.y, 0, false); p = __builtin_amdgcn_cvt_pk_fp8_f32(2.0f * t.z, 2.0f * t.w, p, true); q8[64 * j] = (unsigned)p; }
}
__device__ __forceinline__ void phase_n1(const Frame& F, int l) {
    convert_weights(F, l, 7);
    const float* x = (l == 0) ? F.in[0] : F.out; bf16* xb = (bf16*)(F.ws + WS_XB);
    const int gw = F.c * NWAVES + F.wave, NGW = F.G * NWAVES;
    for (int m = gw; m < T; m += NGW) norm_row_to_bf16(x + (size_t)m * D, xb + (size_t)m * D, F.ws + (m < TH ? WS_XB8A : WS_XB8B) + (size_t)(m < TH ? m : m - TH) * D, F.lane);
}
__device__ __forceinline__ void phase_final(const Frame& F) {
    const float* g = F.in[25]; const int gw = F.c * NWAVES + F.wave, NGW = F.G * NWAVES;
    f32x4 gv[4];
#pragma unroll
    for (int j = 0; j < 4; ++j) gv[j] = ((const f32x4*)g)[F.lane + 64 * j];
    for (int m = gw; m < T; m += NGW) { f32x4* xr = (f32x4*)(F.out + (size_t)m * D) + F.lane; f32x4 v[4]; float s = 0.f;
#pragma unroll
        for (int j = 0; j < 4; ++j) { v[j] = xr[64 * j]; s += (v[j].x * v[j].x + v[j].y * v[j].y) + (v[j].z * v[j].z + v[j].w * v[j].w); }
        const float rstd = rsqrtf(wave_sum(s) * (1.f / D) + EPS);
#pragma unroll
        for (int j = 0; j < 4; ++j) xr[64 * j] = v[j] * rstd * gv[j]; }
}
constexpr int RT_ROWB = 2064;
constexpr int RT_HI = 0, RT_LO = 20 * RT_ROWB, RT_HIST = 2 * 20 * RT_ROWB, RT_GBASE = RT_HIST + 128, RT_RTMP = RT_HIST + 256, RT_LG = RT_RTMP + 2048, RT_RS = RT_LG + 8 * 16 * 32 * 4;
__device__ __forceinline__ void phase_router(const Frame& F, int l, int rep = 0) {
    LAS unsigned char* lds = F.lds;
    LAS unsigned* hist = (LAS unsigned*)(lds + RT_HIST); LAS unsigned* gbase = (LAS unsigned*)(lds + RT_GBASE); LAS i32x4* rtmp = (LAS i32x4*)(lds + RT_RTMP);
    LAS float* LG = (LAS float*)(lds + RT_LG) + F.wave * 16 * 32; LAS float* RS = (LAS float*)(lds + RT_RS) + F.wave * 16;
    const float* g2 = F.in[17] + (size_t)l * D; const float* wg = F.in[18] + (size_t)l * D * NG; const float* we = F.in[20] + (size_t)l * D * NE;
    const float* bg = F.in[19] + (size_t)l * NG; const float* be = F.in[21] + (size_t)l * NE;
    __syncthreads();
    for (int idx = F.tid; idx < 20 * 1024; idx += NTHR) { const int j = idx >> 10, k = idx & 1023; const float v = g2[k] * (j < 4 ? wg[k * NG + j] : we[k * NE + (j - 4)]);
        const bf16 hi = f2bf(v); const bf16 lo = f2bf(v - bf2f(hi)); *(LAS bf16*)(lds + RT_HI + j * RT_ROWB + k * 2) = hi; *(LAS bf16*)(lds + RT_LO + j * RT_ROWB + k * 2) = lo; }
    const float* x = F.out; bf16* h2 = (bf16*)(F.ws + WS_XB); i32x4* rinfo = (i32x4*)(F.ws + (rep ? WS_ZH + 112 * MiB : WS_RINFO)); unsigned* gcnt = F.ctl + CW_CNT + 64 * (l + 2 * rep);
    const int lane = F.lane, fr = lane & 15, fq = lane >> 4;
    for (int blk = F.c; blk < T / 128; blk += F.G) {
        if (F.tid < 32) hist[F.tid] = 0u;
        __syncthreads();
        const int row = blk * 128 + F.wave * 16 + fr;
        const float* xr = x + (size_t)row * D + 8 * fq; unsigned char* hr = (unsigned char*)h2 + (size_t)row * D + 8 * fq;
        f32x4 d0 = (f32x4){0.f, 0.f, 0.f, 0.f}, d1 = d0; float ss = 0.f;
        const bool n1ok = fr < 4;
#pragma unroll 8
        for (int ks = 0; ks < 32; ++ks) {
            const f32x4 v0 = *(const f32x4*)(xr + 32 * ks), v1 = *(const f32x4*)(xr + 32 * ks + 4);
            ss += (v0.x * v0.x + v0.y * v0.y) + (v0.z * v0.z + v0.w * v0.w) + (v1.x * v1.x + v1.y * v1.y) + (v1.z * v1.z + v1.w * v1.w);
            u32x4 hi; hi.x = cvt_pk_bf16(v0.x, v0.y); hi.y = cvt_pk_bf16(v0.z, v0.w); hi.z = cvt_pk_bf16(v1.x, v1.y); hi.w = cvt_pk_bf16(v1.z, v1.w);
            { int t0 = __builtin_amdgcn_cvt_pk_fp8_f32(v0.x, v0.y, 0, false); t0 = __builtin_amdgcn_cvt_pk_fp8_f32(v0.z, v0.w, t0, true);
              int t1 = __builtin_amdgcn_cvt_pk_fp8_f32(v1.x, v1.y, 0, false); t1 = __builtin_amdgcn_cvt_pk_fp8_f32(v1.z, v1.w, t1, true);
              u32x2 q; q.x = (unsigned)t0; q.y = (unsigned)t1; *(u32x2*)(hr + 32 * ks) = q; }
            u32x4 lo; lo.x = cvt_pk_bf16(v0.x - bflo(hi.x), v0.y - bfhi(hi.x)); lo.y = cvt_pk_bf16(v0.z - bflo(hi.y), v0.w - bfhi(hi.y));
            lo.z = cvt_pk_bf16(v1.x - bflo(hi.z), v1.y - bfhi(hi.z)); lo.w = cvt_pk_bf16(v1.z - bflo(hi.w), v1.w - bfhi(hi.w));
            const bf16x8 ah = __builtin_bit_cast(bf16x8, hi), al = __builtin_bit_cast(bf16x8, lo);
            const int bo = (32 * ks + 8 * fq) * 2;
            const bf16x8 bh0 = *(const LAS bf16x8*)(lds + RT_HI + fr * RT_ROWB + bo), bl0 = *(const LAS bf16x8*)(lds + RT_LO + fr * RT_ROWB + bo);
            bf16x8 bh1 = (bf16x8){0, 0, 0, 0, 0, 0, 0, 0}, bl1 = bh1;
            if (n1ok) { bh1 = *(const LAS bf16x8*)(lds + RT_HI + (16 + fr) * RT_ROWB + bo); bl1 = *(const LAS bf16x8*)(lds + RT_LO + (16 + fr) * RT_ROWB + bo); }
            d0 = __builtin_amdgcn_mfma_f32_16x16x32_bf16(ah, bh0, d0, 0, 0, 0); d0 = __builtin_amdgcn_mfma_f32_16x16x32_bf16(al, bh0, d0, 0, 0, 0); d0 = __builtin_amdgcn_mfma_f32_16x16x32_bf16(ah, bl0, d0, 0, 0, 0);
            d1 = __builtin_amdgcn_mfma_f32_16x16x32_bf16(ah, bh1, d1, 0, 0, 0); d1 = __builtin_amdgcn_mfma_f32_16x16x32_bf16(al, bh1, d1, 0, 0, 0); d1 = __builtin_amdgcn_mfma_f32_16x16x32_bf16(ah, bl1, d1, 0, 0, 0);
        }
        ss += __builtin_bit_cast(float, __builtin_amdgcn_ds_bpermute((lane ^ 16) << 2, __builtin_bit_cast(int, ss))); ss += __builtin_bit_cast(float, __builtin_amdgcn_ds_bpermute((lane ^ 32) << 2, __builtin_bit_cast(int, ss)));
        const float rstd = rsqrtf(ss * (1.f / D) + EPS);
        if (fq == 0) RS[fr] = rstd;
#pragma unroll
        for (int r = 0; r < 4; ++r) { LG[(4 * fq + r) * 32 + fr] = d0[r]; LG[(4 * fq + r) * 32 + 16 + fr] = d1[r]; }
        LDS_WAIT();
        if (lane < 16) {
            const float rs = RS[lane]; float lg[20];
#pragma unroll
            for (int q = 0; q < 20; ++q) lg[q] = LG[lane * 32 + q] * rs + (q < 4 ? bg[q] : be[q - 4]);
            int gi = 0; float mx = lg[0];
#pragma unroll
            for (int j = 1; j < 4; ++j) if (lg[j] > mx) { mx = lg[j]; gi = j; }
            float den = 0.f;
#pragma unroll
            for (int j = 0; j < 4; ++j) den += __expf(lg[j] - mx);
            const float gp = 1.0f / den;
            float el[4];
#pragma unroll
            for (int j = 0; j < 4; ++j) el[j] = (gi == 0) ? lg[4 + j] : (gi == 1) ? lg[8 + j] : (gi == 2) ? lg[12 + j] : lg[16 + j];
            int i1 = 0; float v1 = el[0];
#pragma unroll
            for (int j = 1; j < 4; ++j) if (el[j] > v1) { v1 = el[j]; i1 = j; }
            int i2 = -1; float v2 = 0.f;
#pragma unroll
            for (int j = 0; j < 4; ++j) if (j != i1 && (i2 < 0 || el[j] > v2)) { i2 = j; v2 = el[j]; }
            const float e2 = __expf(v2 - v1); const float p1 = gp / (1.0f + e2), p2 = gp * e2 / (1.0f + e2);
            const int lo_ = i1 < i2 ? i1 : i2, hi_ = i1 < i2 ? i2 : i1; const float glo = i1 < i2 ? p1 : p2, ghi = i1 < i2 ? p2 : p1;
            const int pidx = (lo_ == 0) ? hi_ - 1 : (lo_ == 1 ? hi_ + 1 : 5); const int cls = gi * 6 + pidx;
            const unsigned ls = atomicAdd((unsigned*)(hist + cls), 1u);
            rtmp[F.wave * 16 + lane] = (i32x4){cls | ((int)ls << 8), __float_as_int(glo), __float_as_int(ghi), __float_as_int(rs)};
        }
        __syncthreads();
        if (F.tid < NCLS) gbase[F.tid] = __hip_atomic_fetch_add(gcnt + F.tid, hist[F.tid], __ATOMIC_RELAXED, __HIP_MEMORY_SCOPE_AGENT);
        __syncthreads();
        if (F.tid < 128) { const i32x4 r = rtmp[F.tid]; const int cls = r.x & 255; const unsigned slot = gbase[cls] + (unsigned)(r.x >> 8); rinfo[(size_t)cls * CAP + slot] = (i32x4){blk * 128 + F.tid, r.y, r.z, r.w}; }
        __syncthreads();
    }
}

constexpr int L_CU = 0, L_PW = 38912, L_PC = 73728;
__device__ __forceinline__ void stage_pad128(const bf16* src, LAS unsigned char* dst, int tid) {
    for (int p = tid; p < 2048; p += NTHR) { const int r = p >> 4, c16 = p & 15; *(LAS u32x4*)(dst + r * 272 + c16 * 16) = *(const u32x4*)(src + r * 128 + c16 * 8); }
}
constexpr int L2_WI = 0, L2_WR = 17408, L2_WAGG = 34816, L2_OT = 36864, L2_CST = 40960, L2_XT = 41984, L2_XTB = 35840;
struct LruCtx { int w, fr, fq; bf16* yrow; };
__device__ __forceinline__ float dpp_shr(float oldv, float v, int d) {
    int r;
    switch (d) { case 1: r = __builtin_amdgcn_update_dpp(__builtin_bit_cast(int, oldv), __builtin_bit_cast(int, v), 0x111, 0xf, 0xf, false); break;
                 case 2: r = __builtin_amdgcn_update_dpp(__builtin_bit_cast(int, oldv), __builtin_bit_cast(int, v), 0x112, 0xf, 0xf, false); break;
                 case 4: r = __builtin_amdgcn_update_dpp(__builtin_bit_cast(int, oldv), __builtin_bit_cast(int, v), 0x114, 0xf, 0xf, false); break;
                 default: r = __builtin_amdgcn_update_dpp(__builtin_bit_cast(int, oldv), __builtin_bit_cast(int, v), 0x118, 0xf, 0xf, false); break; }
    return __builtin_bit_cast(float, r);
}
#define LRU_RD12(F, G, WADDR, XADDR, KK) asm volatile("ds_read_b128 %0, %12 offset:%14\n\tds_read_b128 %1, %12 offset:%15\n\tds_read_b128 %2, %12 offset:%16\n\tds_read_b128 %3, %12 offset:%17\n\t" \
        "ds_read_b128 %4, %12 offset:%18\n\tds_read_b128 %5, %12 offset:%19\n\tds_read_b128 %6, %12 offset:%20\n\tds_read_b128 %7, %12 offset:%21\n\t" \
        "ds_read_b128 %8, %13 offset:%22\n\tds_read_b128 %9, %13 offset:%23\n\tds_read_b128 %10, %13 offset:%24\n\tds_read_b128 %11, %13 offset:%25\n\ts_waitcnt lgkmcnt(0)" \
        : "=&v"(F[0]), "=&v"(F[1]), "=&v"(F[2]), "=&v"(F[3]), "=&v"(F[4]), "=&v"(F[5]), "=&v"(F[6]), "=&v"(F[7]), "=&v"(G[0]), "=&v"(G[1]), "=&v"(G[2]), "=&v"(G[3]) : "v"(WADDR), "v"(XADDR), \
          "n"(L2_WR + (KK) * 4352), "n"(L2_WR + (KK) * 4352 + 64), "n"(L2_WR + (KK) * 4352 + 128), "n"(L2_WR + (KK) * 4352 + 192), \
          "n"(L2_WI + (KK) * 4352), "n"(L2_WI + (KK) * 4352 + 64), "n"(L2_WI + (KK) * 4352 + 128), "n"(L2_WI + (KK) * 4352 + 192), \
          "n"((KK) * 272), "n"((KK) * 272 + 64), "n"((KK) * 272 + 128), "n"((KK) * 272 + 192) : "memory")
__device__ __forceinline__ void lru_chunk(const LruCtx& X, const bf16x8 (&Wr)[4][4], LAS unsigned char* lds, u32x2& byraw, int ch, int tb, int tb2, float (&Hc)[4], const char* zdma, const unsigned (&doff)[5], const char* byn, unsigned loff8, unsigned xsub) {
    const int fr = X.fr, fq = X.fq, w = X.w;
    { LAS unsigned char* dst = lds + L2_XT + (tb2 * L2_XTB) + w * 1024;
#pragma unroll
      for (int j = 0; j < 5; ++j) { const int jj = (w + 8 * j < 35) ? j : 3; __builtin_amdgcn_global_load_lds((const unsigned*)(zdma + doff[jj]), (LAS unsigned*)(dst + jj * 8192), 16, 0, 0); } }
    const u32x2 bynext = *(const u32x2*)(byn + loff8);
    const f32x4 z4 = (f32x4){0.f, 0.f, 0.f, 0.f};
    f32x4 ar = z4, ai = z4;
    const unsigned xaddr = (unsigned)(L2_XT + tb * L2_XTB + (16 * w + fr) * 272 + 16 * fq);
    const unsigned waddr = (unsigned)(fr * 136 + 8 * fq) * 2u;
#define LRU_RD8(F, G, WADDR, XADDR, KK) asm volatile("ds_read_b128 %0, %8 offset:%10\n\tds_read_b128 %1, %8 offset:%11\n\tds_read_b128 %2, %8 offset:%12\n\tds_read_b128 %3, %8 offset:%13\n\t" \
        "ds_read_b128 %4, %9 offset:%14\n\tds_read_b128 %5, %9 offset:%15\n\tds_read_b128 %6, %9 offset:%16\n\tds_read_b128 %7, %9 offset:%17\n\ts_waitcnt lgkmcnt(0)" \
        : "=&v"(F[0]), "=&v"(F[1]), "=&v"(F[2]), "=&v"(F[3]), "=&v"(G[0]), "=&v"(G[1]), "=&v"(G[2]), "=&v"(G[3]) : "v"(WADDR), "v"(XADDR), \
          "n"(L2_WI + (KK) * 4352), "n"(L2_WI + (KK) * 4352 + 64), "n"(L2_WI + (KK) * 4352 + 128), "n"(L2_WI + (KK) * 4352 + 192), \
          "n"((KK) * 272), "n"((KK) * 272 + 64), "n"((KK) * 272 + 128), "n"((KK) * 272 + 192) : "memory")
#define LRU_TAPR(KK) do { bf16x8 f_[4], g_[4]; LRU_RD8(f_, g_, waddr, xaddr, KK); \
        _Pragma("unroll") for (int i = 0; i < 4; ++i) { ar = __builtin_amdgcn_mfma_f32_16x16x32_bf16(Wr[KK][i], g_[i], ar, 0, 0, 0); ai = __builtin_amdgcn_mfma_f32_16x16x32_bf16(f_[i], g_[i], ai, 0, 0, 0); } } while (0)
    LRU_TAPR(0); LRU_TAPR(1); LRU_TAPR(2); LRU_TAPR(3);
#undef LRU_TAPR
#undef LRU_RD8
#define LRU_TAP(KK)
#undef LRU_TAP
    u32x2 xv[4];
#pragma unroll
    for (int kk = 0; kk < 4; ++kk) xv[kk] = *(const LAS u32x2*)(lds + L2_XT + tb * L2_XTB + (16 * w + fr + kk) * 272 + xsub);
    float A[4], H[4];
#pragma unroll
    for (int r = 0; r < 4; ++r) { const LAS float* cs = (const LAS float*)(lds + L2_CST) + (4 * fq + r) * 8; const f32x4 c0 = *(const LAS f32x4*)cs, c1 = *(const LAS f32x4*)(cs + 4);
        const float x0 = (r & 1) ? bfhi(r < 2 ? xv[0].x : xv[0].y) : bflo(r < 2 ? xv[0].x : xv[0].y), x1 = (r & 1) ? bfhi(r < 2 ? xv[1].x : xv[1].y) : bflo(r < 2 ? xv[1].x : xv[1].y);
        const float x2 = (r & 1) ? bfhi(r < 2 ? xv[2].x : xv[2].y) : bflo(r < 2 ? xv[2].x : xv[2].y), x3 = (r & 1) ? bfhi(r < 2 ? xv[3].x : xv[3].y) : bflo(r < 2 ? xv[3].x : xv[3].y);
        const float xbr = c0.z + c1.x * x0 + c1.y * x1 + c1.z * x2 + c1.w * x3;
        const float rr = fsig(ar[r] + c0.x), ii = fsig(ai[r] + c0.y); const float la = -c0.w * rr; const float a = fexp(la);
        const float t2 = 2.0f * la; const float om = (t2 > -0.02f) ? -(t2 * (1.0f + t2 * (0.5f + t2 * (1.0f / 6.0f + t2 * (1.0f / 24.0f))))) : 1.0f - a * a;
        A[r] = a; H[r] = sqrtf(fmaxf(om, 0.f)) * (ii * xbr); }
#pragma unroll
    for (int d = 1; d < 16; d <<= 1) {
#pragma unroll
        for (int r = 0; r < 4; ++r) { const float Ap = dpp_shr(1.0f, A[r], d), Hp = dpp_shr(0.0f, H[r], d); H[r] = A[r] * Hp + H[r]; A[r] = A[r] * Ap; } }
    LAS float* WAGG = (LAS float*)(lds + L2_WAGG) + (ch & 1) * 256;
    if (fr == 15) { *(LAS f32x4*)(WAGG + w * 32 + 8 * fq) = (f32x4){A[0], H[0], A[1], H[1]}; *(LAS f32x4*)(WAGG + w * 32 + 8 * fq + 4) = (f32x4){A[2], H[2], A[3], H[3]}; }
    asm volatile("s_waitcnt vmcnt(8) lgkmcnt(0)" ::: "memory");
    __builtin_amdgcn_s_barrier(); asm volatile("" ::: "memory");
    float Awp[4], Hwp[4], At[4], Ht[4];
#pragma unroll
    for (int r = 0; r < 4; ++r) { Awp[r] = 1.f; Hwp[r] = 0.f; At[r] = 1.f; Ht[r] = 0.f; }
#pragma unroll
    for (int q = 0; q < 8; ++q) { const f32x4 v0 = *(const LAS f32x4*)(WAGG + q * 32 + 8 * fq), v1 = *(const LAS f32x4*)(WAGG + q * 32 + 8 * fq + 4);
        Ht[0] = v0.x * Ht[0] + v0.y; At[0] *= v0.x; Ht[1] = v0.z * Ht[1] + v0.w; At[1] *= v0.z; Ht[2] = v1.x * Ht[2] + v1.y; At[2] *= v1.x; Ht[3] = v1.z * Ht[3] + v1.w; At[3] *= v1.z;
        if (q + 1 == w) {
#pragma unroll
            for (int r = 0; r < 4; ++r) { Awp[r] = At[r]; Hwp[r] = Ht[r]; } } }
    float y[4]; const float g0 = bflo(byraw.x), g1 = bfhi(byraw.x), g2 = bflo(byraw.y), g3 = bfhi(byraw.y);
#pragma unroll
    for (int r = 0; r < 4; ++r) { const float Hs = Hwp[r] + Awp[r] * Hc[r]; const float h = H[r] + A[r] * Hs; Hc[r] = Ht[r] + At[r] * Hc[r];
        y[r] = h * fgelu(r == 0 ? g0 : r == 1 ? g1 : r == 2 ? g2 : g3); }
    u32x2 o; o.x = cvt_pk_bf16(y[0], y[1]); o.y = cvt_pk_bf16(y[2], y[3]);
    *(u32x2*)(X.yrow + ((size_t)ch * 128 + fr) * 2048 + 4 * fq) = o;
    byraw = bynext;
}
__device__ __forceinline__ void lru_seq_unit(const Frame& F, int l, int bl, int hd, int ct, const bf16* zh, bf16* yh) {
    LAS unsigned char* lds = F.lds; const int tid = F.tid, lane = F.lane, w = F.wave, fr = lane & 15, fq = lane >> 4;
    const float* cw = F.in[5] + (size_t)l * 4 * W_B + hd * 128; const float* cb = F.in[6] + (size_t)l * W_B + hd * 128;
    const float* wa = F.in[7] + ((size_t)l * 8 + hd) * 128 * 128 + 16 * ct; const float* wx = F.in[9] + ((size_t)l * 8 + hd) * 128 * 128 + 16 * ct;
    LAS float* CST = (LAS float*)(lds + L2_CST);
    const int ks0 = ct >> 1;
    const size_t tl0 = (size_t)bl * SEQ;
    __syncthreads();
    const char* zt = (const char*)(zh + tl0 * INC + C_BX + hd * 128) - (size_t)3 * INC * 2;
    { LAS unsigned char* dst = lds + L2_XT + w * 1024;
#pragma unroll
      for (int j = 0; j < 5; ++j) if (w + 8 * j < 35) { int p = 64 * (w + 8 * j) + lane; if (p > 131 * 17 - 1) p = 131 * 17 - 1; const int row = p / 17; int c = p - row * 17; if (c > 15) c = 15; c = (c + 4 * ks0) & 15;
          __builtin_amdgcn_global_load_lds((const unsigned*)(zt + (unsigned)((row < 3 ? 3 : row) * INC + c * 8) * 2u), (LAS unsigned*)(dst + j * 8192), 16, 0, 0); } }
#pragma unroll 2
    for (int idx = tid; idx < 4 * 16 * 128; idx += NTHR) { const int n = idx & 15, k = (idx >> 4) & 127, kk = idx >> 11; const float c_ = cw[kk * W_B + k];
        const int slot = ((k >> 5) - ks0) & 3, off = ((kk * 16 + n) * 136 + 32 * slot + (k & 31)) * 2;
        *(LAS bf16*)(lds + L2_WR + off) = f2bf(c_ * wa[k * 128 + n]); *(LAS bf16*)(lds + L2_WI + off) = f2bf(c_ * wx[k * 128 + n]); }
    { LAS float* PART = (LAS float*)(lds + L2_OT);
      const int o = tid & 31, part = tid >> 5, g = o >> 4, n = o & 15; const float* W = g ? wx : wa; float cbv[8], wv[8];
#pragma unroll
      for (int i = 0; i < 8; ++i) { cbv[i] = cb[8 * part + i]; wv[i] = W[(8 * part + i) * 128 + n]; }
      float a = 0.f;
#pragma unroll
      for (int i = 0; i < 8; ++i) a += cbv[i] * wv[i];
      PART[part * 32 + o] = a; }
    asm volatile("s_waitcnt vmcnt(0)" ::: "memory");
    if (w == 0 && lane < 51) *(LAS u32x4*)(lds + L2_XT + lane * 16) = (u32x4){0u, 0u, 0u, 0u};
    __syncthreads();
    if (tid < 32) { const int g = tid >> 4, n = tid & 15; float a = (g ? F.in[10] : F.in[8])[(size_t)l * W_B + hd * 128 + 16 * ct + n];
        const LAS float* PART = (const LAS float*)(lds + L2_OT);
#pragma unroll
        for (int q = 0; q < 16; ++q) a += PART[q * 32 + tid];
        CST[n * 8 + g] = a; }
    else if (tid < 48) { const int n = tid - 32, c = 16 * ct + n; CST[n * 8 + 2] = cb[c];
#pragma unroll
        for (int kk = 0; kk < 4; ++kk) CST[n * 8 + 4 + kk] = cw[kk * W_B + c];
        const float lam = F.in[11][(size_t)l * W_B + hd * 128 + c]; const float ex = __expf(-lam); const float sp = (-lam > 20.f) ? -lam : (ex < 0.05f ? ex * (1.0f - ex * (0.5f - ex * (0.33333333f - 0.25f * ex))) : __logf(1.0f + ex)); CST[n * 8 + 3] = 8.0f * sp; }
    __syncthreads();
    LruCtx X; X.w = w; X.fr = fr; X.fq = fq;
    X.yrow = yh + (tl0 + 16 * w) * 2048 + 512 + hd * 128 + 16 * ct;
    const char* zby = (const char*)(zh + (tl0 + 16 * w) * INC + C_BY + hd * 128);
    const unsigned loff8 = (unsigned)(fr * INC + 16 * ct + 4 * fq) * 2u;
    const unsigned xsub = (unsigned)(16 * (ct & 1) + 4 * fq) * 2u;
    unsigned doff[5];
#pragma unroll
    for (int j = 0; j < 5; ++j) { int p = 64 * (w + 8 * j) + lane; if (p > 131 * 17 - 1) p = 131 * 17 - 1; const int row = p / 17; int c = p - row * 17; if (c > 15) c = 15; c = (c + 4 * ks0) & 15; doff[j] = (unsigned)(row * INC + c * 8) * 2u; }
    bf16x8 Wr[4][4];
#pragma unroll
    for (int kk = 0; kk < 4; ++kk)
#pragma unroll
        for (int i = 0; i < 4; ++i) { const int off = ((kk * 16 + fr) * 136 + 32 * i + 8 * fq) * 2; Wr[kk][i] = *(const LAS bf16x8*)(lds + L2_WR + off); }
    { LAS unsigned char* dst = lds + L2_XT + L2_XTB + w * 1024;
#pragma unroll
      for (int j = 0; j < 5; ++j) if (w + 8 * j < 35) __builtin_amdgcn_global_load_lds((const unsigned*)(zt + (size_t)128 * INC * 2 + doff[j]), (LAS unsigned*)(dst + j * 8192), 16, 0, 0); }
    u32x2 by = *(const u32x2*)(zby + loff8); float Hc[4] = {0.f, 0.f, 0.f, 0.f};
    asm volatile("s_waitcnt vmcnt(0)" ::: "memory"); __syncthreads();
    int tb = 0;
#pragma unroll 1
    for (int ch = 0; ch < 32; ++ch) { const int c2 = ch + 2 < 32 ? ch + 2 : 31, cn = ch + 1 < 32 ? ch + 1 : 31; const int tb2 = tb >= 1 ? tb - 1 : 2;
        lru_chunk(X, Wr, lds, by, ch, tb, tb2, Hc, zt + (size_t)c2 * 128 * INC * 2, doff, zby + (size_t)cn * 128 * INC * 2, loff8, xsub);
        tb = tb == 2 ? 0 : tb + 1; }
    asm volatile("s_waitcnt vmcnt(0)" ::: "memory");
    __syncthreads();
}
__device__ __forceinline__ void pool_item(const Frame& F, int l, int bl, int ch, int g, const bf16* zh, bf16* yh) {
    LAS unsigned char* lds = F.lds; const int tid = F.tid, lane = F.lane, w = F.wave, fr = lane & 15, fq = lane >> 4;
    const int s0 = ch * 128, W = 2 << g;
    for (int p = tid; p < 143 * 16; p += NTHR) { const int r = p >> 4, c16 = p & 15, s = s0 - 15 + r; u32x4 v = (u32x4){0u, 0u, 0u, 0u};
        if (s >= 0) v = *(const u32x4*)(zh + ((size_t)bl * SEQ + s) * INC + C_CU + g * 128 + c16 * 8);
        *(LAS u32x4*)(lds + L_CU + r * 272 + c16 * 16) = v; }
    __syncthreads();
    LAS unsigned char* pc = lds + L_PC + w * 4352;
    { const int cg = lane & 15, tq = lane >> 4, t0 = 16 * w + 4 * tq;
        float sum[8];
#pragma unroll
        for (int j = 0; j < 8; ++j) sum[j] = 0.f;
        for (int d = 0; d < W; ++d) { const u32x4 v = *(const LAS u32x4*)(lds + L_CU + (15 + t0 - d) * 272 + cg * 16);
            sum[0] += bflo(v.x); sum[1] += bfhi(v.x); sum[2] += bflo(v.y); sum[3] += bfhi(v.y); sum[4] += bflo(v.z); sum[5] += bfhi(v.z); sum[6] += bflo(v.w); sum[7] += bfhi(v.w); }
#pragma unroll
        for (int i = 0; i < 4; ++i) { const int tr = 15 + t0 + i; const u32x4 cur = *(const LAS u32x4*)(lds + L_CU + tr * 272 + cg * 16);
            if (i > 0) { const u32x4 old = *(const LAS u32x4*)(lds + L_CU + (tr - W) * 272 + cg * 16);
                sum[0] += bflo(cur.x) - bflo(old.x); sum[1] += bfhi(cur.x) - bfhi(old.x); sum[2] += bflo(cur.y) - bflo(old.y); sum[3] += bfhi(cur.y) - bfhi(old.y);
                sum[4] += bflo(cur.z) - bflo(old.z); sum[5] += bfhi(cur.z) - bfhi(old.z); sum[6] += bflo(cur.w) - bflo(old.w); sum[7] += bfhi(cur.w) - bfhi(old.w); }
            const int sp1 = s0 + t0 + i + 1; const float inv = 1.0f / (float)(sp1 < W ? sp1 : W);
            u32x4 o; o.x = cvt_pk_bf16(sum[0] * inv - bflo(cur.x), sum[1] * inv - bfhi(cur.x)); o.y = cvt_pk_bf16(sum[2] * inv - bflo(cur.y), sum[3] * inv - bfhi(cur.y));
            o.z = cvt_pk_bf16(sum[4] * inv - bflo(cur.z), sum[5] * inv - bfhi(cur.z)); o.w = cvt_pk_bf16(sum[6] * inv - bflo(cur.w), sum[7] * inv - bfhi(cur.w));
            *(LAS u32x4*)(pc + (4 * tq + i) * 272 + cg * 16) = o; } }
    LDS_WAIT();
    bf16x8 Af[4];
#pragma unroll
    for (int ks = 0; ks < 4; ++ks) Af[ks] = *(const LAS bf16x8*)(pc + fr * 272 + (32 * ks + 8 * fq) * 2);
    LDS_WAIT();
    const float* psc = F.in[14] + (size_t)l * W_C + g * 128;
#pragma unroll
    for (int ct = 0; ct < 8; ++ct) { f32x4 a = (f32x4){0.f, 0.f, 0.f, 0.f};
#pragma unroll
        for (int ks = 0; ks < 4; ++ks) a = __builtin_amdgcn_mfma_f32_16x16x32_bf16(Af[ks], *(const LAS bf16x8*)(lds + L_PW + (16 * ct + fr) * 272 + (32 * ks + 8 * fq) * 2), a, 0, 0, 0);
        const float sc = psc[16 * ct + fr];
#pragma unroll
        for (int r = 0; r < 4; ++r) *(LAS bf16*)(pc + (4 * fq + r) * 272 + (16 * ct + fr) * 2) = f2bf(a[r] * sc); }
    LDS_WAIT();
    const size_t tlw = (size_t)bl * SEQ + s0 + 16 * w;
#pragma unroll
    for (int i = 0; i < 4; ++i) { const int p = lane + 64 * i, tk = p >> 4, c16 = p & 15;
        *(u32x4*)(yh + (tlw + tk) * 2048 + 1536 + g * 128 + c16 * 8) = *(const LAS u32x4*)(pc + tk * 272 + c16 * 16); }
    __syncthreads();
}
__device__ __forceinline__ void conva_item(const Frame& F, int l, int bl, int ch, int part, const bf16* zh, bf16* yh) {
    const int cg = F.tid & 31, strip = F.tid >> 5, c0 = part * 256 + cg * 8, s0 = ch * 128 + strip * 8;
    const float* cw = F.in[3] + (size_t)l * 3 * W_A + c0;
    float w0[8], w1[8], w2[8];
#pragma unroll
    for (int j = 0; j < 8; ++j) { w0[j] = cw[j]; w1[j] = cw[W_A + j]; w2[j] = cw[2 * W_A + j]; }
    float u2[8], u1[8];
    const bf16* zb = zh + (size_t)bl * SEQ * INC;
#pragma unroll
    for (int q = 0; q < 2; ++q) { const int s = s0 - 2 + q; float* dst = q ? u1 : u2;
        if (s >= 0) { const u32x4 a = *(const u32x4*)(zb + (size_t)s * INC + C_AC + c0), b = *(const u32x4*)(zb + (size_t)s * INC + C_AX + c0);
            dst[0] = bflo(a.x) * bflo(b.x); dst[1] = bfhi(a.x) * bfhi(b.x); dst[2] = bflo(a.y) * bflo(b.y); dst[3] = bfhi(a.y) * bfhi(b.y);
            dst[4] = bflo(a.z) * bflo(b.z); dst[5] = bfhi(a.z) * bfhi(b.z); dst[6] = bflo(a.w) * bflo(b.w); dst[7] = bfhi(a.w) * bfhi(b.w); }
        else {
#pragma unroll
            for (int j = 0; j < 8; ++j) dst[j] = 0.f; } }
#pragma unroll
    for (int i = 0; i < 8; ++i) { const int s = s0 + i; const bf16* zr = zb + (size_t)s * INC;
        const u32x4 a = *(const u32x4*)(zr + C_AC + c0), b = *(const u32x4*)(zr + C_AX + c0), g = *(const u32x4*)(zr + C_AB + c0);
        float u0[8]; u0[0] = bflo(a.x) * bflo(b.x); u0[1] = bfhi(a.x) * bfhi(b.x); u0[2] = bflo(a.y) * bflo(b.y); u0[3] = bfhi(a.y) * bfhi(b.y);
        u0[4] = bflo(a.z) * bflo(b.z); u0[5] = bfhi(a.z) * bfhi(b.z); u0[6] = bflo(a.w) * bflo(b.w); u0[7] = bfhi(a.w) * bfhi(b.w);
        float gb[8]; gb[0] = bflo(g.x); gb[1] = bfhi(g.x); gb[2] = bflo(g.y); gb[3] = bfhi(g.y); gb[4] = bflo(g.z); gb[5] = bfhi(g.z); gb[6] = bflo(g.w); gb[7] = bfhi(g.w);
        float y[8];
#pragma unroll
        for (int j = 0; j < 8; ++j) { y[j] = gb[j] * (w0[j] * u2[j] + w1[j] * u1[j] + w2[j] * u0[j]); u2[j] = u1[j]; u1[j] = u0[j]; }
        u32x4 o; o.x = cvt_pk_bf16(y[0], y[1]); o.y = cvt_pk_bf16(y[2], y[3]); o.z = cvt_pk_bf16(y[4], y[5]); o.w = cvt_pk_bf16(y[6], y[7]);
        *(u32x4*)(yh + ((size_t)bl * SEQ + s) * 2048 + c0) = o; }
}
__device__ __forceinline__ void phase_p2(const Frame& F0, int l, const bf16* zh, bf16* yh) {
    Frame F = F0;
#define REFRESH_LANE() do { int l_; asm volatile("v_mbcnt_lo_u32_b32 %0, -1, 0\n\tv_mbcnt_hi_u32_b32 %0, -1, %0" : "=v"(l_)); F.lane = l_; F.tid = F.wave * 64 + l_; } while (0)
    REP(1024) { for (int it = F.c; it < 256; it += F.G) { const int hd = it & 7, ct = (it >> 3) & 7, bl = it >> 6; lru_seq_unit(F, l, bl, hd, ct, zh, yh); } }
    REFRESH_LANE();
    REP(2048) { int cur_g = -1;
    for (int it = F.c; it < 512; it += F.G) { const int g = it & 3, rest = it >> 2, bl = rest >> 5, ch = rest & 31;
        if (g != cur_g) { __syncthreads(); stage_pad128((const bf16*)(F.ws + WS_PLT) + (size_t)g * 128 * 128, F.lds + L_PW, F.tid); cur_g = g; }
        pool_item(F, l, bl, ch, g, zh, yh); } }
    REFRESH_LANE();
    REP(4096) { for (int it = F.c; it < 256; it += F.G) { const int part = it & 1, rest = it >> 1, bl = rest >> 5, ch = rest & 31; conva_item(F, l, bl, ch, part, zh, yh); } }
}

constexpr int NPHASE = 23;
__global__ void __launch_bounds__(NTHR, 2) mega_fwd(Args args) {
    extern __shared__ __attribute__((aligned(16))) unsigned char lds_raw[];
    Frame F; F.lds = (LAS unsigned char*)lds_raw; F.MISC = (volatile LAS unsigned*)(F.lds + MISC_OFF);
    const int wave_s = __builtin_amdgcn_readfirstlane((int)threadIdx.x >> 6);
    F.wave = wave_s; F.lane = (int)__builtin_amdgcn_mbcnt_hi(~0u, __builtin_amdgcn_mbcnt_lo(~0u, 0u)); F.tid = wave_s * 64 + F.lane; F.G = gridDim.x; F.c = blockIdx.x;
    F.in = args.in; F.out = args.out; F.ws = args.ws; F.ctl = (unsigned*)(args.ws + WS_CTL);
    for (int u = F.tid; u < (LDS_BYTES - MISC_OFF) / 4; u += NTHR) F.MISC[u] = 0u;
    __syncthreads();
    const int lo = args.ph_lo, hi = args.ph_hi;
    XcdBarrier bar; bar.bar = F.ctl + CW_BAR; bar.x = 0; bar.st = nullptr;
    if (hi - lo > 1) bar = xcd_barrier_post(F.ctl + CW_BAR, F.MISC + MW_BAR, F.tid == 0);
    int pid = 0;
#define PH_BEGIN if (pid >= lo && pid < hi) { { int c_ = (int)blockIdx.x; asm volatile("" : "+s"(c_)); F.c = c_; int l_; asm volatile("v_mbcnt_lo_u32_b32 %0, -1, 0\n\tv_mbcnt_hi_u32_b32 %0, -1, %0" : "=v"(l_)); F.lane = l_; F.wave = wave_s; F.tid = wave_s * 64 + l_; }
#define PH_END if (pid + 1 < hi) xcd_barrier(bar, F.tid == 0); } ++pid;
    bf16* zh = (bf16*)(F.ws + WS_ZH); bf16* yh = (bf16*)(F.ws + WS_YH); bf16* xb = (bf16*)(F.ws + WS_XB); bf16* mb = (bf16*)(F.ws + WS_MB);
    for (int l = 0; l < DEPTH; ++l) {
        PH_BEGIN REP(1) { phase_n1(F, l); __syncthreads(); } if ((DUP_MASK & 16384) && l == 0) { for (int xb_ = 0; xb_ < 20; ++xb_) xcd_barrier(bar, F.tid == 0); } PH_END
        for (int hf = 0; hf < 2; ++hf) {
            PH_BEGIN { { ProbG1 p; p.S.init(TH, 4096, F.G, F.c, (DUP_MASK & 2) ? 2 : 1); p.A = (const char*)(xb + (size_t)hf * TH * D); p.B = (const char*)(F.ws + WS_WINT); p.O = zh; p.dummy = yh; pg8::gemm_phase(F.lds, p, F.tid); }
                       { ProbG1g p; p.S.init(TH, 3072, F.G, F.c, (DUP_MASK & 2) ? 2 : 1); p.A = (const char*)(F.ws + (hf ? WS_XB8B : WS_XB8A)); p.B = (const char*)(F.ws + WS_WING8); p.O = zh; pg8::gemm_phase(F.lds, p, F.tid); } } PH_END
            PH_BEGIN REP(8) { if (PH_MASK & 8) phase_p2(F, l, zh, yh); __syncthreads(); } PH_END
            PH_BEGIN { ProbG2 p; p.S.init(TH, D, F.G, F.c, (DUP_MASK & 16) ? 2 : 1); p.A = (const char*)yh; p.B = (const char*)(F.ws + WS_WCAT); p.zh = zh; p.O = mb + (size_t)hf * TH * D; pg8::gemm_phase(F.lds, p, F.tid); } PH_END
        }
        PH_BEGIN { ProbG3 p; p.S.init(T, D, F.G, F.c, (DUP_MASK & 32) ? 2 : 1); p.xdummy = (float*)(F.ws + WS_ZH); p.A = (const char*)mb; p.B = (const char*)(F.ws + WS_WOT); p.xin = (l == 0) ? F.in[0] : F.out; p.xout = F.out; pg8::gemm_phase(F.lds, p, F.tid); } PH_END
        PH_BEGIN REP(64) { phase_router(F, l, rep_); __syncthreads(); } PH_END
        PH_BEGIN { moe_panel_table(F, l); ProbMA p; p.MISC = F.MISC; p.rinfo = (const i32x4*)(F.ws + WS_RINFO); p.G = F.G; p.c = F.c; p.nsh = 3;
                   p.A = (const char*)xb; p.B = (const char*)(F.ws + WS_BAT); p.hid = (bf16*)(F.ws + WS_HID); pg8::gemm_phase(F.lds, p, F.tid); } PH_END
        PH_BEGIN { moe_panel_table(F, l); ProbMB p; p.xdummy = nullptr; p.MISC = F.MISC; p.rinfo = (const i32x4*)(F.ws + WS_RINFO); p.G = F.G; p.c = F.c; p.nsh = 2;
                   p.A = (const char*)(F.ws + WS_HID); p.B = (const char*)(F.ws + WS_W2T); p.x = F.out; pg8::gemm_phase(F.lds, p, F.tid); } PH_END
    }
    PH_BEGIN phase_final(F); PH_END
#undef PH_BEGIN
#undef PH_END
}
static void launch_mega(const Args& base, int lo, int hi, int grid, hipStream_t stream) {
    Args a = base; a.ph_lo = lo; a.ph_hi = hi;
    hipLaunchKernelGGL(mega_fwd, dim3(grid), dim3(NTHR), LDS_BYTES, stream, a);
}
extern "C" void kernel_launch(void* const* d_in, const int* in_sizes, int n_in, void* d_out, int out_size, void* d_ws, size_t ws_size, hipStream_t stream) {
    static int grid = 0;
    if (grid == 0) {
        if (n_in != 26 || out_size != T * D || ws_size < WS_END) { fprintf(stderr, "kernel_launch: unexpected shapes (n_in %d out %d ws %zu)\n", n_in, out_size, ws_size); grid = -1; return; }
        int dev = 0, cus = 0;
        if (hipGetDevice(&dev) != hipSuccess || hipDeviceGetAttribute(&cus, hipDeviceAttributeMultiprocessorCount, dev) != hipSuccess) { grid = -1; return; }
        if (hipFuncSetAttribute((const void*)mega_fwd, hipFuncAttributeMaxDynamicSharedMemorySize, LDS_BYTES) != hipSuccess) { fprintf(stderr, "kernel_launch: hipFuncSetAttribute failed\n"); grid = -1; return; }
        int per_cu = 0; (void)hipOccupancyMaxActiveBlocksPerMultiprocessor(&per_cu, (const void*)mega_fwd, NTHR, LDS_BYTES); (void)hipGetLastError();
        if (per_cu < 1) fprintf(stderr, "kernel_launch: occupancy query says %d blocks per CU\n", per_cu);
        grid = cus;
    }
    if (grid < 0) return;
    (void)hipMemsetAsync((char*)d_ws + WS_CTL, 0, CTL_BYTES, stream);
    Args a{};
    for (int i = 0; i < 26; ++i) a.in[i] = (const float*)d_in[i];
    a.out = (float*)d_out; a.ws = (unsigned char*)d_ws; a.ph_lo = 0; a.ph_hi = 0;
#if ONE_LAUNCH
    launch_mega(a, 0, NPHASE, grid, stream);
#else
    for (int ph = 0; ph < NPHASE; ++ph) launch_mega(a, ph, ph + 1, grid, stream);
#endif
}
```

```cpp
#include <hip/hip_runtime.h>
#include <stdint.h>
#include <stdio.h>

#ifndef ONE_LAUNCH
#define ONE_LAUNCH 1
#endif
#ifndef PH_MASK
#define PH_MASK 1023
#endif
#ifndef DUP_MASK
#define DUP_MASK 0
#endif
#define REP(bit) for (int rep_ = 0; rep_ < ((DUP_MASK & (bit)) ? 2 : 1); ++rep_)

#define LAS __attribute__((address_space(3)))
typedef unsigned short bf16;
typedef short bf16x8 __attribute__((ext_vector_type(8)));
typedef float f32x4 __attribute__((ext_vector_type(4)));
typedef float f32x2 __attribute__((ext_vector_type(2)));
typedef unsigned u32x4 __attribute__((ext_vector_type(4)));
typedef unsigned u32x2 __attribute__((ext_vector_type(2)));
typedef int i32x4 __attribute__((ext_vector_type(4)));
typedef int i32x8 __attribute__((ext_vector_type(8)));

constexpr int D = 1024, BATCH = 8, SEQ = 4096, T = BATCH * SEQ, DEPTH = 2;
constexpr int W_A = 512, W_B = 1024, W_C = 512, INC = 7168;
constexpr int C_AB = 0, C_AC = 512, C_AX = 1024, C_BX = 1536, C_BY = 2560, C_CU = 3584, C_GA = 4096, C_GB = 5120, C_GC = 6144;
constexpr int TH = T / 2;
constexpr int NG = 4, EPG = 4, NE = 16, DE = 512, NCLS = 24, CAP = 32768;
constexpr float EPS_C = 1e-6f;
__device__ __forceinline__ float eps_v() { float e = EPS_C; asm volatile("" : "+v"(e)); return e; }
#define EPS eps_v()
constexpr int NWAVES = 8, NTHR = 512;

constexpr size_t MiB = 1u << 20;
constexpr size_t WS_CTL = 0, CTL_BYTES = 128 * 1024;
constexpr size_t WS_WINT = 1 * MiB;
constexpr size_t WS_WCAT = WS_WINT + 14 * MiB;
constexpr size_t WS_WOT = WS_WCAT + 4 * MiB;
constexpr size_t WS_BAT = WS_WOT + 2 * MiB;
constexpr size_t WS_W2T = WS_BAT + 32 * MiB;
constexpr size_t WS_WAT = WS_W2T + 16 * MiB;
constexpr size_t WS_WXT = WS_WAT + 256 * 1024;
constexpr size_t WS_PLT = WS_WXT + 256 * 1024;
constexpr size_t WS_GW = 70 * MiB;
constexpr size_t WS_RSTD = 70 * MiB + 128 * 1024;
constexpr size_t WS_XB = 71 * MiB;
constexpr size_t WS_ZH = 135 * MiB;
constexpr size_t WS_XS = 359 * MiB;
constexpr size_t WS_CAR = 487 * MiB;
constexpr size_t WS_END = 504 * MiB;
constexpr size_t WS_WING8 = WS_WINT + (size_t)4096 * 1024 * 2;
constexpr size_t WS_XB8A = WS_BAT + 16 * MiB, WS_XB8B = 487 * MiB;
constexpr size_t WS_HID = WS_ZH;
constexpr size_t WS_RINFO = WS_ZH + 96 * MiB;
static_assert(WS_PLT + 128 * 1024 <= WS_XB, "weights fit");
constexpr int CW_BAR = 4096;
constexpr int CW_WQ = 20480;
constexpr int CW_CNT = 16384;

constexpr int RING_BYTES = 131072, LDS_BYTES = 163840, MISC_OFF = LDS_BYTES - 2048;
constexpr int MW_BAR = 8, MW_CNT = 16, MW_NPAN = 44, MW_PT = 48, MW_SCR = 256;

__device__ __forceinline__ float bf2f(bf16 v) { return __uint_as_float(((unsigned)v) << 16); }
__device__ __forceinline__ float bflo(unsigned w) { return __uint_as_float(w << 16); }
__device__ __forceinline__ float bfhi(unsigned w) { return __uint_as_float(w & 0xffff0000u); }
__device__ __forceinline__ bf16 f2bf(float f) { unsigned u = __float_as_uint(f); return (bf16)((u + 0x7fffu + ((u >> 16) & 1u)) >> 16); }
__device__ __forceinline__ unsigned cvt_pk_bf16(float lo, float hi) { unsigned r; asm volatile("v_cvt_pk_bf16_f32 %0, %1, %2" : "=v"(r) : "v"(lo), "v"(hi)); return r; }
__device__ __forceinline__ float dpp_mov(float v, int ctrl_sel) {
    int r; const int x = __builtin_bit_cast(int, v);
    switch (ctrl_sel) { case 0: r = __builtin_amdgcn_update_dpp(0, x, 0xB1, 0xf, 0xf, true); break;
                        case 1: r = __builtin_amdgcn_update_dpp(0, x, 0x4E, 0xf, 0xf, true); break;
                        case 2: r = __builtin_amdgcn_update_dpp(0, x, 0x141, 0xf, 0xf, true); break;
                        default: r = __builtin_amdgcn_update_dpp(0, x, 0x140, 0xf, 0xf, true); break; }
    return __builtin_bit_cast(float, r);
}
__device__ __forceinline__ float wave_sum(float v) {
    v += dpp_mov(v, 0); v += dpp_mov(v, 1); v += dpp_mov(v, 2); v += dpp_mov(v, 3);
    const int x = __builtin_bit_cast(int, v);
    return (__builtin_bit_cast(float, __builtin_amdgcn_readlane(x, 0)) + __builtin_bit_cast(float, __builtin_amdgcn_readlane(x, 16)))
         + (__builtin_bit_cast(float, __builtin_amdgcn_readlane(x, 32)) + __builtin_bit_cast(float, __builtin_amdgcn_readlane(x, 48)));
}
__device__ __forceinline__ float fexp(float x) { return __builtin_amdgcn_exp2f(x * 1.4426950408889634f); }
__device__ __forceinline__ float frcp(float x) { return __builtin_amdgcn_rcpf(x); }
__device__ __forceinline__ float sigmoidf_(float x) { return 1.0f / (1.0f + __expf(-x)); }
__device__ __forceinline__ float fsig(float x) { return frcp(1.0f + __builtin_amdgcn_exp2f(x * -1.4426950408889634f)); }
__device__ __forceinline__ float gelu_tanh(float x) { const float u = 0.7978845608028654f * (x + 0.044715f * x * x * x); return 0.5f * x * (1.0f + tanhf(u)); }
__device__ __forceinline__ float fgelu(float x) { const float u = 1.5957691216057308f * (x + 0.044715f * x * x * x); return x * fsig(u); }
struct SigC { float c[6], k6; };
__device__ __forceinline__ SigC sigc_make(float scale) {
    SigC k; k.c[0] = 2.474571982e-01f * scale; k.c[1] = -1.806103845e-02f * scale; k.c[2] = 1.142852964e-03f * scale; k.c[3] = -4.464323739e-05f * scale; k.c[4] = 9.237665070e-07f * scale; k.c[5] = -7.679337749e-09f * scale; k.k6 = 6.0f;
#pragma unroll
    for (int i = 0; i < 6; ++i) asm volatile("" : "+s"(k.c[i]));
    asm volatile("" : "+s"(k.k6));
    return k;
}
__device__ __forceinline__ f32x4 sig_odd4(f32x4 x, const SigC& k) {
#pragma unroll
    for (int e = 0; e < 4; ++e) x[e] = __builtin_amdgcn_fmed3f(x[e], -k.k6, k.k6);
    const f32x4 u = x * x;
    f32x4 p = u * k.c[5] + k.c[4]; p = p * u + k.c[3]; p = p * u + k.c[2]; p = p * u + k.c[1]; p = p * u + k.c[0];
    return p * x;
}
#define LDS_WAIT() asm volatile("s_waitcnt lgkmcnt(0)" ::: "memory")
#define VM_WAIT() asm volatile("s_waitcnt vmcnt(0)" ::: "memory")

#define XB_TMO      128
#define XB_XCNT(j)  (256  + 64 * (j))
#define XB_XSUB(j)  (1280 + 64 * (j))
#define XB_XGEN(j)  (2304 + 64 * (j))
#define XB_TOP      3328
#define XB_TOPGEN   3392
#define XCD_BAR_WORDS 3456
#define XB_SPIN_CAP (1u << 20)
__device__ __forceinline__ unsigned xb_ld(unsigned* p)              { return __hip_atomic_load(p, __ATOMIC_RELAXED, __HIP_MEMORY_SCOPE_AGENT); }
__device__ __forceinline__ unsigned xb_add(unsigned* p, unsigned v) { return __hip_atomic_fetch_add(p, v, __ATOMIC_RELAXED, __HIP_MEMORY_SCOPE_AGENT); }
__device__ __forceinline__ unsigned xb_xcc_id() { return (unsigned)__builtin_amdgcn_s_getreg((3 << 11) | 20) & 0xFu; }
#define XB_SPIN(cond, bar) do { unsigned _sp = 0; while (cond) { __builtin_amdgcn_s_sleep(1); \
    if ((++_sp & 255u) == 0u) { if (xb_ld(&(bar)[XB_TMO])) break; if (_sp > XB_SPIN_CAP) { atomicAdd(&(bar)[XB_TMO], 1u); break; } } } } while (0)
struct XcdBarrier { unsigned* bar; unsigned x; volatile LAS unsigned* st; };
__device__ __forceinline__ XcdBarrier xcd_barrier_post(unsigned* bar, volatile LAS unsigned* st, bool is0) {
    XcdBarrier b; b.bar = bar; b.x = xb_xcc_id(); b.st = st;
    if (is0) (void)xb_add(&bar[XB_XCNT(b.x)], 1u);
    return b;
}
__device__ __forceinline__ void xcd_barrier_complete(unsigned* bar, unsigned x, unsigned& nloc, unsigned& nx) {
    const unsigned G = gridDim.x * gridDim.y * gridDim.z;
    unsigned sum, cnt, mine, sp = 0u;
    for (;;) {
        sum = 0u; cnt = 0u; mine = 0u;
        unsigned cv[16];
        { const unsigned* p0 = bar + XB_XCNT(0); const unsigned* p1 = bar + XB_XCNT(8);
          asm volatile("global_load_dword %0, %16, off sc1\n\tglobal_load_dword %1, %16, off offset:256 sc1\n\tglobal_load_dword %2, %16, off offset:512 sc1\n\tglobal_load_dword %3, %16, off offset:768 sc1\n\t"
                       "global_load_dword %4, %16, off offset:1024 sc1\n\tglobal_load_dword %5, %16, off offset:1280 sc1\n\tglobal_load_dword %6, %16, off offset:1536 sc1\n\tglobal_load_dword %7, %16, off offset:1792 sc1\n\t"
                       "global_load_dword %8, %17, off sc1\n\tglobal_load_dword %9, %17, off offset:256 sc1\n\tglobal_load_dword %10, %17, off offset:512 sc1\n\tglobal_load_dword %11, %17, off offset:768 sc1\n\t"
                       "global_load_dword %12, %17, off offset:1024 sc1\n\tglobal_load_dword %13, %17, off offset:1280 sc1\n\tglobal_load_dword %14, %17, off offset:1536 sc1\n\tglobal_load_dword %15, %17, off offset:1792 sc1\n\ts_waitcnt vmcnt(0)"
                       : "=&v"(cv[0]), "=&v"(cv[1]), "=&v"(cv[2]), "=&v"(cv[3]), "=&v"(cv[4]), "=&v"(cv[5]), "=&v"(cv[6]), "=&v"(cv[7]),
                         "=&v"(cv[8]), "=&v"(cv[9]), "=&v"(cv[10]), "=&v"(cv[11]), "=&v"(cv[12]), "=&v"(cv[13]), "=&v"(cv[14]), "=&v"(cv[15]) : "v"(p0), "v"(p1) : "memory"); }
#pragma unroll
        for (unsigned j = 0; j < 16; ++j) { const unsigned c = cv[j]; sum += c; cnt += (c > 0u) ? 1u : 0u; mine = (j == x) ? c : mine; }
        if (sum == G) break;
        __builtin_amdgcn_s_sleep(1);
        if ((++sp & 255u) == 0u) { if (xb_ld(&bar[XB_TMO])) break; if (sp > XB_SPIN_CAP) { atomicAdd(&bar[XB_TMO], 1u); break; } }
    }
    nloc = mine > 0u ? mine : 1u; nx = cnt > 0u ? cnt : 1u;
}
__device__ __forceinline__ void xcd_barrier(const XcdBarrier& b, bool is0) {
    asm volatile("s_waitcnt vmcnt(0)" ::: "memory");
    __syncthreads();
    if (is0) {
        unsigned* bar = b.bar;
        __builtin_amdgcn_s_waitcnt(0);
        unsigned nloc = b.st[0], nx = b.st[1];
        if (nloc == 0u) { xcd_barrier_complete(bar, b.x, nloc, nx); b.st[0] = nloc; b.st[1] = nx; }
        const unsigned old = xb_add(&bar[XB_XSUB(b.x)], 1u);
        const unsigned gen = old / nloc;
        if (old + 1u == (gen + 1u) * nloc) {
            __builtin_amdgcn_fence(__ATOMIC_RELEASE, "agent");
            asm volatile("s_waitcnt vmcnt(0)" ::: "memory");
            const unsigned og = xb_add(&bar[XB_TOP], 1u);
            const unsigned tg = og / nx;
            if (og + 1u == (tg + 1u) * nx) xb_add(&bar[XB_TOPGEN], 1u);
            else XB_SPIN(xb_ld(&bar[XB_TOPGEN]) == tg, bar);
            __builtin_amdgcn_fence(__ATOMIC_ACQUIRE, "agent");
            xb_add(&bar[XB_XGEN(b.x)], 1u);
            asm volatile("s_waitcnt vmcnt(0)" ::: "memory");
        } else {
            XB_SPIN(xb_ld(&bar[XB_XGEN(b.x)]) == gen, bar);
            __builtin_amdgcn_fence(__ATOMIC_ACQUIRE, "agent");
            asm volatile("s_waitcnt vmcnt(0)" ::: "memory");
        }
    }
    __syncthreads();
}

namespace pg8 {
constexpr int BM = 256, BK = 64, HALF = 128, HTB = HALF * BK * 2, STAGE_BYTES = 8 * HTB, NXCD = 8, WGM = 8;
__host__ __device__ __forceinline__ int lds_byte(int r, int c) { const int st = (r >> 4) * 2 + (c >> 5), rr = r & 15, cc = c & 31, ob = rr * 64 + cc * 2; return st * 1024 + (ob ^ (((ob >> 9) & 1) << 5)); }
__host__ __device__ __forceinline__ void stage_rc(int b, int& R, int& C) { const int st = b / 1024, sb = b % 1024, swz = sb ^ (((sb >> 9) & 1) << 5); R = (st >> 1) * 16 + swz / 64; C = (st & 1) * 32 + (swz % 64) / 2; }
__host__ __device__ __forceinline__ int perm32(int rho) { const int n = rho >> 4, i = rho & 15; return 8 * (i >> 2) + 4 * n + (i & 3); }
struct Unit { int pm, pn, rep; };
struct StaticOrder {
    int nM, nN, nwg, G, c, dupf;
    __host__ __device__ void init(int M, int N, int G_, int c_, int dupf_ = 1) { nM = M / BM; nN = N / BM; nwg = nM * nN; G = G_; c = c_; dupf = dupf_; }
    __host__ __device__ bool next(int i, Unit& u) const {
        const long L0 = (long)i * G + c; if (L0 >= (long)nwg * dupf) return false; const long L = L0 % nwg; u.rep = (int)(L0 / nwg);
        int wgid = (int)L; { const int q = nwg / NXCD, r = nwg % NXCD, xcd = wgid % NXCD, off = wgid / NXCD; wgid = (xcd < r ? xcd * (q + 1) : r * (q + 1) + (xcd - r) * q) + off; }
        const int nig = WGM * nN, gid = wgid / nig, fm = gid * WGM, gsz = (nM - fm) < WGM ? (nM - fm) : WGM;
        u.pm = fm + ((wgid % nig) % gsz); u.pn = (wgid % nig) / gsz; return true;
    }
};
template <class P>
__device__ __forceinline__ void gemm_phase(LAS unsigned char* lds, const P& p, const int tid) {
    const int wid = __builtin_amdgcn_readfirstlane(tid >> 6), lane = tid & 63, wr = wid >> 2, wc = wid & 3, fr = lane & 15, fq = lane >> 4;
    constexpr int nt = P::NT, lda = P::LDA, ldb = P::LDB;
    unsigned voffA[2], voffB[2]; int Rr[2], Cc[2];
#pragma unroll
    for (int i = 0; i < 2; ++i) { int R, C; stage_rc(tid * 16 + i * 8192, R, C); const int Rb = P::PERM ? ((R & ~31) + perm32(R & 31)) : R;
        voffA[i] = (unsigned)(R * lda + C) * 2u; voffB[i] = (unsigned)(Rb * ldb + C) * 2u; Rr[i] = R; Cc[i] = C; }
    constexpr size_t kstep = (size_t)(BK * 2), hstepA = (size_t)HALF * lda * 2, hstepB = (size_t)HALF * ldb * 2;
    const unsigned ldsw = (unsigned)wid * 1024u;
    const int aoff = lds_byte(wr * 64 + fr, fq * 8), boff = lds_byte(wc * 32 + fr, fq * 8);
#define PG8_SA(b, h) (((b) * 2 + (h)) * HTB)
#define PG8_SB(b, h) ((4 + (b) * 2 + (h)) * HTB)
#define PG8_GL(gp, off) __builtin_amdgcn_global_load_lds((const unsigned*)(gp), (LAS unsigned*)(lds + (off)), 16, 0, 0)
#define PG8_STAGE_B(bufoff, base, h) do { PG8_GL((base) + (h) * hstepB + voffB[0], (bufoff) + ldsw); PG8_GL((base) + (h) * hstepB + voffB[1], (bufoff) + ldsw + 8192); } while (0)
#define PG8_STAGE_A(bufoff, base, h, ro) do { if constexpr (P::GATHER) { PG8_GL((base) + ro[h][0], (bufoff) + ldsw); PG8_GL((base) + ro[h][1], (bufoff) + ldsw + 8192); } \
        else { PG8_GL((base) + (h) * hstepA + voffA[0], (bufoff) + ldsw); PG8_GL((base) + (h) * hstepA + voffA[1], (bufoff) + ldsw + 8192); } } while (0)
#define PG8_LDA(dst, b, h) do { if constexpr (P::F8) { _Pragma("unroll") for (int m = 0; m < 4; ++m) { const i32x4 lo_ = *(const LAS i32x4*)(lds + PG8_SA(b, h) + aoff + m * 2048), hi_ = *(const LAS i32x4*)(lds + PG8_SA(b, h) + aoff + m * 2048 + 1024); \
            dst##8[m] = __builtin_shufflevector(lo_, hi_, 0, 1, 2, 3, 4, 5, 6, 7); } } \
        else { _Pragma("unroll") for (int m = 0; m < 4; ++m) _Pragma("unroll") for (int k = 0; k < 2; ++k) dst[m][k] = *(const LAS bf16x8*)(lds + PG8_SA(b, h) + aoff + m * 2048 + k * 1024); } } while (0)
#define PG8_LDB(dst, b, h) do { if constexpr (P::F8) { _Pragma("unroll") for (int n = 0; n < 2; ++n) { const i32x4 lo_ = *(const LAS i32x4*)(lds + PG8_SB(b, h) + boff + n * 2048), hi_ = *(const LAS i32x4*)(lds + PG8_SB(b, h) + boff + n * 2048 + 1024); \
            dst##8[n] = __builtin_shufflevector(lo_, hi_, 0, 1, 2, 3, 4, 5, 6, 7); } } \
        else { _Pragma("unroll") for (int n = 0; n < 2; ++n) _Pragma("unroll") for (int k = 0; k < 2; ++k) dst[n][k] = *(const LAS bf16x8*)(lds + PG8_SB(b, h) + boff + n * 2048 + k * 1024); } } while (0)
#define PG8_MMA(ai, bj, At, Bt) do { __builtin_amdgcn_s_setprio(1); \
        if constexpr (P::F8) { _Pragma("unroll") for (int m = 0; m < 4; ++m) _Pragma("unroll") for (int n = 0; n < 2; ++n) \
            acc[ai][bj][m][n] = __builtin_amdgcn_mfma_scale_f32_16x16x128_f8f6f4(Bt##8[n], At##8[m], acc[ai][bj][m][n], 0, 0, 0, scB_, 0, scA_); } \
        else { _Pragma("unroll") for (int m = 0; m < 4; ++m) _Pragma("unroll") for (int n = 0; n < 2; ++n) _Pragma("unroll") for (int k = 0; k < 2; ++k) \
            acc[ai][bj][m][n] = __builtin_amdgcn_mfma_f32_16x16x32_bf16(Bt[n][k], At[m][k], acc[ai][bj][m][n], 0, 0, 0); } \
        __builtin_amdgcn_s_setprio(0); } while (0)
#define PG8_WAIT_V(n) asm volatile("s_waitcnt vmcnt(" #n ")" ::: "memory")
#define PG8_WAIT_L(n) asm volatile("s_waitcnt lgkmcnt(" #n ")" ::: "memory")
#define PG8_BAR __builtin_amdgcn_s_barrier()
#define PG8_SCHED __builtin_amdgcn_sched_barrier(0)
    int scA_ = P::SCALE_A, scB_ = P::SCALE_B; if constexpr (P::F8) { asm volatile("" : "+v"(scA_), "+v"(scB_)); }
    Unit cur, nxt; int ui = 0;
    if (!p.next(0, cur)) return;
    f32x4 acc[2][2][4][2];
#pragma unroll
    for (int a = 0; a < 2; ++a)
#pragma unroll
        for (int b = 0; b < 2; ++b)
#pragma unroll
            for (int m = 0; m < 4; ++m)
#pragma unroll
                for (int n = 0; n < 2; ++n) acc[a][b][m][n] = (f32x4){0.f, 0.f, 0.f, 0.f};
    bf16x8 At[4][2], B0[2][2], B1[2][2]; i32x8 At8[4], B08[2], B18[2];
    unsigned roC[2][2] = {{0u, 0u}, {0u, 0u}};
    const char* cA; const char* cB = p.b_base(cur); long bdC = p.b_delta(cur);
    if constexpr (P::PRE) p.pre_next(cur, lds + RING_BYTES, wid, lane);
    if constexpr (P::GATHER) { cA = p.a_gbase(); p.a_rows(cur, Rr, Cc, roC); } else { cA = p.a_base(cur); }
    PG8_STAGE_B(PG8_SB(0, 0), cB, 0); PG8_STAGE_B(PG8_SB(0, 1), cB, 1); PG8_STAGE_A(PG8_SA(0, 0), cA, 0, roC); PG8_STAGE_A(PG8_SA(0, 1), cA, 1, roC);
    if (wr == 1) PG8_BAR;
    PG8_WAIT_V(2); PG8_BAR;
    PG8_STAGE_B(PG8_SB(1, 0), cB + kstep, 0); PG8_STAGE_A(PG8_SA(1, 0), cA + kstep, 0, roC); PG8_STAGE_B(PG8_SB(1, 1), cB + kstep, 1);
    PG8_WAIT_V(6); PG8_BAR;
    for (;;) {
        const bool has_next = p.next(ui + 1, nxt);
        if constexpr (P::PRE) { if (has_next) p.pre_next(nxt, lds + RING_BYTES + ((ui + 1) & 1) * 4096, wid, lane); }
        const char* nA = cA; const char* nB = cB; long bdN = bdC;
        if (has_next) { nB = p.b_base(nxt); bdN = p.b_delta(nxt); if constexpr (!P::GATHER) { nA = p.a_base(nxt); } }
#pragma unroll 1
        for (int t = 0; t < nt; t += 2) {
            const bool last = (t == nt - 2);
            if constexpr (P::HAS_MID) { if (t == P::MID0 || t == P::MID1) p.mid(acc, cur, t, wr, wc, fr, fq); }
            const char* a1 = cA + (size_t)(t + 1) * kstep;
            const char* a2 = last ? nA : cA + (size_t)(t + 2) * kstep;
            const char* b2 = last ? nB : cB + (size_t)(t + 2) * kstep + ((t + 2) >= P::BSEG ? bdC : 0l);
            const char* a3 = a2 + kstep; const char* b3 = b2 + kstep;
            PG8_LDB(B0, 0, 0); PG8_LDB(B1, 0, 1); PG8_SCHED; PG8_LDA(At, 0, 0); PG8_STAGE_A(PG8_SA(1, 1), a1, 1, roC);
            if constexpr (P::GATHER) { if (last && has_next) { if constexpr (P::PRE) p.a_rows_lds(nxt, Rr, Cc, roC, lds + RING_BYTES + ((ui + 1) & 1) * 4096); else p.a_rows(nxt, Rr, Cc, roC); } }
            PG8_WAIT_V(8); PG8_WAIT_L(0); PG8_BAR; PG8_MMA(0, 0, At, B0); PG8_MMA(0, 1, At, B1); PG8_BAR; PG8_SCHED;
            PG8_LDA(At, 0, 1); PG8_STAGE_B(PG8_SB(0, 0), b2, 0); PG8_STAGE_B(PG8_SB(0, 1), b2, 1); PG8_STAGE_A(PG8_SA(0, 0), a2, 0, roC);
            PG8_WAIT_V(8); PG8_WAIT_L(0); PG8_BAR; PG8_MMA(1, 0, At, B0); PG8_MMA(1, 1, At, B1); PG8_BAR; PG8_SCHED;
            PG8_LDB(B0, 1, 0); PG8_LDB(B1, 1, 1); PG8_SCHED; PG8_LDA(At, 1, 0); PG8_STAGE_A(PG8_SA(0, 1), a2, 1, roC);
            PG8_WAIT_V(8); PG8_WAIT_L(0); PG8_BAR; PG8_MMA(0, 0, At, B0); PG8_MMA(0, 1, At, B1); PG8_BAR; PG8_SCHED;
            PG8_LDA(At, 1, 1); PG8_STAGE_B(PG8_SB(1, 0), b3, 0); PG8_STAGE_B(PG8_SB(1, 1), b3, 1); PG8_STAGE_A(PG8_SA(1, 0), a3, 0, roC);
            PG8_WAIT_V(8); PG8_WAIT_L(0); PG8_BAR; PG8_MMA(1, 0, At, B0); PG8_MMA(1, 1, At, B1); PG8_BAR; PG8_SCHED;
        }
        if constexpr (P::ALIGN) { if (wr == 0) PG8_BAR; }
        if constexpr (P::PRE) p.epi_lds(acc, cur, wr, wc, fr, fq, lds + RING_BYTES + (ui & 1) * 4096); else p.epi(acc, cur, wr, wc, fr, fq);
        if (!has_next) break;
#pragma unroll
        for (int a = 0; a < 2; ++a)
#pragma unroll
            for (int b = 0; b < 2; ++b)
#pragma unroll
                for (int m = 0; m < 4; ++m)
#pragma unroll
                    for (int n = 0; n < 2; ++n) acc[a][b][m][n] = (f32x4){0.f, 0.f, 0.f, 0.f};
        cur = nxt; cA = nA; cB = nB; bdC = bdN; ++ui;
        if constexpr (P::ALIGN) { if (wr == 1) PG8_BAR; }
    }
    PG8_WAIT_V(0);
    if constexpr (!P::ALIGN) { if (wr == 0) PG8_BAR; }
    PG8_BAR;
#undef PG8_SA
#undef PG8_SB
#undef PG8_GL
#undef PG8_STAGE_A
#undef PG8_STAGE_B
#undef PG8_LDA
#undef PG8_LDB
#undef PG8_MMA
#undef PG8_WAIT_V
#undef PG8_WAIT_L
#undef PG8_BAR
#undef PG8_SCHED
}
}
using pg8::Unit;
typedef f32x4 AccT[2][2][4][2];

struct Args { const float* in[26]; float* out; unsigned char* ws; int ph_lo, ph_hi; };
struct Frame {
    LAS unsigned char* lds; volatile LAS unsigned* MISC; unsigned* ctl;
    int tid, lane, wave, G, c;
    const float* const* in; float* out; unsigned char* ws;
};

struct DenseBase {
    static constexpr bool GATHER = false, HAS_MID = false, F8 = false, PRE = false; static constexpr int SCALE_A = 0x7F7F7F7F, SCALE_B = 0x7F7F7F7F; static constexpr int MID0 = -1, MID1 = -1, BSEG = 1 << 20;
    pg8::StaticOrder S;
    __device__ __forceinline__ bool next(int i, Unit& u) const { return S.next(i, u); }
    __device__ __forceinline__ long b_delta(const Unit&) const { return 0l; }
    __device__ __forceinline__ const char* a_gbase() const { return nullptr; }
    __device__ __forceinline__ void a_rows(const Unit&, const int (&)[2], const int (&)[2], unsigned (&)[2][2]) const {}
    __device__ __forceinline__ void mid(AccT&, const Unit&, int, int, int, int, int) const {}
};
struct ProbG1 : DenseBase {
    static constexpr int NT = 16, LDA = 1024, LDB = 1024; static constexpr bool PERM = true, ALIGN = true, PRE = true;
    const char* A; const char* B; bf16* O; bf16* dummy; const float* rstd;
    __device__ __forceinline__ void pre_next(const Unit& u, LAS unsigned char* scr, int wid, int lane) const {
        if (wid == 0) __builtin_amdgcn_global_load_lds((const unsigned*)(rstd + u.pm * 256 + lane * 4), (LAS unsigned*)scr, 16, 0, 0); }
    __device__ __forceinline__ const char* a_base(const Unit& u) const { return A + (size_t)u.pm * 256 * LDA * 2; }
    static __device__ __forceinline__ int ctile(int pn) { return pn < 6 ? pn : pn + 8; }
    __device__ __forceinline__ const char* b_base(const Unit& u) const { return B + (size_t)ctile(u.pn) * 256 * LDB * 2; }
    __device__ __forceinline__ void epi_lds(AccT& acc, const Unit& u, int wr, int wc, int fr, int fq, LAS unsigned char* scr) const {
        int row0 = u.pm * 256 + wr * 64 + fr; const int col0 = ctile(u.pn) * 256 + wc * 32 + 8 * fq; asm volatile("" : "+v"(row0));
        float rsv[2][4];
#pragma unroll
        for (int ai = 0; ai < 2; ++ai)
#pragma unroll
            for (int m = 0; m < 4; ++m) rsv[ai][m] = *(const LAS float*)(scr + (wr * 64 + fr + ai * 128 + m * 16) * 4);
#pragma unroll
        for (int ai = 0; ai < 2; ++ai)
#pragma unroll
            for (int m = 0; m < 4; ++m) { bf16* rowp = O + (size_t)(row0 + ai * 128 + m * 16) * INC + col0;
#pragma unroll
                for (int bj = 0; bj < 2; ++bj) { const f32x4 v0 = acc[ai][bj][m][0] * rsv[ai][m], v1 = acc[ai][bj][m][1] * rsv[ai][m];
                    u32x4 w; w.x = cvt_pk_bf16(v0[0], v0[1]); w.y = cvt_pk_bf16(v0[2], v0[3]); w.z = cvt_pk_bf16(v1[0], v1[1]); w.w = cvt_pk_bf16(v1[2], v1[3]);
                    *(u32x4*)(rowp + bj * 128) = w;
                    if (DUP_MASK & 8192) { const size_t off = ((size_t)((rowp + bj * 128) - O) * 2) & (size_t)(64 * MiB - 16); *(u32x4*)((char*)dummy + off) = w; } } }
    }
};
struct ProbG1g : DenseBase {
    static constexpr int NT = 8, LDA = 512, LDB = 512, SCALE_A = 0x7C7C7C7C, SCALE_B = 0x7C7C7C7C; static constexpr bool PERM = true, ALIGN = true, F8 = true, GATHER = true;
    const char* A; const char* B; bf16* O; const float* rstd;
    __device__ __forceinline__ const char* a_gbase() const { return A; }
    __device__ __forceinline__ void a_rows(const Unit& u, const int (&R)[2], const int (&C)[2], unsigned (&ro)[2][2]) const {
#pragma unroll
        for (int h = 0; h < 2; ++h)
#pragma unroll
            for (int i = 0; i < 2; ++i) ro[h][i] = (unsigned)((u.pm * 256 + h * 128 + R[i]) * LDA + C[i]) * 2u; }
    __device__ __forceinline__ const char* a_base(const Unit& u) const { return A + (size_t)u.pm * 256 * LDA * 2; }
    __device__ __forceinline__ const char* b_base(const Unit& u) const { return B + (size_t)u.pn * 256 * LDB * 2; }
    __device__ __forceinline__ void epi(AccT& acc, const Unit& u, int wr, int wc, int fr, int fq) const {
        int row0 = u.pm * 256 + wr * 64 + fr; asm volatile("" : "+v"(row0));
        if (u.pn < 8) {
            const int col0 = 1536 + u.pn * 256 + wc * 32 + 8 * fq;
#pragma unroll
            for (int ai = 0; ai < 2; ++ai)
#pragma unroll
                for (int m = 0; m < 4; ++m) { bf16* rowp = O + (size_t)(row0 + ai * 128 + m * 16) * INC + col0;
#pragma unroll
                    for (int bj = 0; bj < 2; ++bj) { const f32x4 v0 = acc[ai][bj][m][0], v1 = acc[ai][bj][m][1];
                        u32x4 w; w.x = cvt_pk_bf16(v0[0], v0[1]); w.y = cvt_pk_bf16(v0[2], v0[3]); w.z = cvt_pk_bf16(v1[0], v1[1]); w.w = cvt_pk_bf16(v1[2], v1[3]);
                        *(u32x4*)(rowp + bj * 128) = w; } }
            return; }
        const int gcol0 = (u.pn - 8) * 256 + wc * 32 + 8 * fq;
        const SigC sk = sigc_make(254.0f); float k128 = 128.0f; asm volatile("" : "+s"(k128));
#pragma unroll
        for (int ai = 0; ai < 2; ++ai)
#pragma unroll
            for (int m = 0; m < 4; ++m) { unsigned char* rowp = (unsigned char*)(O + (size_t)(row0 + ai * 128 + m * 16) * INC + 4096) + gcol0;
#pragma unroll
                for (int bj = 0; bj < 2; ++bj) { const f32x4 q0 = sig_odd4(acc[ai][bj][m][0], sk) + k128, q1 = sig_odd4(acc[ai][bj][m][1], sk) + k128; unsigned w0 = 0u, w1 = 0u;
#pragma unroll
                    for (int e = 0; e < 4; ++e) { w0 = __builtin_amdgcn_cvt_pk_u8_f32(q0[e], e, w0); w1 = __builtin_amdgcn_cvt_pk_u8_f32(q1[e], e, w1); }
                    u32x2 w; w.x = w0; w.y = w1;
                    *(u32x2*)(rowp + bj * 128) = w; } }
    }
};
struct ProbG2 : DenseBase {
    static constexpr int NT = 32, LDA = 2048, LDB = 2048, MID0 = 8, MID1 = 24; static constexpr bool PERM = true, ALIGN = false, HAS_MID = true;
    const char* A; const char* B; const bf16* zh; bf16* O;
    __device__ __forceinline__ const char* a_base(const Unit& u) const { return A + (size_t)u.pm * 256 * LDA * 2; }
    __device__ __forceinline__ const char* b_base(const Unit& u) const { return B + (size_t)u.pn * 256 * LDB * 2; }
    __device__ __forceinline__ void mid(AccT& acc, const Unit& u, int t, int wr, int wc, int fr, int fq) const {
        const int gsel = (t == MID0) ? 0 : 1;
        int row0 = u.pm * 256 + wr * 64 + fr; const int col0 = u.pn * 256 + wc * 32 + 8 * fq; asm volatile("" : "+v"(row0));
        u32x2 va[2][4][2], vb[2][4][2];
#pragma unroll
        for (int ai = 0; ai < 2; ++ai)
#pragma unroll
            for (int m = 0; m < 4; ++m) { const unsigned char* zr = (const unsigned char*)(zh + (size_t)(row0 + ai * 128 + m * 16) * INC + 4096) + gsel * 1024 + col0;
#pragma unroll
                for (int bj = 0; bj < 2; ++bj) { va[ai][m][bj] = *(const u32x2*)(zr + bj * 128); vb[ai][m][bj] = *(const u32x2*)(zr + 1024 + bj * 128); } }
#pragma unroll
        for (int ai = 0; ai < 2; ++ai) {
#pragma unroll
            for (int m = 0; m < 4; ++m)
#pragma unroll
                for (int bj = 0; bj < 2; ++bj)
#pragma unroll
                    for (int e = 0; e < 8; ++e) { const unsigned wa = (e < 4) ? va[ai][m][bj].x : va[ai][m][bj].y, wb = (e < 4) ? vb[ai][m][bj].x : vb[ai][m][bj].y;
                        const float sa = (float)((wa >> (8 * (e & 3))) & 255u), sb = (float)((wb >> (8 * (e & 3))) & 255u);
                        acc[ai][bj][m][e >> 2][e & 3] *= sa * frcp(sb); }
            asm volatile("" ::: "memory"); }
    }
    __device__ __forceinline__ void epi(AccT& acc, const Unit& u, int wr, int wc, int fr, int fq) const {
        int row0 = u.pm * 256 + wr * 64 + fr; const int col0 = u.pn * 256 + wc * 32 + 8 * fq; asm volatile("" : "+v"(row0));
        u32x2 vc8[2][4][2];
#pragma unroll
        for (int ai = 0; ai < 2; ++ai)
#pragma unroll
            for (int m = 0; m < 4; ++m) { const unsigned char* zr = (const unsigned char*)(zh + (size_t)(row0 + ai * 128 + m * 16) * INC + 4096) + 2048 + col0;
#pragma unroll
                for (int bj = 0; bj < 2; ++bj) vc8[ai][m][bj] = *(const u32x2*)(zr + bj * 128); }
#pragma unroll
        for (int ai = 0; ai < 2; ++ai) {
            u32x2 vc[4][2];
#pragma unroll
            for (int m = 0; m < 4; ++m)
#pragma unroll
                for (int bj = 0; bj < 2; ++bj) vc[m][bj] = vc8[ai][m][bj];
#pragma unroll
            for (int m = 0; m < 4; ++m) { bf16* rowp = O + (size_t)(row0 + ai * 128 + m * 16) * D + col0;
#pragma unroll
                for (int bj = 0; bj < 2; ++bj) { float sc[8];
#pragma unroll
                    for (int e = 0; e < 8; ++e) { const unsigned wv = (e < 4) ? vc[m][bj].x : vc[m][bj].y; sc[e] = (float)((wv >> (8 * (e & 3))) & 255u) * (1.0f / 255.0f); }
                    u32x4 w;
#pragma unroll
                    for (int e = 0; e < 4; ++e) w[e] = cvt_pk_bf16(acc[ai][bj][m][e >> 1][(e & 1) * 2] * sc[2 * e], acc[ai][bj][m][e >> 1][(e & 1) * 2 + 1] * sc[2 * e + 1]);
                    *(u32x4*)(rowp + bj * 128) = w; } }
            asm volatile("" ::: "memory"); }
    }
};
struct ProbG3 : DenseBase {
    static constexpr int NT = 16, LDA = 1024, LDB = 1024; static constexpr bool PERM = true, ALIGN = true;
    const char* A; const char* B; const float* xin32; bf16* xs;
    __device__ __forceinline__ bool next(int i, Unit& u) const {
        if (S.G != 256) return S.next(i, u);
        if (i >= 2) return false;
        const int off = S.c >> 3; u.rep = 0; u.pm = (1 - i) * 64 + 8 * (S.c & 7) + (off & 7); u.pn = off >> 3; return true; }
    __device__ __forceinline__ const char* a_base(const Unit& u) const { return A + (size_t)u.pm * 256 * LDA * 2; }
    __device__ __forceinline__ const char* b_base(const Unit& u) const { return B + (size_t)u.pn * 256 * LDB * 2; }
    __device__ __forceinline__ void epi(AccT& acc, const Unit& u, int wr, int wc, int fr, int fq) const {
        int row0 = u.pm * 256 + wr * 64 + fr; const int col0 = u.pn * 256 + wc * 32 + 8 * fq; asm volatile("" : "+v"(row0));
        u32x4 xd[2][4][2];
#pragma unroll
        for (int ai = 0; ai < 2; ++ai)
#pragma unroll
            for (int m = 0; m < 4; ++m) { const bf16* xr = xs + (size_t)(row0 + ai * 128 + m * 16) * D + col0;
#pragma unroll
                for (int bj = 0; bj < 2; ++bj) xd[ai][m][bj] = *(const u32x4*)(xr + bj * 128); }
#pragma unroll
        for (int ai = 0; ai < 2; ++ai)
#pragma unroll
            for (int m = 0; m < 4; ++m) { bf16* xo = xs + (size_t)(row0 + ai * 128 + m * 16) * D + col0;
#pragma unroll
                for (int bj = 0; bj < 2; ++bj) { const u32x4 d = xd[ai][m][bj];
                    const f32x4 v0 = (f32x4){bflo(d.x), bfhi(d.x), bflo(d.y), bfhi(d.y)} + acc[ai][bj][m][0], v1 = (f32x4){bflo(d.z), bfhi(d.z), bflo(d.w), bfhi(d.w)} + acc[ai][bj][m][1];
                    u32x4 w; w.x = cvt_pk_bf16(v0[0], v0[1]); w.y = cvt_pk_bf16(v0[2], v0[3]); w.z = cvt_pk_bf16(v1[0], v1[1]); w.w = cvt_pk_bf16(v1[2], v1[3]);
                    *(u32x4*)(xo + bj * 128) = w; } }
    }
};
struct MoeBase {
    static constexpr bool HAS_MID = false, PRE = false; static constexpr int MID0 = -1, MID1 = -1;
    volatile LAS unsigned* MISC; const i32x4* rinfo; int G, c, nsh, dupm = 1;
    __device__ __forceinline__ bool next(int i, Unit& u) const { int L = i * G + c; const int np = (int)MISC[MW_NPAN]; const int tot = np << nsh; if (L >= tot * dupm) return false; if (dupm > 1) L %= tot; u.rep = 0; u.pm = L >> nsh; u.pn = L & ((1 << nsh) - 1); return true; }
    __device__ __forceinline__ void mid(AccT&, const Unit&, int, int, int, int, int) const {}
    __device__ __forceinline__ void pinfo(const Unit& u, int& cls, int& lp, int& cnt) const { const unsigned pt = MISC[MW_PT + u.pm]; cls = (int)(pt >> 8); lp = (int)(pt & 255u); cnt = (int)MISC[MW_CNT + cls]; }
    static __device__ __forceinline__ int e_lo(int cls) { const int g = cls / 6, pi = cls - g * 6; return g * 4 + ((0x940 >> (2 * pi)) & 3); }
    static __device__ __forceinline__ int e_hi(int cls) { const int g = cls / 6, pi = cls - g * 6; return g * 4 + ((0xFB9 >> (2 * pi)) & 3); }
};
struct ProbMA : MoeBase {
    static constexpr int NT = 8, LDA = 512, LDB = 512, BSEG = 1 << 20, SCALE_A = 0x7C7C7C7C, SCALE_B = 0x7C7C7C7C; static constexpr bool PERM = true, ALIGN = true, GATHER = true, F8 = true, PRE = true;
    const char* A; const char* B; unsigned char* hid;
    __device__ __forceinline__ void pre_next(const Unit& u, LAS unsigned char* scr, int wid, int lane) const {
        if (wid < 4) { int cls, lp, cnt; pinfo(u, cls, lp, cnt);
            __builtin_amdgcn_global_load_lds((const unsigned*)(rinfo + (size_t)cls * CAP + lp * 256 + wid * 64 + lane), (LAS unsigned*)(scr + wid * 1024), 16, 0, 0); } }
    __device__ __forceinline__ void a_rows_lds(const Unit& u, const int (&R)[2], const int (&C)[2], unsigned (&ro)[2][2], LAS unsigned char* scr) const {
        int cls, lp, cnt; pinfo(u, cls, lp, cnt);
#pragma unroll
        for (int h = 0; h < 2; ++h)
#pragma unroll
            for (int i = 0; i < 2; ++i) { const int idx = h * 128 + R[i]; const int tk = *(const LAS int*)(scr + idx * 16); const int tok = (lp * 256 + idx < cnt) ? tk : 0; ro[h][i] = (unsigned)(tok * LDA + C[i]) * 2u; }
    }
    __device__ __forceinline__ const char* a_gbase() const { return A; }
    __device__ __forceinline__ const char* a_base(const Unit&) const { return A; }
    __device__ __forceinline__ long b_delta(const Unit&) const { return 0l; }
    __device__ __forceinline__ void a_rows(const Unit& u, const int (&R)[2], const int (&C)[2], unsigned (&ro)[2][2]) const {
        int cls, lp, cnt; pinfo(u, cls, lp, cnt);
#pragma unroll
        for (int h = 0; h < 2; ++h)
#pragma unroll
            for (int i = 0; i < 2; ++i) ro[h][i] = (unsigned)rinfo[(size_t)cls * CAP + lp * 256 + h * 128 + R[i]].x;
        asm volatile("" : "+v"(ro[0][0]), "+v"(ro[0][1]), "+v"(ro[1][0]), "+v"(ro[1][1]));
#pragma unroll
        for (int h = 0; h < 2; ++h)
#pragma unroll
            for (int i = 0; i < 2; ++i) { const int slot = lp * 256 + h * 128 + R[i]; const int tok = (slot < cnt) ? (int)ro[h][i] : 0; ro[h][i] = (unsigned)(tok * LDA + C[i]) * 2u; }
    }
    __device__ __forceinline__ const char* b_base(const Unit& u) const { int cls, lp, cnt; pinfo(u, cls, lp, cnt); const int e = (u.pn < 4) ? e_lo(cls) : e_hi(cls); return B + ((size_t)e * 1024 + (u.pn & 3) * 256) * LDB * 2; }
    __device__ __forceinline__ void epi_lds(AccT& acc, const Unit& u, int wr, int wc, int fr, int fq, LAS unsigned char* scr) const {
        int cls, lp, cnt; pinfo(u, cls, lp, cnt);
        int r0 = wr * 64 + fr; const int colb = (u.pn >> 2) * 512 + (u.pn & 3) * 128 + wc * 32 + 8 * fq; asm volatile("" : "+v"(r0));
        const SigC sk = sigc_make(1.0f); float k448 = 448.f; asm volatile("" : "+s"(k448));
        float gv[2][4], rv[2][4];
        { const LAS int* ri = (const LAS int*)(scr + r0 * 16) + (u.pn < 4 ? 1 : 2);
#pragma unroll
          for (int ai = 0; ai < 2; ++ai)
#pragma unroll
              for (int m = 0; m < 4; ++m) { gv[ai][m] = __int_as_float(ri[(ai * 128 + m * 16) * 4]); rv[ai][m] = __int_as_float(((const LAS int*)(scr + r0 * 16))[(ai * 128 + m * 16) * 4 + 3]); } }
#pragma unroll
        for (int ai = 0; ai < 2; ++ai)
#pragma unroll
            for (int m = 0; m < 4; ++m) { const int rr = r0 + ai * 128 + m * 16, slot = lp * 256 + rr; const bool live = slot < cnt;
                float gate = live ? gv[ai][m] : 0.f, rs = live ? rv[ai][m] : 0.f;
                gate *= rs;
                { float k16 = 16.0f; asm volatile("" : "+v"(k16)); gate *= k16; }
                f32x4 hq[2];
#pragma unroll
                for (int n = 0; n < 2; ++n) { const f32x4 a = acc[ai][0][m][n] * rs; const f32x4 sg = sig_odd4(a, sk) + 0.5f; f32x4 h = ((a * gate) * sg) * acc[ai][1][m][n];
#pragma unroll
                    for (int e = 0; e < 4; ++e) h[e] = __builtin_amdgcn_fmed3f(h[e], -k448, k448);
                    hq[n] = h; }
                u32x2 w; int t0 = __builtin_amdgcn_cvt_pk_fp8_f32(hq[0][0], hq[0][1], 0, false); t0 = __builtin_amdgcn_cvt_pk_fp8_f32(hq[0][2], hq[0][3], t0, true);
                int t1 = __builtin_amdgcn_cvt_pk_fp8_f32(hq[1][0], hq[1][1], 0, false); t1 = __builtin_amdgcn_cvt_pk_fp8_f32(hq[1][2], hq[1][3], t1, true); w.x = (unsigned)t0; w.y = (unsigned)t1;
                *(u32x2*)(hid + (size_t)(u.pm * 256 + rr) * 1024 + colb) = w; }
    }
};
struct ProbMB : MoeBase {
    static constexpr int NT = 8, LDA = 512, LDB = 256, BSEG = 4, SCALE_A = 0x7B7B7B7B, SCALE_B = 0x7B7B7B7B; static constexpr bool PERM = true, ALIGN = true, GATHER = true, F8 = true, PRE = true;
    const char* A; const char* B; bf16* xs;
    __device__ __forceinline__ void pre_next(const Unit& u, LAS unsigned char* scr, int wid, int lane) const {
        if (wid < 4) { int cls, lp, cnt; pinfo(u, cls, lp, cnt);
            __builtin_amdgcn_global_load_lds((const unsigned*)(rinfo + (size_t)cls * CAP + lp * 256 + wid * 64 + lane), (LAS unsigned*)(scr + wid * 1024), 16, 0, 0); } }
    __device__ __forceinline__ void a_rows_lds(const Unit& u, const int (&R)[2], const int (&C)[2], unsigned (&ro)[2][2], LAS unsigned char*) const { a_rows(u, R, C, ro); }
    __device__ __forceinline__ const char* a_gbase() const { return A; }
    __device__ __forceinline__ void a_rows(const Unit& u, const int (&R)[2], const int (&C)[2], unsigned (&ro)[2][2]) const {
#pragma unroll
        for (int h = 0; h < 2; ++h)
#pragma unroll
            for (int i = 0; i < 2; ++i) ro[h][i] = (unsigned)((u.pm * 256 + h * 128 + R[i]) * LDA + C[i]) * 2u; }
    __device__ __forceinline__ const char* a_base(const Unit& u) const { return A + (size_t)u.pm * 256 * LDA * 2; }
    __device__ __forceinline__ const char* b_base(const Unit& u) const { int cls, lp, cnt; pinfo(u, cls, lp, cnt); return B + ((size_t)e_lo(cls) * 1024 + u.pn * 256) * LDB * 2; }
    __device__ __forceinline__ long b_delta(const Unit& u) const { int cls, lp, cnt; pinfo(u, cls, lp, cnt); return (long)(e_hi(cls) - e_lo(cls)) * 1024 * LDB * 2 - 4 * 128; }
    __device__ __forceinline__ void epi_lds(AccT& acc, const Unit& u, int wr, int wc, int fr, int fq, LAS unsigned char* scr) const {
        int cls, lp, cnt; pinfo(u, cls, lp, cnt);
        int r0 = wr * 64 + fr; const int col0 = u.pn * 256 + wc * 32 + 8 * fq; asm volatile("" : "+v"(r0));
        int tk8[2][4];
#pragma unroll
        for (int ai = 0; ai < 2; ++ai)
#pragma unroll
            for (int m = 0; m < 4; ++m) tk8[ai][m] = *(const LAS int*)(scr + (r0 + ai * 128 + m * 16) * 16);
        int tok[2][4]; u32x4 xv[2][4][2];
#pragma unroll
        for (int ai = 0; ai < 2; ++ai)
#pragma unroll
            for (int m = 0; m < 4; ++m) { const int slot = lp * 256 + r0 + ai * 128 + m * 16; tok[ai][m] = (slot < cnt) ? tk8[ai][m] : -1; const bf16* xr = xs + (size_t)(tok[ai][m] < 0 ? 0 : tok[ai][m]) * D + col0;
#pragma unroll
                for (int bj = 0; bj < 2; ++bj) xv[ai][m][bj] = *(const u32x4*)(xr + bj * 128); }
#pragma unroll
        for (int ai = 0; ai < 2; ++ai) {
#pragma unroll
            for (int m = 0; m < 4; ++m) if (tok[ai][m] >= 0) { bf16* xr = xs + (size_t)tok[ai][m] * D + col0;
#pragma unroll
                for (int bj = 0; bj < 2; ++bj) { const u32x4 d = xv[ai][m][bj]; const f32x4 a0 = acc[ai][bj][m][0], a1 = acc[ai][bj][m][1];
                    u32x4 w; w.x = cvt_pk_bf16(bflo(d.x) + a0[0], bfhi(d.x) + a0[1]); w.y = cvt_pk_bf16(bflo(d.y) + a0[2], bfhi(d.y) + a0[3]);
                    w.z = cvt_pk_bf16(bflo(d.z) + a1[0], bfhi(d.z) + a1[1]); w.w = cvt_pk_bf16(bflo(d.w) + a1[2], bfhi(d.w) + a1[3]);
                    *(u32x4*)(xr + bj * 128) = w; } }
            asm volatile("" ::: "memory"); }
    }
};
__device__ __forceinline__ void moe_panel_table(const Frame& F, int l) {
    __syncthreads();
    if (F.tid < NCLS) { const int cls = F.tid; const unsigned* gc = F.ctl + CW_CNT + 64 * l;
        const unsigned cnt = __hip_atomic_load(gc + cls, __ATOMIC_RELAXED, __HIP_MEMORY_SCOPE_AGENT); const int k = (int)((cnt + 255u) >> 8);
        F.MISC[MW_CNT + cls] = cnt; F.MISC[MW_SCR + 8 + cls] = (unsigned)k;
        LDS_WAIT();
        int base = 0;
        for (int j = 0; j < NCLS; ++j) { const int kj = (int)F.MISC[MW_SCR + 8 + j]; base += (j < cls) ? kj : 0; }
        for (int j = 0; j < k; ++j) F.MISC[MW_PT + base + j] = ((unsigned)cls << 8) | (unsigned)j;
        if (cls == NCLS - 1) F.MISC[MW_NPAN] = (unsigned)(base + k); }
    __syncthreads();
}

__device__ __forceinline__ void tr_item(const float* W, int N, int k0, int n0, const float* gain, bf16* dst, int ldd, int drow0, int kofs, LAS float* scr, int lane) {
    float tv[32];
#pragma unroll
    for (int i = 0; i < 32; ++i) { const int kk = 2 * i + (lane >> 5); tv[i] = W[(size_t)(k0 + kk) * N + n0 + (lane & 31)]; }
    if (gain) {
#pragma unroll
        for (int i = 0; i < 32; ++i) tv[i] *= gain[k0 + 2 * i + (lane >> 5)]; }
#pragma unroll
    for (int i = 0; i < 32; ++i) { const int kk = 2 * i + (lane >> 5); scr[kk * 33 + (lane & 31)] = tv[i]; }
    LDS_WAIT();
    const int c = lane & 7;
#pragma unroll
    for (int j = 0; j < 4; ++j) { const int n = (lane >> 3) + 8 * j; const LAS float* s = scr + (8 * c) * 33 + n;
        u32x4 o; o.x = cvt_pk_bf16(s[0 * 33], s[1 * 33]); o.y = cvt_pk_bf16(s[2 * 33], s[3 * 33]); o.z = cvt_pk_bf16(s[4 * 33], s[5 * 33]); o.w = cvt_pk_bf16(s[6 * 33], s[7 * 33]);
        *(u32x4*)(dst + (size_t)(drow0 + n) * ldd + kofs + k0 + 8 * c) = o; }
    LDS_WAIT();
}
__device__ __forceinline__ void tr_item_f8(const float* W, int N, int k0, int n0, const float* gain, float scale, unsigned char* dst, int ldd, int drow0, LAS float* scr, int lane) {
    float tv[32];
#pragma unroll
    for (int i = 0; i < 32; ++i) { const int kk = 2 * i + (lane >> 5); tv[i] = W[(size_t)(k0 + kk) * N + n0 + (lane & 31)] * scale; }
    if (gain) {
#pragma unroll
        for (int i = 0; i < 32; ++i) tv[i] *= gain[k0 + 2 * i + (lane >> 5)]; }
    float k448 = 448.f; asm volatile("" : "+v"(k448));
#pragma unroll
    for (int i = 0; i < 32; ++i) { const int kk = 2 * i + (lane >> 5); scr[kk * 33 + (lane & 31)] = fminf(fmaxf(tv[i], -k448), k448); }
    LDS_WAIT();
    const int c = lane & 7;
#pragma unroll
    for (int j = 0; j < 4; ++j) { const int n = (lane >> 3) + 8 * j; const LAS float* s = scr + (8 * c) * 33 + n;
        int t0 = __builtin_amdgcn_cvt_pk_fp8_f32(s[0 * 33], s[1 * 33], 0, false); t0 = __builtin_amdgcn_cvt_pk_fp8_f32(s[2 * 33], s[3 * 33], t0, true);
        int t1 = __builtin_amdgcn_cvt_pk_fp8_f32(s[4 * 33], s[5 * 33], 0, false); t1 = __builtin_amdgcn_cvt_pk_fp8_f32(s[6 * 33], s[7 * 33], t1, true);
        u32x2 o; o.x = (unsigned)t0; o.y = (unsigned)t1;
        *(u32x2*)(dst + (size_t)(drow0 + n) * ldd + k0 + 8 * c) = o; }
    LDS_WAIT();
}
constexpr int CV_IN = 16 * 224, CV_A = 8 * 32, CV_B = 16 * 32, CV_O = 16 * 32, CV_W1 = 16 * 16 * 16, CV_W2 = 16 * 8 * 32, CV_PL = 4 * 2 * 4;
constexpr int CV_N0 = CV_PL, CV_N1 = CV_IN + 2 * CV_A + CV_B + CV_O, CV_N2 = 2 * CV_W1, CV_N3 = CV_W2;
__device__ __forceinline__ int conv_count(int grp) { return grp == 0 ? CV_N0 : grp == 1 ? CV_N1 : grp == 2 ? CV_N2 : CV_N3; }
__device__ __forceinline__ void conv_item(const Frame& F, int l, int grp, int r, LAS float* scr) {
    const float* const* in = F.in; unsigned char* ws = F.ws;
    if (grp == 0) { const int g = r >> 3, q = r & 7, kb = q >> 2, nb = q & 3;
        tr_item(in[13] + ((size_t)l * 4 + g) * 128 * 128, 128, kb * 64, nb * 32, nullptr, (bf16*)(ws + WS_PLT) + (size_t)g * 128 * 128, 128, nb * 32, 0, scr, F.lane); return; }
    if (grp == 1) {
        if (r < CV_IN) { const int kb = r / 224, nb = r % 224;
            const int n0 = nb * 32;
            if (n0 < 1536 || (n0 >= 3584 && n0 < 4096)) tr_item(in[2] + (size_t)l * D * INC, INC, kb * 64, n0, in[1] + (size_t)l * D, (bf16*)(ws + WS_WINT), 1024, n0, 0, scr, F.lane);
            else tr_item_f8(in[2] + (size_t)l * D * INC, INC, kb * 64, n0, in[1] + (size_t)l * D, 32.0f, ws + WS_WING8, 1024, n0 < 3584 ? n0 - 1536 : n0 - 2048, scr, F.lane);
            return; } r -= CV_IN;
        if (r < CV_A) { const int kb = r / 32, nb = r % 32; tr_item(in[4] + (size_t)l * W_A * D, D, kb * 64, nb * 32, nullptr, (bf16*)(ws + WS_WCAT), 2048, nb * 32, 0, scr, F.lane); return; } r -= CV_A;
        if (r < CV_B) { const int kb = r / 32, nb = r % 32; tr_item(in[12] + (size_t)l * W_B * D, D, kb * 64, nb * 32, nullptr, (bf16*)(ws + WS_WCAT), 2048, nb * 32, 512, scr, F.lane); return; } r -= CV_B;
        if (r < CV_A) { const int kb = r / 32, nb = r % 32; tr_item(in[15] + (size_t)l * W_C * D, D, kb * 64, nb * 32, nullptr, (bf16*)(ws + WS_WCAT), 2048, nb * 32, 1536, scr, F.lane); return; } r -= CV_A;
        { const int kb = r / 32, nb = r % 32; tr_item(in[16] + (size_t)l * D * D, D, kb * 64, nb * 32, nullptr, (bf16*)(ws + WS_WOT), 1024, nb * 32, 0, scr, F.lane); } return; }
    if (grp == 2) { const int sel = r / CV_W1; r -= sel * CV_W1; const int e = r >> 8, q = r & 255, kb = q >> 4, nb = q & 15, n0 = nb * 32;
        tr_item_f8(in[sel ? 23 : 22] + ((size_t)l * NE + e) * D * DE, DE, kb * 64, n0, in[17] + (size_t)l * D, 64.0f, ws + WS_BAT + (size_t)e * 1024 * 1024, 1024, 256 * (n0 >> 7) + 128 * sel + (n0 & 127), scr, F.lane); return; }
    { const int e = r >> 8, q = r & 255, kb = q >> 5, nb = q & 31;
        tr_item_f8(in[24] + ((size_t)l * NE + e) * DE * D, D, kb * 64, nb * 32, nullptr, 16.0f, ws + WS_W2T + (size_t)e * 1024 * 512, 512, nb * 32, scr, F.lane); }
}
__device__ __forceinline__ void convert_weights(const Frame& F, int l, int mask) {
    LAS float* scr = (LAS float*)(F.lds + F.wave * 8448);
    const int gw = F.c * NWAVES + F.wave, NGW = F.G * NWAVES;
#pragma unroll 1
    for (int grp = 0; grp < 4; ++grp) if (mask & (1 << grp)) { const int n = conv_count(grp); for (int it = gw; it < n; it += NGW) conv_item(F, l, grp, it, scr); }
}
__device__ __forceinline__ void convert_queue(const Frame& F, int l, int grp, unsigned* counter) {
    LAS float* scr = (LAS float*)(F.lds + F.wave * 8448); const int n = conv_count(grp);
    for (;;) {
        __syncthreads();
        if (F.tid == 0) F.MISC[MW_SCR] = __hip_atomic_fetch_add(counter, 8u, __ATOMIC_RELAXED, __HIP_MEMORY_SCOPE_AGENT);
        __syncthreads();
        const int base = (int)F.MISC[MW_SCR];
        if (base >= n) break;
        const int it = base + F.wave; if (it < n) conv_item(F, l, grp, it, scr);
    }
}
__device__ __forceinline__ void norm_row_prep(const float* xrow32, bf16* xsrow, unsigned char* orow8, float* rstd_out, int lane) {
    f32x4 v[4]; float s = 0.f;
    if (xrow32) { const f32x4* xr = (const f32x4*)xrow32 + lane;
#pragma unroll
        for (int j = 0; j < 4; ++j) v[j] = xr[64 * j];
        u32x2* o8 = (u32x2*)xsrow + lane;
#pragma unroll
        for (int j = 0; j < 4; ++j) { u32x2 w; w.x = cvt_pk_bf16(v[j].x, v[j].y); w.y = cvt_pk_bf16(v[j].z, v[j].w); o8[64 * j] = w; v[j] = (f32x4){bflo(w.x), bfhi(w.x), bflo(w.y), bfhi(w.y)}; } }
    else { const u32x2* xr = (const u32x2*)xsrow + lane;
#pragma unroll
        for (int j = 0; j < 4; ++j) { const u32x2 d = xr[64 * j]; v[j] = (f32x4){bflo(d.x), bfhi(d.x), bflo(d.y), bfhi(d.y)}; } }
#pragma unroll
    for (int j = 0; j < 4; ++j) s += (v[j].x * v[j].x + v[j].y * v[j].y) + (v[j].z * v[j].z + v[j].w * v[j].w);
    const float rstd = rsqrtf(wave_sum(s) * (1.f / D) + EPS);
    if (lane == 0) *rstd_out = rstd;
    unsigned* q8 = (unsigned*)orow8 + lane;
    const float r2 = 2.0f * rstd;
#pragma unroll
    for (int j = 0; j < 4; ++j) { int p = __builtin_amdgcn_cvt_pk_fp8_f32(r2 * v[j].x, r2 * v[j].y, 0, false); p = __builtin_amdgcn_cvt_pk_fp8_f32(r2 * v[j].z, r2 * v[j].w, p, true); q8[64 * j] = (unsigned)p; }
}
__device__ __forceinline__ void phase_n1(const Frame& F, int l) {
    convert_weights(F, l, l == 0 ? 15 : 8);
    { const float* g2 = F.in[17] + (size_t)l * D; const float* wg = F.in[18] + (size_t)l * D * NG; const float* we = F.in[20] + (size_t)l * D * NE; bf16* gwp = (bf16*)(F.ws + WS_GW);
      for (int idx = F.c * NTHR + F.tid; idx < 20 * 1024; idx += F.G * NTHR) { const int j = idx >> 10, k = idx & 1023; const float v = g2[k] * (j < 4 ? wg[k * NG + j] : we[k * NE + (j - 4)]);
          const bf16 hi = f2bf(v); gwp[idx] = hi; gwp[20 * 1024 + idx] = f2bf(v - bf2f(hi)); } }
    const float* x32 = (l == 0) ? F.in[0] : nullptr; bf16* xs = (bf16*)(F.ws + WS_XS); float* rs = (float*)(F.ws + WS_RSTD);
    const int gw = F.c * NWAVES + F.wave, NGW = F.G * NWAVES;
    for (int m = gw; m < T; m += NGW) norm_row_prep(x32 ? x32 + (size_t)m * D : nullptr, xs + (size_t)m * D, F.ws + (m < TH ? WS_XB8A : WS_XB8B) + (size_t)(m < TH ? m : m - TH) * D, rs + m, F.lane);
}
__device__ __forceinline__ void phase_final(const Frame& F) {
    const float* g = F.in[25]; const int gw = F.c * NWAVES + F.wave, NGW = F.G * NWAVES;
    f32x4 gv[4];
#pragma unroll
    for (int j = 0; j < 4; ++j) gv[j] = ((const f32x4*)g)[F.lane + 64 * j];
    const bf16* xs = (const bf16*)(F.ws + WS_XS);
    for (int m = gw; m < T; m += NGW) { const u32x2* xi = (const u32x2*)(xs + (size_t)m * D) + F.lane; f32x4* xr = (f32x4*)(F.out + (size_t)m * D) + F.lane; f32x4 v[4]; float s = 0.f;
#pragma unroll
        for (int j = 0; j < 4; ++j) { const u32x2 d = xi[64 * j]; v[j] = (f32x4){bflo(d.x), bfhi(d.x), bflo(d.y), bfhi(d.y)}; s += (v[j].x * v[j].x + v[j].y * v[j].y) + (v[j].z * v[j].z + v[j].w * v[j].w); }
        const float rstd = rsqrtf(wave_sum(s) * (1.f / D) + EPS);
#pragma unroll
        for (int j = 0; j < 4; ++j) xr[64 * j] = v[j] * rstd * gv[j]; }
}
constexpr int RT_ROWB = 2064;
constexpr int RT_HI = 0, RT_LO = 20 * RT_ROWB, RT_HIST = 2 * 20 * RT_ROWB, RT_GBASE = RT_HIST + 128, RT_RTMP = RT_HIST + 256, RT_LG = RT_RTMP + 2048, RT_RS = RT_LG + 8 * 16 * 32 * 4;
__device__ __forceinline__ void phase_router(const Frame& F, int l, int rep = 0) {
    LAS unsigned char* lds = F.lds;
    LAS unsigned* hist = (LAS unsigned*)(lds + RT_HIST); LAS unsigned* gbase = (LAS unsigned*)(lds + RT_GBASE); LAS i32x4* rtmp = (LAS i32x4*)(lds + RT_RTMP);
    LAS float* LG = (LAS float*)(lds + RT_LG) + F.wave * 16 * 32; LAS float* RS = (LAS float*)(lds + RT_RS) + F.wave * 16;
    const float* g2 = F.in[17] + (size_t)l * D; const float* wg = F.in[18] + (size_t)l * D * NG; const float* we = F.in[20] + (size_t)l * D * NE;
    const float* bg = F.in[19] + (size_t)l * NG; const float* be = F.in[21] + (size_t)l * NE;
    __syncthreads();
    { const bf16* gwp = (const bf16*)(F.ws + WS_GW);
      for (int p = F.tid; p < 2 * 20 * 128; p += NTHR) { const int hl = p / 2560, r = p - hl * 2560, j = r >> 7, c16 = r & 127;
          *(LAS u32x4*)(lds + (hl ? RT_LO : RT_HI) + j * RT_ROWB + c16 * 16) = *(const u32x4*)(gwp + (size_t)hl * 20480 + j * 1024 + c16 * 8); } }
    const bf16* x = (const bf16*)(F.ws + WS_XS); bf16* h2 = (bf16*)(F.ws + WS_XB); i32x4* rinfo = (i32x4*)(F.ws + (rep ? WS_ZH + 112 * MiB : WS_RINFO)); unsigned* gcnt = F.ctl + CW_CNT + 64 * (l + 2 * rep);
    const int lane = F.lane, fr = lane & 15, fq = lane >> 4;
    for (int blk = F.c; blk < T / 128; blk += F.G) {
        if (F.tid < 32) hist[F.tid] = 0u;
        __syncthreads();
        const int row = blk * 128 + F.wave * 16 + fr;
        const bf16* xr = x + (size_t)row * D + 16 * fq; unsigned char* hr = (unsigned char*)h2 + (size_t)row * D + 16 * fq;
        f32x4 d0 = (f32x4){0.f, 0.f, 0.f, 0.f}, d1 = d0; float ss = 0.f;
        const bool n1ok = fr < 4;
#pragma unroll 1
        for (int kh = 0; kh < 2; ++kh) {
        u32x4 hv[16];
#pragma unroll
        for (int i = 0; i < 16; ++i) hv[i] = *(const u32x4*)(xr + 64 * (8 * kh + (i >> 1)) + 8 * (i & 1));
#pragma unroll
        for (int kq = 0; kq < 8; ++kq) { const int kp = 8 * kh + kq;
            const u32x4 hA = hv[2 * kq], hB = hv[2 * kq + 1];
            u32x4 q;
#pragma unroll
            for (int sst = 0; sst < 2; ++sst) { const u32x4 hi = sst ? hB : hA;
                const f32x4 v0 = (f32x4){bflo(hi.x), bfhi(hi.x), bflo(hi.y), bfhi(hi.y)}, v1 = (f32x4){bflo(hi.z), bfhi(hi.z), bflo(hi.w), bfhi(hi.w)};
                ss += (v0.x * v0.x + v0.y * v0.y) + (v0.z * v0.z + v0.w * v0.w) + (v1.x * v1.x + v1.y * v1.y) + (v1.z * v1.z + v1.w * v1.w);
                int t0 = __builtin_amdgcn_cvt_pk_fp8_f32(v0.x, v0.y, 0, false); t0 = __builtin_amdgcn_cvt_pk_fp8_f32(v0.z, v0.w, t0, true);
                int t1 = __builtin_amdgcn_cvt_pk_fp8_f32(v1.x, v1.y, 0, false); t1 = __builtin_amdgcn_cvt_pk_fp8_f32(v1.z, v1.w, t1, true);
                if (sst) { q.z = (unsigned)t0; q.w = (unsigned)t1; } else { q.x = (unsigned)t0; q.y = (unsigned)t1; }
                const bf16x8 ah = __builtin_bit_cast(bf16x8, hi);
                const int bo = (64 * kp + 16 * fq + 8 * sst) * 2;
                const bf16x8 bh0 = *(const LAS bf16x8*)(lds + RT_HI + fr * RT_ROWB + bo), bl0 = *(const LAS bf16x8*)(lds + RT_LO + fr * RT_ROWB + bo);
                bf16x8 bh1 = (bf16x8){0, 0, 0, 0, 0, 0, 0, 0}, bl1 = bh1;
                if (n1ok) { bh1 = *(const LAS bf16x8*)(lds + RT_HI + (16 + fr) * RT_ROWB + bo); bl1 = *(const LAS bf16x8*)(lds + RT_LO + (16 + fr) * RT_ROWB + bo); }
                d0 = __builtin_amdgcn_mfma_f32_16x16x32_bf16(ah, bh0, d0, 0, 0, 0); d0 = __builtin_amdgcn_mfma_f32_16x16x32_bf16(ah, bl0, d0, 0, 0, 0);
                d1 = __builtin_amdgcn_mfma_f32_16x16x32_bf16(ah, bh1, d1, 0, 0, 0); d1 = __builtin_amdgcn_mfma_f32_16x16x32_bf16(ah, bl1, d1, 0, 0, 0); }
            *(u32x4*)(hr + 64 * kp) = q;
        } }
        ss += __builtin_bit_cast(float, __builtin_amdgcn_ds_bpermute((lane ^ 16) << 2, __builtin_bit_cast(int, ss))); ss += __builtin_bit_cast(float, __builtin_amdgcn_ds_bpermute((lane ^ 32) << 2, __builtin_bit_cast(int, ss)));
        const float rstd = rsqrtf(ss * (1.f / D) + EPS);
        if (fq == 0) RS[fr] = rstd;
#pragma unroll
        for (int r = 0; r < 4; ++r) { LG[(4 * fq + r) * 32 + fr] = d0[r]; LG[(4 * fq + r) * 32 + 16 + fr] = d1[r]; }
        LDS_WAIT();
        if (lane < 16) {
            const float rs = RS[lane]; float lg[20];
#pragma unroll
            for (int q = 0; q < 20; ++q) lg[q] = LG[lane * 32 + q] * rs + (q < 4 ? bg[q] : be[q - 4]);
#pragma unroll
            for (int q = 0; q < 20; ++q) asm volatile("" : "+v"(lg[q]));
            int gi = 0; float mx = lg[0];
#pragma unroll
            for (int j = 1; j < 4; ++j) if (lg[j] > mx) { mx = lg[j]; gi = j; }
            float den = 0.f;
#pragma unroll
            for (int j = 0; j < 4; ++j) den += __expf(lg[j] - mx);
            const float gp = 1.0f / den;
            float el[4];
#pragma unroll
            for (int j = 0; j < 4; ++j) el[j] = (gi == 0) ? lg[4 + j] : (gi == 1) ? lg[8 + j] : (gi == 2) ? lg[12 + j] : lg[16 + j];
            int i1 = 0; float v1 = el[0];
#pragma unroll
            for (int j = 1; j < 4; ++j) if (el[j] > v1) { v1 = el[j]; i1 = j; }
            int i2 = -1; float v2 = 0.f;
#pragma unroll
            for (int j = 0; j < 4; ++j) if (j != i1 && (i2 < 0 || el[j] > v2)) { i2 = j; v2 = el[j]; }
            const float e2 = __expf(v2 - v1); const float p1 = gp / (1.0f + e2), p2 = gp * e2 / (1.0f + e2);
            const int lo_ = i1 < i2 ? i1 : i2, hi_ = i1 < i2 ? i2 : i1; const float glo = i1 < i2 ? p1 : p2, ghi = i1 < i2 ? p2 : p1;
            const int pidx = (lo_ == 0) ? hi_ - 1 : (lo_ == 1 ? hi_ + 1 : 5); const int cls = gi * 6 + pidx;
            const unsigned ls = atomicAdd((unsigned*)(hist + cls), 1u);
            rtmp[F.wave * 16 + lane] = (i32x4){cls | ((int)ls << 8), __float_as_int(glo), __float_as_int(ghi), __float_as_int(rs)};
        }
        __syncthreads();
        if (F.tid < NCLS) gbase[F.tid] = __hip_atomic_fetch_add(gcnt + F.tid, hist[F.tid], __ATOMIC_RELAXED, __HIP_MEMORY_SCOPE_AGENT);
        __syncthreads();
        if (F.tid < 128) { const i32x4 r = rtmp[F.tid]; const int cls = r.x & 255; const unsigned slot = gbase[cls] + (unsigned)(r.x >> 8); rinfo[(size_t)cls * CAP + slot] = (i32x4){blk * 128 + F.tid, r.y, r.z, r.w}; }
        __syncthreads();
    }
}

constexpr int L_CU = 0, L_PW = 38912, L_PC = 73728;
__device__ __forceinline__ void stage_pad128(const bf16* src, LAS unsigned char* dst, int tid) {
    u32x4 v[4];
#pragma unroll
    for (int i = 0; i < 4; ++i) { const int p = tid + i * NTHR; v[i] = *(const u32x4*)(src + (p >> 4) * 128 + (p & 15) * 8); }
#pragma unroll
    for (int i = 0; i < 4; ++i) { const int p = tid + i * NTHR; *(LAS u32x4*)(dst + (p >> 4) * 272 + (p & 15) * 16) = v[i]; }
}
constexpr int L2_RS = 288;
constexpr int L2_WI = 0, L2_WR = 18432, L2_WAGG = 36864, L2_OT = 38912, L2_CST = 40960, L2_XT = 41984, L2_XTB = 37888;
struct LruCtx { int w, fr, fq; bf16* yrow; };
__device__ __forceinline__ float dpp_shr(float oldv, float v, int d) {
    int r;
    switch (d) { case 1: r = __builtin_amdgcn_update_dpp(__builtin_bit_cast(int, oldv), __builtin_bit_cast(int, v), 0x111, 0xf, 0xf, false); break;
                 case 2: r = __builtin_amdgcn_update_dpp(__builtin_bit_cast(int, oldv), __builtin_bit_cast(int, v), 0x112, 0xf, 0xf, false); break;
                 case 4: r = __builtin_amdgcn_update_dpp(__builtin_bit_cast(int, oldv), __builtin_bit_cast(int, v), 0x114, 0xf, 0xf, false); break;
                 default: r = __builtin_amdgcn_update_dpp(__builtin_bit_cast(int, oldv), __builtin_bit_cast(int, v), 0x118, 0xf, 0xf, false); break; }
    return __builtin_bit_cast(float, r);
}
#define LRU_RD12(F, G, WADDR, XADDR, KK) asm volatile("ds_read_b128 %0, %12 offset:%14\n\tds_read_b128 %1, %12 offset:%15\n\tds_read_b128 %2, %12 offset:%16\n\tds_read_b128 %3, %12 offset:%17\n\t" \
        "ds_read_b128 %4, %12 offset:%18\n\tds_read_b128 %5, %12 offset:%19\n\tds_read_b128 %6, %12 offset:%20\n\tds_read_b128 %7, %12 offset:%21\n\t" \
        "ds_read_b128 %8, %13 offset:%22\n\tds_read_b128 %9, %13 offset:%23\n\tds_read_b128 %10, %13 offset:%24\n\tds_read_b128 %11, %13 offset:%25\n\ts_waitcnt lgkmcnt(0)" \
        : "=&v"(F[0]), "=&v"(F[1]), "=&v"(F[2]), "=&v"(F[3]), "=&v"(F[4]), "=&v"(F[5]), "=&v"(F[6]), "=&v"(F[7]), "=&v"(G[0]), "=&v"(G[1]), "=&v"(G[2]), "=&v"(G[3]) : "v"(WADDR), "v"(XADDR), \
          "n"(L2_WR + (KK) * 4352), "n"(L2_WR + (KK) * 4352 + 64), "n"(L2_WR + (KK) * 4352 + 128), "n"(L2_WR + (KK) * 4352 + 192), \
          "n"(L2_WI + (KK) * 4608), "n"(L2_WI + (KK) * 4608 + 64), "n"(L2_WI + (KK) * 4608 + 128), "n"(L2_WI + (KK) * 4608 + 192), \
          "n"((KK) * 288), "n"((KK) * 288 + 64), "n"((KK) * 288 + 128), "n"((KK) * 288 + 192) : "memory")
struct LruSt { float A[4], H[4]; u32x2 by; };
__device__ __forceinline__ void lru_out(const LruCtx& X, LAS unsigned char* lds, const LruSt& S, int ch, int bprev, int bcur, float (&Hs)[4]) {
    const int fr = X.fr, fq = X.fq, w = X.w;
#pragma unroll
    for (int j = 0; j < 8; ++j) { const int q = w + j; const int slot = (q < 8) ? bprev * 8 + q : bcur * 8 + q - 8;
        const LAS float* p = (const LAS float*)(lds + L2_WAGG) + slot * 32 + 8 * fq; const f32x4 v0 = *(const LAS f32x4*)p, v1 = *(const LAS f32x4*)(p + 4);
        Hs[0] = v0.x * Hs[0] + v0.y; Hs[1] = v0.z * Hs[1] + v0.w; Hs[2] = v1.x * Hs[2] + v1.y; Hs[3] = v1.z * Hs[3] + v1.w; }
    float y[4]; const float g0 = bflo(S.by.x), g1 = bfhi(S.by.x), g2 = bflo(S.by.y), g3 = bfhi(S.by.y);
#pragma unroll
    for (int r = 0; r < 4; ++r) { const float h = S.H[r] + S.A[r] * Hs[r];
        y[r] = h * fgelu(r == 0 ? g0 : r == 1 ? g1 : r == 2 ? g2 : g3); }
    u32x2 o; o.x = cvt_pk_bf16(y[0], y[1]); o.y = cvt_pk_bf16(y[2], y[3]);
    *(u32x2*)(X.yrow + ((size_t)ch * 128 + fr) * 2048 + 4 * fq) = o;
}
__device__ __forceinline__ void lru_taps(const LruCtx& X, int tbx, f32x4& ar, f32x4& ai, const bf16x8 (&wk)[8]) {
    const f32x4 z4 = (f32x4){0.f, 0.f, 0.f, 0.f}; ar = z4; ai = z4;
    const unsigned xaddr = (unsigned)(L2_XT + tbx * L2_XTB + (16 * X.w + X.fr) * L2_RS + 16 * X.fq);
    const unsigned waddr = (unsigned)(X.fr * L2_RS + 16 * X.fq);
#define LRU_RD12(F, G, WADDR, XADDR, KK) asm volatile("ds_read_b128 %0, %12 offset:%14\n\tds_read_b128 %1, %12 offset:%15\n\tds_read_b128 %2, %12 offset:%16\n\tds_read_b128 %3, %12 offset:%17\n\t" \
        "ds_read_b128 %4, %12 offset:%18\n\tds_read_b128 %5, %12 offset:%19\n\tds_read_b128 %6, %12 offset:%20\n\tds_read_b128 %7, %12 offset:%21\n\t" \
        "ds_read_b128 %8, %13 offset:%22\n\tds_read_b128 %9, %13 offset:%23\n\tds_read_b128 %10, %13 offset:%24\n\tds_read_b128 %11, %13 offset:%25\n\ts_waitcnt lgkmcnt(0)" \
        : "=&v"(F[0]), "=&v"(F[1]), "=&v"(F[2]), "=&v"(F[3]), "=&v"(F[4]), "=&v"(F[5]), "=&v"(F[6]), "=&v"(F[7]), "=&v"(G[0]), "=&v"(G[1]), "=&v"(G[2]), "=&v"(G[3]) : "v"(WADDR), "v"(XADDR), \
          "n"(L2_WR + (KK) * 4608), "n"(L2_WR + (KK) * 4608 + 64), "n"(L2_WR + (KK) * 4608 + 128), "n"(L2_WR + (KK) * 4608 + 192), \
          "n"(L2_WI + (KK) * 4608), "n"(L2_WI + (KK) * 4608 + 64), "n"(L2_WI + (KK) * 4608 + 128), "n"(L2_WI + (KK) * 4608 + 192), \
          "n"((KK) * 288), "n"((KK) * 288 + 64), "n"((KK) * 288 + 128), "n"((KK) * 288 + 192))
#define LRU_TAPR(KK) do { bf16x8 f_[8], g_[4]; LRU_RD12(f_, g_, waddr, xaddr, KK); \
        _Pragma("unroll") for (int i = 0; i < 4; ++i) { ar = __builtin_amdgcn_mfma_f32_16x16x32_bf16(f_[i], g_[i], ar, 0, 0, 0); ai = __builtin_amdgcn_mfma_f32_16x16x32_bf16(f_[4 + i], g_[i], ai, 0, 0, 0); } } while (0)
    LRU_TAPR(0); LRU_TAPR(1); LRU_TAPR(2);
    { bf16x8 g_[4];
      asm volatile("ds_read_b128 %0, %4 offset:%5\n\tds_read_b128 %1, %4 offset:%6\n\tds_read_b128 %2, %4 offset:%7\n\tds_read_b128 %3, %4 offset:%8\n\ts_waitcnt lgkmcnt(0)"
                   : "=&v"(g_[0]), "=&v"(g_[1]), "=&v"(g_[2]), "=&v"(g_[3]) : "v"(xaddr), "n"(3 * 288), "n"(3 * 288 + 64), "n"(3 * 288 + 128), "n"(3 * 288 + 192));
#pragma unroll
      for (int i = 0; i < 4; ++i) { ar = __builtin_amdgcn_mfma_f32_16x16x32_bf16(wk[i], g_[i], ar, 0, 0, 0); ai = __builtin_amdgcn_mfma_f32_16x16x32_bf16(wk[4 + i], g_[i], ai, 0, 0, 0); } }
#undef LRU_TAPR
#undef LRU_RD12
}
__device__ __forceinline__ void lru_chunk(const LruCtx& X, LAS unsigned char* lds, u32x2& byraw, LruSt& S, f32x4& arN, f32x4& aiN, int ch, int tb, int tb1, int tb2, float (&Hc)[4],
                                          const char* zdma, const unsigned (&doff)[5], const char* byn, unsigned loff8, unsigned xsub, const bf16x8 (&wk)[8]) {
    const int fr = X.fr, fq = X.fq, w = X.w;
    if (ch > 0) lru_out(X, lds, S, ch - 1, tb1, tb2, Hc);
    { LAS unsigned char* dst = lds + L2_XT + (tb2 * L2_XTB) + w * 1024;
#pragma unroll
      for (int j = 0; j < 5; ++j) { const int jj = (w + 8 * j < 37) ? j : 3; __builtin_amdgcn_global_load_lds((const unsigned*)(zdma + doff[jj]), (LAS unsigned*)(dst + jj * 8192), 16, 0, 0); } }
    const u32x2 bynext = *(const u32x2*)(byn + loff8);
    u32x2 xv[4];
#pragma unroll
    for (int kk = 0; kk < 4; ++kk) xv[kk] = *(const LAS u32x2*)(lds + L2_XT + tb * L2_XTB + (16 * w + fr + kk) * L2_RS + xsub);
    f32x4 arX, aiX; lru_taps(X, tb1, arX, aiX, wk);
    float A[4], H[4];
#pragma unroll
    for (int r = 0; r < 4; ++r) { const LAS float* cs = (const LAS float*)(lds + L2_CST) + (4 * fq + r) * 8; const f32x4 c0 = *(const LAS f32x4*)cs, c1 = *(const LAS f32x4*)(cs + 4);
        const float x0 = (r & 1) ? bfhi(r < 2 ? xv[0].x : xv[0].y) : bflo(r < 2 ? xv[0].x : xv[0].y), x1 = (r & 1) ? bfhi(r < 2 ? xv[1].x : xv[1].y) : bflo(r < 2 ? xv[1].x : xv[1].y);
        const float x2 = (r & 1) ? bfhi(r < 2 ? xv[2].x : xv[2].y) : bflo(r < 2 ? xv[2].x : xv[2].y), x3 = (r & 1) ? bfhi(r < 2 ? xv[3].x : xv[3].y) : bflo(r < 2 ? xv[3].x : xv[3].y);
        const float xbr = c0.z + c1.x * x0 + c1.y * x1 + c1.z * x2 + c1.w * x3;
        const float rr = fsig(arN[r] + c0.x), ii = fsig(aiN[r] + c0.y); const float a = __builtin_amdgcn_exp2f(rr * c0.w);
        A[r] = a; H[r] = __builtin_amdgcn_sqrtf(fmaxf(1.0f - a * a, 0.f)) * (ii * xbr); }
#define LRU_STEP(D) "v_fmac_f32_dpp %4, %4, %0 row_shr:" #D " row_mask:0xf bank_mask:0xf\n\tv_fmac_f32_dpp %5, %5, %1 row_shr:" #D " row_mask:0xf bank_mask:0xf\n\t" \
                    "v_fmac_f32_dpp %6, %6, %2 row_shr:" #D " row_mask:0xf bank_mask:0xf\n\tv_fmac_f32_dpp %7, %7, %3 row_shr:" #D " row_mask:0xf bank_mask:0xf\n\t" \
                    "v_mul_f32_dpp %0, %0, %0 row_shr:" #D " row_mask:0xf bank_mask:0xf\n\tv_mul_f32_dpp %1, %1, %1 row_shr:" #D " row_mask:0xf bank_mask:0xf\n\t" \
                    "v_mul_f32_dpp %2, %2, %2 row_shr:" #D " row_mask:0xf bank_mask:0xf\n\tv_mul_f32_dpp %3, %3, %3 row_shr:" #D " row_mask:0xf bank_mask:0xf\n\t"
    asm volatile("s_nop 1\n\t" LRU_STEP(1) LRU_STEP(2) LRU_STEP(4) LRU_STEP(8)
                 : "+v"(A[0]), "+v"(A[1]), "+v"(A[2]), "+v"(A[3]), "+v"(H[0]), "+v"(H[1]), "+v"(H[2]), "+v"(H[3]));
#undef LRU_STEP
    LAS float* WAGG = (LAS float*)(lds + L2_WAGG) + tb * 256;
    if (fr == 15 && ch >= 0) { *(LAS f32x4*)(WAGG + w * 32 + 8 * fq) = (f32x4){A[0], H[0], A[1], H[1]}; *(LAS f32x4*)(WAGG + w * 32 + 8 * fq + 4) = (f32x4){A[2], H[2], A[3], H[3]}; }
    asm volatile("s_waitcnt vmcnt(0) lgkmcnt(0)" ::: "memory");
    __builtin_amdgcn_s_barrier(); asm volatile("" ::: "memory");
#pragma unroll
    for (int r = 0; r < 4; ++r) { S.A[r] = A[r]; S.H[r] = H[r]; }
    S.by = byraw; byraw = bynext; arN = arX; aiN = aiX;
}
__device__ __forceinline__ void lru_seq_unit(const Frame& F, int l, int bl, int hd, int ct, const bf16* zh, bf16* yh) {
    int lane0_; asm volatile("v_mbcnt_lo_u32_b32 %0, -1, 0\n\tv_mbcnt_hi_u32_b32 %0, -1, %0" : "=v"(lane0_));
    LAS unsigned char* lds = F.lds; const int lane = lane0_, w = F.wave, tid = w * 64 + lane, fr = lane & 15, fq = lane >> 4;
    const float* cw = F.in[5] + (size_t)l * 4 * W_B + hd * 128; const float* cb = F.in[6] + (size_t)l * W_B + hd * 128;
    const float* wa = F.in[7] + ((size_t)l * 8 + hd) * 128 * 128 + 16 * ct; const float* wx = F.in[9] + ((size_t)l * 8 + hd) * 128 * 128 + 16 * ct;
    LAS float* CST = (LAS float*)(lds + L2_CST);
    const int ks0 = ct >> 1;
    const size_t tl0 = (size_t)bl * SEQ;
    const char* zt = (const char*)(zh + tl0 * INC + C_BX + hd * 128) - (size_t)3 * INC * 2;
    {
    __syncthreads();
    { const int k = tid >> 2, n4 = (tid & 3) * 4; const f32x4 wa4 = *(const f32x4*)(wa + k * 128 + n4), wx4 = *(const f32x4*)(wx + k * 128 + n4);
      float c4[4];
#pragma unroll
      for (int kk = 0; kk < 4; ++kk) c4[kk] = cw[kk * W_B + k];
      const int slot = ((k >> 5) - ks0) & 3; LAS unsigned char* wbase = lds + n4 * L2_RS + (32 * slot + (k & 31)) * 2;
#pragma unroll
      for (int kk = 0; kk < 4; ++kk)
#pragma unroll
          for (int j = 0; j < 4; ++j) { *(LAS bf16*)(wbase + L2_WR + (kk * 16 + j) * L2_RS) = f2bf(c4[kk] * wa4[j]); *(LAS bf16*)(wbase + L2_WI + (kk * 16 + j) * L2_RS) = f2bf(c4[kk] * wx4[j]); } }
    { LAS float* PART = (LAS float*)(lds + L2_OT);
      const int o = tid & 31, part = tid >> 5, g = o >> 4, n = o & 15; const float* W = g ? wx : wa; float cbv[8], wv[8];
#pragma unroll
      for (int i = 0; i < 8; ++i) { cbv[i] = cb[8 * part + i]; wv[i] = W[(8 * part + i) * 128 + n]; }
      float a = 0.f;
#pragma unroll
      for (int i = 0; i < 8; ++i) a += cbv[i] * wv[i];
      PART[part * 32 + o] = a; }
    { LAS unsigned char* dst = lds + L2_XT + w * 1024;
      int lane3; asm volatile("v_mbcnt_lo_u32_b32 %0, -1, 0\n\tv_mbcnt_hi_u32_b32 %0, -1, %0" : "=v"(lane3));
#pragma unroll 1
      for (int j = 0; j < 5; ++j) if (w + 8 * j < 37) { int p = 64 * (w + 8 * j) + lane3; if (p > 131 * 18 - 1) p = 131 * 18 - 1; const int row = p / 18; int c = p - row * 18; if (c > 15) c = 15; c = (c + 4 * ks0) & 15;
          __builtin_amdgcn_global_load_lds((const unsigned*)(zt + (unsigned)((row < 3 ? 3 : row) * INC + c * 8) * 2u), (LAS unsigned*)(dst + j * 8192), 16, 0, 0); } }
    asm volatile("s_waitcnt vmcnt(0)" ::: "memory");
    { int lz; asm volatile("v_mbcnt_lo_u32_b32 %0, -1, 0\n\tv_mbcnt_hi_u32_b32 %0, -1, %0" : "=v"(lz));
      if (w == 0 && lz < 54) { const unsigned zz = (unsigned)lz >> 31; *(LAS u32x4*)(lds + L2_XT + lz * 16) = (u32x4){zz, zz, zz, zz}; } }
    __syncthreads();
    if (tid < 32) { const int g = tid >> 4, n = tid & 15; float a = (g ? F.in[10] : F.in[8])[(size_t)l * W_B + hd * 128 + 16 * ct + n];
        const LAS float* PART = (const LAS float*)(lds + L2_OT);
#pragma unroll
        for (int q = 0; q < 16; ++q) a += PART[q * 32 + tid];
        CST[n * 8 + g] = a; }
    else if (tid < 48) { const int n = tid - 32, c = 16 * ct + n; CST[n * 8 + 2] = cb[c];
#pragma unroll
        for (int kk = 0; kk < 4; ++kk) CST[n * 8 + 4 + kk] = cw[kk * W_B + c];
        const float lam = F.in[11][(size_t)l * W_B + hd * 128 + c]; const float ex = __expf(-lam); const float sp = (-lam > 20.f) ? -lam : (ex < 0.05f ? ex * (1.0f - ex * (0.5f - ex * (0.33333333f - 0.25f * ex))) : __logf(1.0f + ex)); CST[n * 8 + 3] = -8.0f * sp * 1.4426950408889634f; }
    __syncthreads();
    }
    int lane2; asm volatile("v_mbcnt_lo_u32_b32 %0, -1, 0\n\tv_mbcnt_hi_u32_b32 %0, -1, %0" : "=v"(lane2));
    const int fr2 = lane2 & 15, fq2 = lane2 >> 4;
    LruCtx X; X.w = w; X.fr = fr2; X.fq = fq2;
    X.yrow = yh + (tl0 + 16 * w) * 2048 + 512 + hd * 128 + 16 * ct;
    const char* zby = (const char*)(zh + (tl0 + 16 * w) * INC + C_BY + hd * 128);
    const unsigned loff8 = (unsigned)(fr2 * INC + 16 * ct + 4 * fq2) * 2u;
    const unsigned xsub = (unsigned)(16 * (ct & 1) + 4 * fq2) * 2u;
    unsigned doff[5];
#pragma unroll
    for (int j = 0; j < 5; ++j) { int p = 64 * (w + 8 * j) + lane2; if (p > 131 * 18 - 1) p = 131 * 18 - 1; const int row = p / 18; int c = p - row * 18; if (c > 15) c = 15; c = (c + 4 * ks0) & 15; doff[j] = (unsigned)(row * INC + c * 8) * 2u; }
    u32x2 by = (u32x2){0u, 0u}; float Hc[4] = {0.f, 0.f, 0.f, 0.f};
    if (w < 2) { const unsigned zz = (unsigned)lane2 >> 31; const float one = __uint_as_float(0x3f800000u | zz), zero = __uint_as_float(zz);
        *(LAS f32x2*)(lds + L2_WAGG + 2 * 1024 + (w * 64 + lane2) * 8) = (f32x2){one, zero}; }
    asm volatile("s_waitcnt vmcnt(0) lgkmcnt(0)" ::: "memory"); __syncthreads();
    LruSt S;
#pragma unroll
    for (int r = 0; r < 4; ++r) { S.A[r] = 1.f; S.H[r] = 0.f; } S.by = by;
    f32x4 arN = (f32x4){0.f, 0.f, 0.f, 0.f}, aiN = arN;
    int tb = 2;
    bf16x8 wk[8];
#pragma unroll
    for (int i = 0; i < 4; ++i) { wk[i] = *(const LAS bf16x8*)(lds + L2_WR + 3 * 4608 + fr2 * L2_RS + 16 * fq2 + 64 * i); wk[4 + i] = *(const LAS bf16x8*)(lds + L2_WI + 3 * 4608 + fr2 * L2_RS + 16 * fq2 + 64 * i); }
    if (w >= 4) __builtin_amdgcn_s_setprio(2);
#pragma unroll 1
    for (int ch = -1; ch < 32; ++ch) { const int c2 = ch + 2 < 32 ? ch + 2 : 31, cn = ch + 1 < 32 ? ch + 1 : 31; const int tb1 = tb == 2 ? 0 : tb + 1, tb2 = tb >= 1 ? tb - 1 : 2;
        lru_chunk(X, lds, by, S, arN, aiN, ch, tb, tb1, tb2, Hc, zt + (size_t)c2 * 128 * INC * 2, doff, zby + (size_t)cn * 128 * INC * 2, loff8, xsub, wk);
        tb = tb1; }
    __builtin_amdgcn_s_setprio(0);
    lru_out(X, lds, S, 31, tb == 2 ? 0 : tb + 1, tb >= 1 ? tb - 1 : 2, Hc);
    asm volatile("s_waitcnt vmcnt(0)" ::: "memory");
    __syncthreads();
}
__device__ __forceinline__ void pool_item(const Frame& F, int l, int bl, int ch, int g, const bf16* zh, bf16* yh) {
    LAS unsigned char* lds = F.lds; const int tid = F.tid, lane = F.lane, w = F.wave, fr = lane & 15, fq = lane >> 4;
    const int s0 = ch * 128, W = 2 << g;
    { u32x4 v[5];
#pragma unroll
      for (int i = 0; i < 5; ++i) { int p = tid + i * NTHR; if (p > 143 * 16 - 1) p = 143 * 16 - 1; const int r = p >> 4, c16 = p & 15, s = s0 - 15 + r;
          v[i] = *(const u32x4*)(zh + ((size_t)bl * SEQ + (s < 0 ? 0 : s)) * INC + C_CU + g * 128 + c16 * 8); }
#pragma unroll
      for (int i = 0; i < 5; ++i) { const int p = tid + i * NTHR; const int r = p >> 4, c16 = p & 15, s = s0 - 15 + r; u32x4 o = v[i]; if (s < 0) { const unsigned zz = (unsigned)p >> 31; o = (u32x4){zz, zz, zz, zz}; }
          if (p < 143 * 16) *(LAS u32x4*)(lds + L_CU + r * 272 + c16 * 16) = o; } }
    __syncthreads();
    LAS unsigned char* pc = lds + L_PC + w * 4352;
    { const int cg = lane & 15, tq = lane >> 4, t0 = 16 * w + 4 * tq;
        float sum[8];
#pragma unroll
        for (int j = 0; j < 8; ++j) sum[j] = 0.f;
        for (int d = 0; d < W; ++d) { const u32x4 v = *(const LAS u32x4*)(lds + L_CU + (15 + t0 - d) * 272 + cg * 16);
            sum[0] += bflo(v.x); sum[1] += bfhi(v.x); sum[2] += bflo(v.y); sum[3] += bfhi(v.y); sum[4] += bflo(v.z); sum[5] += bfhi(v.z); sum[6] += bflo(v.w); sum[7] += bfhi(v.w); }
#pragma unroll
        for (int i = 0; i < 4; ++i) { const int tr = 15 + t0 + i; const u32x4 cur = *(const LAS u32x4*)(lds + L_CU + tr * 272 + cg * 16);
            if (i > 0) { const u32x4 old = *(const LAS u32x4*)(lds + L_CU + (tr - W) * 272 + cg * 16);
                sum[0] += bflo(cur.x) - bflo(old.x); sum[1] += bfhi(cur.x) - bfhi(old.x); sum[2] += bflo(cur.y) - bflo(old.y); sum[3] += bfhi(cur.y) - bfhi(old.y);
                sum[4] += bflo(cur.z) - bflo(old.z); sum[5] += bfhi(cur.z) - bfhi(old.z); sum[6] += bflo(cur.w) - bflo(old.w); sum[7] += bfhi(cur.w) - bfhi(old.w); }
            const int sp1 = s0 + t0 + i + 1; const float inv = 1.0f / (float)(sp1 < W ? sp1 : W);
            u32x4 o; o.x = cvt_pk_bf16(sum[0] * inv - bflo(cur.x), sum[1] * inv - bfhi(cur.x)); o.y = cvt_pk_bf16(sum[2] * inv - bflo(cur.y), sum[3] * inv - bfhi(cur.y));
            o.z = cvt_pk_bf16(sum[4] * inv - bflo(cur.z), sum[5] * inv - bfhi(cur.z)); o.w = cvt_pk_bf16(sum[6] * inv - bflo(cur.w), sum[7] * inv - bfhi(cur.w));
            *(LAS u32x4*)(pc + (4 * tq + i) * 272 + cg * 16) = o; } }
    LDS_WAIT();
    bf16x8 Af[4];
#pragma unroll
    for (int ks = 0; ks < 4; ++ks) Af[ks] = *(const LAS bf16x8*)(pc + fr * 272 + (32 * ks + 8 * fq) * 2);
    LDS_WAIT();
    const float* psc = F.in[14] + (size_t)l * W_C + g * 128;
    float scv[8];
#pragma unroll
    for (int ct = 0; ct < 8; ++ct) scv[ct] = psc[16 * ct + fr];
#pragma unroll
    for (int ct = 0; ct < 8; ++ct) { f32x4 a = (f32x4){0.f, 0.f, 0.f, 0.f};
#pragma unroll
        for (int ks = 0; ks < 4; ++ks) a = __builtin_amdgcn_mfma_f32_16x16x32_bf16(Af[ks], *(const LAS bf16x8*)(lds + L_PW + (16 * ct + fr) * 272 + (32 * ks + 8 * fq) * 2), a, 0, 0, 0);
        const float sc = scv[ct];
#pragma unroll
        for (int r = 0; r < 4; ++r) *(LAS bf16*)(pc + (4 * fq + r) * 272 + (16 * ct + fr) * 2) = f2bf(a[r] * sc); }
    LDS_WAIT();
    const size_t tlw = (size_t)bl * SEQ + s0 + 16 * w;
#pragma unroll
    for (int i = 0; i < 4; ++i) { const int p = lane + 64 * i, tk = p >> 4, c16 = p & 15;
        *(u32x4*)(yh + (tlw + tk) * 2048 + 1536 + g * 128 + c16 * 8) = *(const LAS u32x4*)(pc + tk * 272 + c16 * 16); }
    __syncthreads();
}
__device__ __forceinline__ void conva_item(const Frame& F, int l, int bl, int ch, int part, const bf16* zh, bf16* yh) {
    const int cg = F.tid & 31, strip = F.tid >> 5, c0 = part * 256 + cg * 8, s0 = ch * 128 + strip * 8;
    const float* cw = F.in[3] + (size_t)l * 3 * W_A + c0;
    float w0[8], w1[8], w2[8];
#pragma unroll
    for (int j = 0; j < 8; ++j) { w0[j] = cw[j]; w1[j] = cw[W_A + j]; w2[j] = cw[2 * W_A + j]; }
    const bf16* zb = zh + (size_t)bl * SEQ * INC;
    u32x4 av[10], bv[10], gv[8];
#pragma unroll
    for (int q = 0; q < 10; ++q) { const int s = s0 - 2 + q; const bf16* zr = zb + (size_t)(s < 0 ? 0 : s) * INC; av[q] = *(const u32x4*)(zr + C_AC + c0); bv[q] = *(const u32x4*)(zr + C_AX + c0); }
#pragma unroll
    for (int i = 0; i < 8; ++i) gv[i] = *(const u32x4*)(zb + (size_t)(s0 + i) * INC + C_AB + c0);
    float u2[8], u1[8];
#pragma unroll
    for (int q = 0; q < 2; ++q) { const int s = s0 - 2 + q; float* dst = q ? u1 : u2; const u32x4 a = av[q], b = bv[q]; const float live = (s >= 0) ? 1.0f : 0.0f;
        dst[0] = live * bflo(a.x) * bflo(b.x); dst[1] = live * bfhi(a.x) * bfhi(b.x); dst[2] = live * bflo(a.y) * bflo(b.y); dst[3] = live * bfhi(a.y) * bfhi(b.y);
        dst[4] = live * bflo(a.z) * bflo(b.z); dst[5] = live * bfhi(a.z) * bfhi(b.z); dst[6] = live * bflo(a.w) * bflo(b.w); dst[7] = live * bfhi(a.w) * bfhi(b.w); }
#pragma unroll
    for (int i = 0; i < 8; ++i) { const int s = s0 + i;
        const u32x4 a = av[i + 2], b = bv[i + 2], g = gv[i];
        float u0[8]; u0[0] = bflo(a.x) * bflo(b.x); u0[1] = bfhi(a.x) * bfhi(b.x); u0[2] = bflo(a.y) * bflo(b.y); u0[3] = bfhi(a.y) * bfhi(b.y);
        u0[4] = bflo(a.z) * bflo(b.z); u0[5] = bfhi(a.z) * bfhi(b.z); u0[6] = bflo(a.w) * bflo(b.w); u0[7] = bfhi(a.w) * bfhi(b.w);
        float gb[8]; gb[0] = bflo(g.x); gb[1] = bfhi(g.x); gb[2] = bflo(g.y); gb[3] = bfhi(g.y); gb[4] = bflo(g.z); gb[5] = bfhi(g.z); gb[6] = bflo(g.w); gb[7] = bfhi(g.w);
        float y[8];
#pragma unroll
        for (int j = 0; j < 8; ++j) { y[j] = gb[j] * (w0[j] * u2[j] + w1[j] * u1[j] + w2[j] * u0[j]); u2[j] = u1[j]; u1[j] = u0[j]; }
        u32x4 o; o.x = cvt_pk_bf16(y[0], y[1]); o.y = cvt_pk_bf16(y[2], y[3]); o.z = cvt_pk_bf16(y[4], y[5]); o.w = cvt_pk_bf16(y[6], y[7]);
        *(u32x4*)(yh + ((size_t)bl * SEQ + s) * 2048 + c0) = o; }
}
__device__ __forceinline__ void phase_p2(const Frame& F0, int l, const bf16* zh, bf16* yh) {
    Frame F = F0;
#define REFRESH_LANE() do { int l_; asm volatile("v_mbcnt_lo_u32_b32 %0, -1, 0\n\tv_mbcnt_hi_u32_b32 %0, -1, %0" : "=v"(l_)); F.lane = l_; F.tid = F.wave * 64 + l_; } while (0)
    for (int it0 = F.c; it0 < ((DUP_MASK & 2048) ? 1024 : 256); it0 += F.G) { const int it = it0 & 255; const int hd = it & 7, ct = (it >> 3) & 7, bl = it >> 6; lru_seq_unit(F, l, bl, hd, ct, zh, yh); }
    REFRESH_LANE();
    { int cur_g = -1;
    for (int it = F.c; it < 512; it += F.G) { const int g = it & 3, rest = it >> 2, bl = rest >> 5, ch = rest & 31;
        if (g != cur_g) { __syncthreads(); stage_pad128((const bf16*)(F.ws + WS_PLT) + (size_t)g * 128 * 128, F.lds + L_PW, F.tid); cur_g = g; }
        pool_item(F, l, bl, ch, g, zh, yh); } }
    REFRESH_LANE();
    { for (int it = F.c; it < 256; it += F.G) { const int part = it & 1, rest = it >> 1, bl = rest >> 5, ch = rest & 31; conva_item(F, l, bl, ch, part, zh, yh); } }
}

constexpr int NPHASE = 23;
__global__ void __launch_bounds__(NTHR, 2) mega_fwd(Args args) {
    extern __shared__ __attribute__((aligned(16))) unsigned char lds_raw[];
    Frame F; F.lds = (LAS unsigned char*)lds_raw; F.MISC = (volatile LAS unsigned*)(F.lds + MISC_OFF);
    const int wave_s = __builtin_amdgcn_readfirstlane((int)threadIdx.x >> 6);
    F.wave = wave_s; F.lane = (int)__builtin_amdgcn_mbcnt_hi(~0u, __builtin_amdgcn_mbcnt_lo(~0u, 0u)); F.tid = wave_s * 64 + F.lane; F.G = gridDim.x; F.c = blockIdx.x;
    F.in = args.in; F.out = args.out; F.ws = args.ws; F.ctl = (unsigned*)(args.ws + WS_CTL);
    for (int u = F.tid; u < (LDS_BYTES - MISC_OFF) / 4; u += NTHR) F.MISC[u] = 0u;
    __syncthreads();
    const int lo = args.ph_lo, hi = args.ph_hi;
    XcdBarrier bar; bar.bar = F.ctl + CW_BAR; bar.x = 0; bar.st = nullptr;
    if (hi - lo > 1) bar = xcd_barrier_post(F.ctl + CW_BAR, F.MISC + MW_BAR, F.tid == 0);
    int pid = 0;
#define PH_BEGIN if (pid >= lo && pid < hi) { { int c_ = (int)blockIdx.x; asm volatile("" : "+s"(c_)); F.c = c_; int l_; asm volatile("v_mbcnt_lo_u32_b32 %0, -1, 0\n\tv_mbcnt_hi_u32_b32 %0, -1, %0" : "=v"(l_)); F.lane = l_; F.wave = wave_s; F.tid = wave_s * 64 + l_; }
#define PH_END if (pid + 1 < hi) xcd_barrier(bar, F.tid == 0); } ++pid;
    bf16* zh = (bf16*)(F.ws + WS_ZH); bf16* yh = (bf16*)F.out; bf16* xb = (bf16*)(F.ws + WS_XB); bf16* mb = (bf16*)((unsigned char*)F.out + 64 * MiB); bf16* xs = (bf16*)(F.ws + WS_XS);
    for (int l = 0; l < DEPTH; ++l) {
        PH_BEGIN REP(1) { phase_n1(F, l); __syncthreads(); } if ((DUP_MASK & 16384) && l == 0) { for (int xb_ = 0; xb_ < 20; ++xb_) xcd_barrier(bar, F.tid == 0); } PH_END
        for (int hf = 0; hf < 2; ++hf) {
            PH_BEGIN { { ProbG1 p; p.S.init(TH, 2048, F.G, F.c, (DUP_MASK & 2) ? 2 : 1); p.A = (const char*)(xs + (size_t)hf * TH * D); p.B = (const char*)(F.ws + WS_WINT); p.O = zh; p.dummy = yh; p.rstd = (const float*)(F.ws + WS_RSTD) + (size_t)hf * TH; pg8::gemm_phase(F.lds, p, F.tid); }
                       { ProbG1g p; p.S.init(TH, 5120, F.G, F.c, (DUP_MASK & 2) ? 2 : 1); p.A = (const char*)(F.ws + (hf ? WS_XB8B : WS_XB8A)); p.B = (const char*)(F.ws + WS_WING8); p.O = zh; p.rstd = (const float*)(F.ws + WS_RSTD) + (size_t)hf * TH; pg8::gemm_phase(F.lds, p, F.tid); } } PH_END
            PH_BEGIN { phase_p2(F, l, zh, yh); __syncthreads(); } PH_END
            PH_BEGIN { ProbG2 p; p.S.init(TH, D, F.G, F.c, (DUP_MASK & 16) ? 2 : 1); p.A = (const char*)yh; p.B = (const char*)(F.ws + WS_WCAT); p.zh = zh; p.O = mb + (size_t)hf * TH * D; pg8::gemm_phase(F.lds, p, F.tid); } PH_END
        }
        PH_BEGIN { ProbG3 p; p.S.init(T, D, F.G, F.c, 1); p.A = (const char*)mb; p.B = (const char*)(F.ws + WS_WOT); p.xin32 = nullptr; p.xs = xs; pg8::gemm_phase(F.lds, p, F.tid); } PH_END
        PH_BEGIN REP(64) { phase_router(F, l, rep_); __syncthreads(); } PH_END
        PH_BEGIN { moe_panel_table(F, l); ProbMA p; p.MISC = F.MISC; p.rinfo = (const i32x4*)(F.ws + WS_RINFO); p.G = F.G; p.c = F.c; p.nsh = 3; p.dupm = (DUP_MASK & 32768) ? 3 : 1;
                   p.A = (const char*)xb; p.B = (const char*)(F.ws + WS_BAT); p.hid = (unsigned char*)(F.ws + WS_HID); pg8::gemm_phase(F.lds, p, F.tid);
                   if (l + 1 < DEPTH) { convert_queue(F, l + 1, 0, F.ctl + CW_WQ + 128); convert_queue(F, l + 1, 1, F.ctl + CW_WQ); } } PH_END
        PH_BEGIN { moe_panel_table(F, l); ProbMB p; p.MISC = F.MISC; p.rinfo = (const i32x4*)(F.ws + WS_RINFO); p.G = F.G; p.c = F.c; p.nsh = 2;
                   p.A = (const char*)(F.ws + WS_HID); p.B = (const char*)(F.ws + WS_W2T); p.xs = xs; pg8::gemm_phase(F.lds, p, F.tid);
                   if (l + 1 < DEPTH) convert_queue(F, l + 1, 2, F.ctl + CW_WQ + 64); } PH_END
    }
    PH_BEGIN phase_final(F); PH_END
#undef PH_BEGIN
#undef PH_END
}
static void launch_mega(const Args& base, int lo, int hi, int grid, hipStream_t stream) {
    Args a = base; a.ph_lo = lo; a.ph_hi = hi;
    hipLaunchKernelGGL(mega_fwd, dim3(grid), dim3(NTHR), LDS_BYTES, stream, a);
}
extern "C" void kernel_launch(void* const* d_in, const int* in_sizes, int n_in, void* d_out, int out_size, void* d_ws, size_t ws_size, hipStream_t stream) {
    static int grid = 0;
    if (grid == 0) {
        if (n_in != 26 || out_size != T * D || ws_size < WS_END) { fprintf(stderr, "kernel_launch: unexpected shapes (n_in %d out %d ws %zu)\n", n_in, out_size, ws_size); grid = -1; return; }
        int dev = 0, cus = 0;
        if (hipGetDevice(&dev) != hipSuccess || hipDeviceGetAttribute(&cus, hipDeviceAttributeMultiprocessorCount, dev) != hipSuccess) { grid = -1; return; }
        if (hipFuncSetAttribute((const void*)mega_fwd, hipFuncAttributeMaxDynamicSharedMemorySize, LDS_BYTES) != hipSuccess) { fprintf(stderr, "kernel_launch: hipFuncSetAttribute failed\n"); grid = -1; return; }
        int per_cu = 0; (void)hipOccupancyMaxActiveBlocksPerMultiprocessor(&per_cu, (const void*)mega_fwd, NTHR, LDS_BYTES); (void)hipGetLastError();
        if (per_cu < 1) fprintf(stderr, "kernel_launch: occupancy query says %d blocks per CU\n", per_cu);
        grid = cus;
    }
    if (grid < 0) return;
    (void)hipMemsetAsync((char*)d_ws + WS_CTL, 0, CTL_BYTES, stream);
    Args a{};
    for (int i = 0; i < 26; ++i) a.in[i] = (const float*)d_in[i];
    a.out = (float*)d_out; a.ws = (unsigned char*)d_ws; a.ph_lo = 0; a.ph_hi = 0;
#if ONE_LAUNCH
    launch_mega(a, 0, NPHASE, grid, stream);
#else
    for (int ph = 0; ph < NPHASE; ++ph) launch_mega(a, ph, ph + 1, grid, stream);
#endif
}
```

```cpp
#include <hip/hip_runtime.h>
#include <stdint.h>
#include <stdio.h>

#ifndef ONE_LAUNCH
#define ONE_LAUNCH 1
#endif
#ifndef PH_MASK
#define PH_MASK 1023
#endif
#ifndef DUP_MASK
#define DUP_MASK 0
#endif
#define REP(bit) for (int rep_ = 0; rep_ < ((DUP_MASK & (bit)) ? 2 : 1); ++rep_)

#define LAS __attribute__((address_space(3)))
typedef unsigned short bf16;
typedef short bf16x8 __attribute__((ext_vector_type(8)));
typedef float f32x4 __attribute__((ext_vector_type(4)));
typedef float f32x2 __attribute__((ext_vector_type(2)));
typedef unsigned u32x4 __attribute__((ext_vector_type(4)));
typedef unsigned u32x2 __attribute__((ext_vector_type(2)));
typedef int i32x4 __attribute__((ext_vector_type(4)));
typedef int i32x8 __attribute__((ext_vector_type(8)));

constexpr int D = 1024, BATCH = 8, SEQ = 4096, T = BATCH * SEQ, DEPTH = 2;
constexpr int W_A = 512, W_B = 1024, W_C = 512, INC = 7168;
constexpr int C_AB = 0, C_AC = 512, C_AX = 1024, C_BX = 1536, C_BY = 2560, C_CU = 3584, C_GA = 4096, C_GB = 5120, C_GC = 6144;
constexpr int TH = T / 2;
constexpr int NG = 4, EPG = 4, NE = 16, DE = 512, NCLS = 24, CAP = 32768;
constexpr float EPS_C = 1e-6f;
__device__ __forceinline__ float eps_v() { float e = EPS_C; asm volatile("" : "+v"(e)); return e; }
#define EPS eps_v()
constexpr int NWAVES = 8, NTHR = 512;

constexpr size_t MiB = 1u << 20;
constexpr size_t WS_CTL = 0, CTL_BYTES = 128 * 1024;
constexpr size_t WS_WINT = 1 * MiB;
constexpr size_t WS_WCAT = WS_WINT + 14 * MiB;
constexpr size_t WS_WOT = WS_WCAT + 4 * MiB;
constexpr size_t WS_BAT = WS_WOT + 2 * MiB;
constexpr size_t WS_W2T = WS_BAT + 32 * MiB;
constexpr size_t WS_WAT = WS_W2T + 16 * MiB;
constexpr size_t WS_WXT = WS_WAT + 256 * 1024;
constexpr size_t WS_PLT = WS_WXT + 256 * 1024;
constexpr size_t WS_GW = 70 * MiB;
constexpr size_t WS_RSTD = 70 * MiB + 128 * 1024;
constexpr size_t WS_XB = 71 * MiB;
constexpr size_t WS_ZH = 135 * MiB;
constexpr size_t WS_XS = 359 * MiB;
constexpr size_t WS_CAR = 487 * MiB;
constexpr size_t WS_END = 504 * MiB;
constexpr size_t WS_WING8 = WS_WINT + (size_t)4096 * 1024 * 2;
constexpr size_t WS_XB8A = WS_BAT + 16 * MiB, WS_XB8B = 487 * MiB;
constexpr size_t WS_HID = WS_ZH;
constexpr size_t WS_RINFO = WS_ZH + 96 * MiB;
static_assert(WS_PLT + 128 * 1024 <= WS_XB, "weights fit");
constexpr int CW_BAR = 4096;
constexpr int CW_WQ = 20480;
constexpr int CW_CNT = 16384;

constexpr int RING_BYTES = 131072, LDS_BYTES = 163840, MISC_OFF = LDS_BYTES - 2048;
constexpr int MW_BAR = 8, MW_CNT = 16, MW_NPAN = 44, MW_PT = 48, MW_SCR = 256;

__device__ __forceinline__ float bf2f(bf16 v) { return __uint_as_float(((unsigned)v) << 16); }
__device__ __forceinline__ float bflo(unsigned w) { return __uint_as_float(w << 16); }
__device__ __forceinline__ float bfhi(unsigned w) { return __uint_as_float(w & 0xffff0000u); }
__device__ __forceinline__ bf16 f2bf(float f) { unsigned u = __float_as_uint(f); return (bf16)((u + 0x7fffu + ((u >> 16) & 1u)) >> 16); }
__device__ __forceinline__ unsigned cvt_pk_bf16(float lo, float hi) { unsigned r; asm volatile("v_cvt_pk_bf16_f32 %0, %1, %2" : "=v"(r) : "v"(lo), "v"(hi)); return r; }
__device__ __forceinline__ float dpp_mov(float v, int ctrl_sel) {
    int r; const int x = __builtin_bit_cast(int, v);
    switch (ctrl_sel) { case 0: r = __builtin_amdgcn_update_dpp(0, x, 0xB1, 0xf, 0xf, true); break;
                        case 1: r = __builtin_amdgcn_update_dpp(0, x, 0x4E, 0xf, 0xf, true); break;
                        case 2: r = __builtin_amdgcn_update_dpp(0, x, 0x141, 0xf, 0xf, true); break;
                        default: r = __builtin_amdgcn_update_dpp(0, x, 0x140, 0xf, 0xf, true); break; }
    return __builtin_bit_cast(float, r);
}
__device__ __forceinline__ float wave_sum(float v) {
    v += dpp_mov(v, 0); v += dpp_mov(v, 1); v += dpp_mov(v, 2); v += dpp_mov(v, 3);
    const int x = __builtin_bit_cast(int, v);
    return (__builtin_bit_cast(float, __builtin_amdgcn_readlane(x, 0)) + __builtin_bit_cast(float, __builtin_amdgcn_readlane(x, 16)))
         + (__builtin_bit_cast(float, __builtin_amdgcn_readlane(x, 32)) + __builtin_bit_cast(float, __builtin_amdgcn_readlane(x, 48)));
}
__device__ __forceinline__ float fexp(float x) { return __builtin_amdgcn_exp2f(x * 1.4426950408889634f); }
__device__ __forceinline__ float frcp(float x) { return __builtin_amdgcn_rcpf(x); }
__device__ __forceinline__ float sigmoidf_(float x) { return 1.0f / (1.0f + __expf(-x)); }
__device__ __forceinline__ float fsig(float x) { return frcp(1.0f + __builtin_amdgcn_exp2f(x * -1.4426950408889634f)); }
__device__ __forceinline__ float gelu_tanh(float x) { const float u = 0.7978845608028654f * (x + 0.044715f * x * x * x); return 0.5f * x * (1.0f + tanhf(u)); }
__device__ __forceinline__ float fgelu(float x) { const float u = 1.5957691216057308f * (x + 0.044715f * x * x * x); return x * fsig(u); }
struct SigC { float c[6], k6; };
__device__ __forceinline__ SigC sigc_make(float scale) {
    SigC k; k.c[0] = 2.474571982e-01f * scale; k.c[1] = -1.806103845e-02f * scale; k.c[2] = 1.142852964e-03f * scale; k.c[3] = -4.464323739e-05f * scale; k.c[4] = 9.237665070e-07f * scale; k.c[5] = -7.679337749e-09f * scale; k.k6 = 6.0f;
#pragma unroll
    for (int i = 0; i < 6; ++i) asm volatile("" : "+s"(k.c[i]));
    asm volatile("" : "+s"(k.k6));
    return k;
}
__device__ __forceinline__ f32x4 sig_odd4(f32x4 x, const SigC& k) {
#pragma unroll
    for (int e = 0; e < 4; ++e) x[e] = __builtin_amdgcn_fmed3f(x[e], -k.k6, k.k6);
    const f32x4 u = x * x;
    f32x4 p = u * k.c[5] + k.c[4]; p = p * u + k.c[3]; p = p * u + k.c[2]; p = p * u + k.c[1]; p = p * u + k.c[0];
    return p * x;
}
#define LDS_WAIT() asm volatile("s_waitcnt lgkmcnt(0)" ::: "memory")
#define VM_WAIT() asm volatile("s_waitcnt vmcnt(0)" ::: "memory")

#define XB_TMO      128
#define XB_XCNT(j)  (256  + 64 * (j))
#define XB_XSUB(j)  (1280 + 64 * (j))
#define XB_XGEN(j)  (2304 + 64 * (j))
#define XB_TOP      3328
#define XB_TOPGEN   3392
#define XCD_BAR_WORDS 3456
#define XB_SPIN_CAP (1u << 20)
__device__ __forceinline__ unsigned xb_ld(unsigned* p)              { return __hip_atomic_load(p, __ATOMIC_RELAXED, __HIP_MEMORY_SCOPE_AGENT); }
__device__ __forceinline__ unsigned xb_add(unsigned* p, unsigned v) { return __hip_atomic_fetch_add(p, v, __ATOMIC_RELAXED, __HIP_MEMORY_SCOPE_AGENT); }
__device__ __forceinline__ unsigned xb_xcc_id() { return (unsigned)__builtin_amdgcn_s_getreg((3 << 11) | 20) & 0xFu; }
#define XB_SPIN(cond, bar) do { unsigned _sp = 0; while (cond) { __builtin_amdgcn_s_sleep(1); \
    if ((++_sp & 255u) == 0u) { if (xb_ld(&(bar)[XB_TMO])) break; if (_sp > XB_SPIN_CAP) { atomicAdd(&(bar)[XB_TMO], 1u); break; } } } } while (0)
struct XcdBarrier { unsigned* bar; unsigned x; volatile LAS unsigned* st; };
__device__ __forceinline__ XcdBarrier xcd_barrier_post(unsigned* bar, volatile LAS unsigned* st, bool is0) {
    XcdBarrier b; b.bar = bar; b.x = xb_xcc_id(); b.st = st;
    if (is0) (void)xb_add(&bar[XB_XCNT(b.x)], 1u);
    return b;
}
__device__ __forceinline__ void xcd_barrier_complete(unsigned* bar, unsigned x, unsigned& nloc, unsigned& nx) {
    const unsigned G = gridDim.x * gridDim.y * gridDim.z;
    unsigned sum, cnt, mine, sp = 0u;
    for (;;) {
        sum = 0u; cnt = 0u; mine = 0u;
        unsigned cv[16];
        { const unsigned* p0 = bar + XB_XCNT(0); const unsigned* p1 = bar + XB_XCNT(8);
          asm volatile("global_load_dword %0, %16, off sc1\n\tglobal_load_dword %1, %16, off offset:256 sc1\n\tglobal_load_dword %2, %16, off offset:512 sc1\n\tglobal_load_dword %3, %16, off offset:768 sc1\n\t"
                       "global_load_dword %4, %16, off offset:1024 sc1\n\tglobal_load_dword %5, %16, off offset:1280 sc1\n\tglobal_load_dword %6, %16, off offset:1536 sc1\n\tglobal_load_dword %7, %16, off offset:1792 sc1\n\t"
                       "global_load_dword %8, %17, off sc1\n\tglobal_load_dword %9, %17, off offset:256 sc1\n\tglobal_load_dword %10, %17, off offset:512 sc1\n\tglobal_load_dword %11, %17, off offset:768 sc1\n\t"
                       "global_load_dword %12, %17, off offset:1024 sc1\n\tglobal_load_dword %13, %17, off offset:1280 sc1\n\tglobal_load_dword %14, %17, off offset:1536 sc1\n\tglobal_load_dword %15, %17, off offset:1792 sc1\n\ts_waitcnt vmcnt(0)"
                       : "=&v"(cv[0]), "=&v"(cv[1]), "=&v"(cv[2]), "=&v"(cv[3]), "=&v"(cv[4]), "=&v"(cv[5]), "=&v"(cv[6]), "=&v"(cv[7]),
                         "=&v"(cv[8]), "=&v"(cv[9]), "=&v"(cv[10]), "=&v"(cv[11]), "=&v"(cv[12]), "=&v"(cv[13]), "=&v"(cv[14]), "=&v"(cv[15]) : "v"(p0), "v"(p1) : "memory"); }
#pragma unroll
        for (unsigned j = 0; j < 16; ++j) { const unsigned c = cv[j]; sum += c; cnt += (c > 0u) ? 1u : 0u; mine = (j == x) ? c : mine; }
        if (sum == G) break;
        __builtin_amdgcn_s_sleep(1);
        if ((++sp & 255u) == 0u) { if (xb_ld(&bar[XB_TMO])) break; if (sp > XB_SPIN_CAP) { atomicAdd(&bar[XB_TMO], 1u); break; } }
    }
    nloc = mine > 0u ? mine : 1u; nx = cnt > 0u ? cnt : 1u;
}
__device__ __forceinline__ void xcd_barrier(const XcdBarrier& b, bool is0) {
    asm volatile("s_waitcnt vmcnt(0)" ::: "memory");
    __syncthreads();
    if (is0) {
        unsigned* bar = b.bar;
        __builtin_amdgcn_s_waitcnt(0);
        unsigned nloc = b.st[0], nx = b.st[1];
        if (nloc == 0u) { xcd_barrier_complete(bar, b.x, nloc, nx); b.st[0] = nloc; b.st[1] = nx; }
        const unsigned old = xb_add(&bar[XB_XSUB(b.x)], 1u);
        const unsigned gen = old / nloc;
        if (old + 1u == (gen + 1u) * nloc) {
            __builtin_amdgcn_fence(__ATOMIC_RELEASE, "agent");
            asm volatile("s_waitcnt vmcnt(0)" ::: "memory");
            const unsigned og = xb_add(&bar[XB_TOP], 1u);
            const unsigned tg = og / nx;
            if (og + 1u == (tg + 1u) * nx) xb_add(&bar[XB_TOPGEN], 1u);
            else XB_SPIN(xb_ld(&bar[XB_TOPGEN]) == tg, bar);
            __builtin_amdgcn_fence(__ATOMIC_ACQUIRE, "agent");
            xb_add(&bar[XB_XGEN(b.x)], 1u);
            asm volatile("s_waitcnt vmcnt(0)" ::: "memory");
        } else {
            XB_SPIN(xb_ld(&bar[XB_XGEN(b.x)]) == gen, bar);
            __builtin_amdgcn_fence(__ATOMIC_ACQUIRE, "agent");
            asm volatile("s_waitcnt vmcnt(0)" ::: "memory");
        }
    }
    __syncthreads();
}

namespace pg8 {
constexpr int BM = 256, BK = 64, HALF = 128, HTB = HALF * BK * 2, STAGE_BYTES = 8 * HTB, NXCD = 8, WGM = 8;
__host__ __device__ __forceinline__ int lds_byte(int r, int c) { const int st = (r >> 4) * 2 + (c >> 5), rr = r & 15, cc = c & 31, ob = rr * 64 + cc * 2; return st * 1024 + (ob ^ (((ob >> 9) & 1) << 5)); }
__host__ __device__ __forceinline__ void stage_rc(int b, int& R, int& C) { const int st = b / 1024, sb = b % 1024, swz = sb ^ (((sb >> 9) & 1) << 5); R = (st >> 1) * 16 + swz / 64; C = (st & 1) * 32 + (swz % 64) / 2; }
__host__ __device__ __forceinline__ int perm32(int rho) { const int n = rho >> 4, i = rho & 15; return 8 * (i >> 2) + 4 * n + (i & 3); }
struct Unit { int pm, pn, rep; };
struct StaticOrder {
    int nM, nN, nwg, G, c, dupf;
    __host__ __device__ void init(int M, int N, int G_, int c_, int dupf_ = 1) { nM = M / BM; nN = N / BM; nwg = nM * nN; G = G_; c = c_; dupf = dupf_; }
    __host__ __device__ bool next(int i, Unit& u) const {
        const long L0 = (long)i * G + c; if (L0 >= (long)nwg * dupf) return false; const long L = L0 % nwg; u.rep = (int)(L0 / nwg);
        int wgid = (int)L; { const int q = nwg / NXCD, r = nwg % NXCD, xcd = wgid % NXCD, off = wgid / NXCD; wgid = (xcd < r ? xcd * (q + 1) : r * (q + 1) + (xcd - r) * q) + off; }
        const int nig = WGM * nN, gid = wgid / nig, fm = gid * WGM, gsz = (nM - fm) < WGM ? (nM - fm) : WGM;
        u.pm = fm + ((wgid % nig) % gsz); u.pn = (wgid % nig) / gsz; return true;
    }
};
template <class P>
__device__ __forceinline__ void gemm_phase(LAS unsigned char* lds, const P& p, const int tid) {
    const int wid = __builtin_amdgcn_readfirstlane(tid >> 6), lane = tid & 63, wr = wid >> 2, wc = wid & 3, fr = lane & 15, fq = lane >> 4;
    constexpr int nt = P::NT, lda = P::LDA, ldb = P::LDB;
    unsigned voffA[2], voffB[2]; int Rr[2], Cc[2];
#pragma unroll
    for (int i = 0; i < 2; ++i) { int R, C; stage_rc(tid * 16 + i * 8192, R, C); const int Rb = P::PERM ? ((R & ~31) + perm32(R & 31)) : R;
        voffA[i] = (unsigned)(R * lda + C) * 2u; voffB[i] = (unsigned)(Rb * ldb + C) * 2u; Rr[i] = R; Cc[i] = C; }
    constexpr size_t kstep = (size_t)(BK * 2), hstepA = (size_t)HALF * lda * 2, hstepB = (size_t)HALF * ldb * 2;
    const unsigned ldsw = (unsigned)wid * 1024u;
    const int aoff = lds_byte(wr * 64 + fr, fq * 8), boff = lds_byte(wc * 32 + fr, fq * 8);
#define PG8_SA(b, h) (((b) * 2 + (h)) * HTB)
#define PG8_SB(b, h) ((4 + (b) * 2 + (h)) * HTB)
#define PG8_GL(gp, off) __builtin_amdgcn_global_load_lds((const unsigned*)(gp), (LAS unsigned*)(lds + (off)), 16, 0, 0)
#define PG8_STAGE_B(bufoff, base, h) do { PG8_GL((base) + (h) * hstepB + voffB[0], (bufoff) + ldsw); PG8_GL((base) + (h) * hstepB + voffB[1], (bufoff) + ldsw + 8192); } while (0)
#define PG8_STAGE_A(bufoff, base, h, ro) do { if constexpr (P::GATHER) { PG8_GL((base) + ro[h][0], (bufoff) + ldsw); PG8_GL((base) + ro[h][1], (bufoff) + ldsw + 8192); } \
        else { PG8_GL((base) + (h) * hstepA + voffA[0], (bufoff) + ldsw); PG8_GL((base) + (h) * hstepA + voffA[1], (bufoff) + ldsw + 8192); } } while (0)
#define PG8_LDA(dst, b, h) do { if constexpr (P::F8) { _Pragma("unroll") for (int m = 0; m < 4; ++m) { const i32x4 lo_ = *(const LAS i32x4*)(lds + PG8_SA(b, h) + aoff + m * 2048), hi_ = *(const LAS i32x4*)(lds + PG8_SA(b, h) + aoff + m * 2048 + 1024); \
            dst##8[m] = __builtin_shufflevector(lo_, hi_, 0, 1, 2, 3, 4, 5, 6, 7); } } \
        else { _Pragma("unroll") for (int m = 0; m < 4; ++m) _Pragma("unroll") for (int k = 0; k < 2; ++k) dst[m][k] = *(const LAS bf16x8*)(lds + PG8_SA(b, h) + aoff + m * 2048 + k * 1024); } } while (0)
#define PG8_LDB(dst, b, h) do { if constexpr (P::F8) { _Pragma("unroll") for (int n = 0; n < 2; ++n) { const i32x4 lo_ = *(const LAS i32x4*)(lds + PG8_SB(b, h) + boff + n * 2048), hi_ = *(const LAS i32x4*)(lds + PG8_SB(b, h) + boff + n * 2048 + 1024); \
            dst##8[n] = __builtin_shufflevector(lo_, hi_, 0, 1, 2, 3, 4, 5, 6, 7); } } \
        else { _Pragma("unroll") for (int n = 0; n < 2; ++n) _Pragma("unroll") for (int k = 0; k < 2; ++k) dst[n][k] = *(const LAS bf16x8*)(lds + PG8_SB(b, h) + boff + n * 2048 + k * 1024); } } while (0)
#define PG8_MMA(ai, bj, At, Bt) do { __builtin_amdgcn_s_setprio(1); \
        if constexpr (P::F8) { _Pragma("unroll") for (int m = 0; m < 4; ++m) _Pragma("unroll") for (int n = 0; n < 2; ++n) \
            acc[ai][bj][m][n] = __builtin_amdgcn_mfma_scale_f32_16x16x128_f8f6f4(Bt##8[n], At##8[m], acc[ai][bj][m][n], 0, 0, 0, scB_, 0, scA_); } \
        else { _Pragma("unroll") for (int m = 0; m < 4; ++m) _Pragma("unroll") for (int n = 0; n < 2; ++n) _Pragma("unroll") for (int k = 0; k < 2; ++k) \
            acc[ai][bj][m][n] = __builtin_amdgcn_mfma_f32_16x16x32_bf16(Bt[n][k], At[m][k], acc[ai][bj][m][n], 0, 0, 0); } \
        __builtin_amdgcn_s_setprio(0); } while (0)
#define PG8_WAIT_V(n) asm volatile("s_waitcnt vmcnt(" #n ")" ::: "memory")
#define PG8_WAIT_L(n) asm volatile("s_waitcnt lgkmcnt(" #n ")" ::: "memory")
#define PG8_BAR __builtin_amdgcn_s_barrier()
#define PG8_SCHED __builtin_amdgcn_sched_barrier(0)
    int scA_ = P::SCALE_A, scB_ = P::SCALE_B; if constexpr (P::F8) { asm volatile("" : "+v"(scA_), "+v"(scB_)); }
    Unit cur, nxt; int ui = 0;
    if (!p.next(0, cur)) return;
    f32x4 acc[2][2][4][2];
#pragma unroll
    for (int a = 0; a < 2; ++a)
#pragma unroll
        for (int b = 0; b < 2; ++b)
#pragma unroll
            for (int m = 0; m < 4; ++m)
#pragma unroll
                for (int n = 0; n < 2; ++n) acc[a][b][m][n] = (f32x4){0.f, 0.f, 0.f, 0.f};
    bf16x8 At[4][2], B0[2][2], B1[2][2]; i32x8 At8[4], B08[2], B18[2];
    unsigned roC[2][2] = {{0u, 0u}, {0u, 0u}};
    const char* cA; const char* cB = p.b_base(cur); long bdC = p.b_delta(cur);
    if constexpr (P::PRE) p.pre_next(cur, lds + RING_BYTES, wid, lane);
    if constexpr (P::GATHER) { cA = p.a_gbase(); p.a_rows(cur, Rr, Cc, roC); } else { cA = p.a_base(cur); }
    PG8_STAGE_B(PG8_SB(0, 0), cB, 0); PG8_STAGE_B(PG8_SB(0, 1), cB, 1); PG8_STAGE_A(PG8_SA(0, 0), cA, 0, roC); PG8_STAGE_A(PG8_SA(0, 1), cA, 1, roC);
    if (wr == 1) PG8_BAR;
    PG8_WAIT_V(2); PG8_BAR;
    PG8_STAGE_B(PG8_SB(1, 0), cB + kstep, 0); PG8_STAGE_A(PG8_SA(1, 0), cA + kstep, 0, roC); PG8_STAGE_B(PG8_SB(1, 1), cB + kstep, 1);
    PG8_WAIT_V(6); PG8_BAR;
    for (;;) {
        const bool has_next = p.next(ui + 1, nxt);
        if constexpr (P::PRE) { if (has_next) p.pre_next(nxt, lds + RING_BYTES + ((ui + 1) & 1) * 4096, wid, lane); }
        const char* nA = cA; const char* nB = cB; long bdN = bdC;
        if (has_next) { nB = p.b_base(nxt); bdN = p.b_delta(nxt); if constexpr (!P::GATHER) { nA = p.a_base(nxt); } }
#pragma unroll 1
        for (int t = 0; t < nt; t += 2) {
            const bool last = (t == nt - 2);
            if constexpr (P::HAS_MID) { if (t == P::MID0 || t == P::MID1) p.mid(acc, cur, t, wr, wc, fr, fq); }
            const char* a1 = cA + (size_t)(t + 1) * kstep;
            const char* a2 = last ? nA : cA + (size_t)(t + 2) * kstep;
            const char* b2 = last ? nB : cB + (size_t)(t + 2) * kstep + ((t + 2) >= P::BSEG ? bdC : 0l);
            const char* a3 = a2 + kstep; const char* b3 = b2 + kstep;
            PG8_LDB(B0, 0, 0); PG8_LDB(B1, 0, 1); PG8_SCHED; PG8_LDA(At, 0, 0); PG8_STAGE_A(PG8_SA(1, 1), a1, 1, roC);
            if constexpr (P::GATHER) { if (last && has_next) { if constexpr (P::PRE) p.a_rows_lds(nxt, Rr, Cc, roC, lds + RING_BYTES + ((ui + 1) & 1) * 4096); else p.a_rows(nxt, Rr, Cc, roC); } }
            PG8_WAIT_V(8); PG8_WAIT_L(0); PG8_BAR; PG8_MMA(0, 0, At, B0); PG8_MMA(0, 1, At, B1); PG8_BAR; PG8_SCHED;
            PG8_LDA(At, 0, 1); PG8_STAGE_B(PG8_SB(0, 0), b2, 0); PG8_STAGE_B(PG8_SB(0, 1), b2, 1); PG8_STAGE_A(PG8_SA(0, 0), a2, 0, roC);
            PG8_WAIT_V(8); PG8_WAIT_L(0); PG8_BAR; PG8_MMA(1, 0, At, B0); PG8_MMA(1, 1, At, B1); PG8_BAR; PG8_SCHED;
            PG8_LDB(B0, 1, 0); PG8_LDB(B1, 1, 1); PG8_SCHED; PG8_LDA(At, 1, 0); PG8_STAGE_A(PG8_SA(0, 1), a2, 1, roC);
            PG8_WAIT_V(8); PG8_WAIT_L(0); PG8_BAR; PG8_MMA(0, 0, At, B0); PG8_MMA(0, 1, At, B1); PG8_BAR; PG8_SCHED;
            PG8_LDA(At, 1, 1); PG8_STAGE_B(PG8_SB(1, 0), b3, 0); PG8_STAGE_B(PG8_SB(1, 1), b3, 1); PG8_STAGE_A(PG8_SA(1, 0), a3, 0, roC);
            PG8_WAIT_V(8); PG8_WAIT_L(0); PG8_BAR; PG8_MMA(1, 0, At, B0); PG8_MMA(1, 1, At, B1); PG8_BAR; PG8_SCHED;
        }
        if constexpr (P::ALIGN) { if (wr == 0) PG8_BAR; }
        if constexpr (P::PRE) p.epi_lds(acc, cur, wr, wc, fr, fq, lds + RING_BYTES + (ui & 1) * 4096); else p.epi(acc, cur, wr, wc, fr, fq);
        if (!has_next) break;
#pragma unroll
        for (int a = 0; a < 2; ++a)
#pragma unroll
            for (int b = 0; b < 2; ++b)
#pragma unroll
                for (int m = 0; m < 4; ++m)
#pragma unroll
                    for (int n = 0; n < 2; ++n) acc[a][b][m][n] = (f32x4){0.f, 0.f, 0.f, 0.f};
        cur = nxt; cA = nA; cB = nB; bdC = bdN; ++ui;
        if constexpr (P::ALIGN) { if (wr == 1) PG8_BAR; }
    }
    PG8_WAIT_V(0);
    if constexpr (!P::ALIGN) { if (wr == 0) PG8_BAR; }
    PG8_BAR;
#undef PG8_SA
#undef PG8_SB
#undef PG8_GL
#undef PG8_STAGE_A
#undef PG8_STAGE_B
#undef PG8_LDA
#undef PG8_LDB
#undef PG8_MMA
#undef PG8_WAIT_V
#undef PG8_WAIT_L
#undef PG8_BAR
#undef PG8_SCHED
}
}
using pg8::Unit;
typedef f32x4 AccT[2][2][4][2];

struct Args { const float* in[26]; float* out; unsigned char* ws; int ph_lo, ph_hi; };
struct Frame {
    LAS unsigned char* lds; volatile LAS unsigned* MISC; unsigned* ctl;
    int tid, lane, wave, G, c;
    const float* const* in; float* out; unsigned char* ws;
};

struct DenseBase {
    static constexpr bool GATHER = false, HAS_MID = false, F8 = false, PRE = false; static constexpr int SCALE_A = 0x7F7F7F7F, SCALE_B = 0x7F7F7F7F; static constexpr int MID0 = -1, MID1 = -1, BSEG = 1 << 20;
    pg8::StaticOrder S;
    __device__ __forceinline__ bool next(int i, Unit& u) const { return S.next(i, u); }
    __device__ __forceinline__ long b_delta(const Unit&) const { return 0l; }
    __device__ __forceinline__ const char* a_gbase() const { return nullptr; }
    __device__ __forceinline__ void a_rows(const Unit&, const int (&)[2], const int (&)[2], unsigned (&)[2][2]) const {}
    __device__ __forceinline__ void mid(AccT&, const Unit&, int, int, int, int, int) const {}
};
struct ProbG1 : DenseBase {
    static constexpr int NT = 16, LDA = 1024, LDB = 1024; static constexpr bool PERM = true, ALIGN = true, PRE = true;
    const char* A; const char* B; bf16* O; bf16* dummy; const float* rstd;
    __device__ __forceinline__ void pre_next(const Unit& u, LAS unsigned char* scr, int wid, int lane) const {
        if (wid == 0) __builtin_amdgcn_global_load_lds((const unsigned*)(rstd + u.pm * 256 + lane * 4), (LAS unsigned*)scr, 16, 0, 0); }
    __device__ __forceinline__ const char* a_base(const Unit& u) const { return A + (size_t)u.pm * 256 * LDA * 2; }
    static __device__ __forceinline__ int ctile(int pn) { return pn < 6 ? pn : pn + 8; }
    __device__ __forceinline__ const char* b_base(const Unit& u) const { return B + (size_t)ctile(u.pn) * 256 * LDB * 2; }
    __device__ __forceinline__ void epi_lds(AccT& acc, const Unit& u, int wr, int wc, int fr, int fq, LAS unsigned char* scr) const {
        int row0 = u.pm * 256 + wr * 64 + fr; const int col0 = ctile(u.pn) * 256 + wc * 32 + 8 * fq; asm volatile("" : "+v"(row0));
        float rsv[2][4];
#pragma unroll
        for (int ai = 0; ai < 2; ++ai)
#pragma unroll
            for (int m = 0; m < 4; ++m) rsv[ai][m] = *(const LAS float*)(scr + (wr * 64 + fr + ai * 128 + m * 16) * 4);
#pragma unroll
        for (int ai = 0; ai < 2; ++ai)
#pragma unroll
            for (int m = 0; m < 4; ++m) { bf16* rowp = O + (size_t)(row0 + ai * 128 + m * 16) * INC + col0;
#pragma unroll
                for (int bj = 0; bj < 2; ++bj) { const f32x4 v0 = acc[ai][bj][m][0] * rsv[ai][m], v1 = acc[ai][bj][m][1] * rsv[ai][m];
                    u32x4 w; w.x = cvt_pk_bf16(v0[0], v0[1]); w.y = cvt_pk_bf16(v0[2], v0[3]); w.z = cvt_pk_bf16(v1[0], v1[1]); w.w = cvt_pk_bf16(v1[2], v1[3]);
                    *(u32x4*)(rowp + bj * 128) = w;
                    if (DUP_MASK & 8192) { const size_t off = ((size_t)((rowp + bj * 128) - O) * 2) & (size_t)(64 * MiB - 16); *(u32x4*)((char*)dummy + off) = w; } } }
    }
};
struct ProbG1g : DenseBase {
    static constexpr int NT = 8, LDA = 512, LDB = 512, SCALE_A = 0x7C7C7C7C, SCALE_B = 0x7C7C7C7C; static constexpr bool PERM = true, ALIGN = true, F8 = true, GATHER = true;
    const char* A; const char* B; bf16* O; const float* rstd;
    __device__ __forceinline__ const char* a_gbase() const { return A; }
    __device__ __forceinline__ void a_rows(const Unit& u, const int (&R)[2], const int (&C)[2], unsigned (&ro)[2][2]) const {
#pragma unroll
        for (int h = 0; h < 2; ++h)
#pragma unroll
            for (int i = 0; i < 2; ++i) ro[h][i] = (unsigned)((u.pm * 256 + h * 128 + R[i]) * LDA + C[i]) * 2u; }
    __device__ __forceinline__ const char* a_base(const Unit& u) const { return A + (size_t)u.pm * 256 * LDA * 2; }
    __device__ __forceinline__ const char* b_base(const Unit& u) const { return B + (size_t)u.pn * 256 * LDB * 2; }
    __device__ __forceinline__ void epi(AccT& acc, const Unit& u, int wr, int wc, int fr, int fq) const {
        int row0 = u.pm * 256 + wr * 64 + fr; asm volatile("" : "+v"(row0));
        if (u.pn < 8) {
            const int col0 = 1536 + u.pn * 256 + wc * 32 + 8 * fq;
#pragma unroll
            for (int ai = 0; ai < 2; ++ai)
#pragma unroll
                for (int m = 0; m < 4; ++m) { bf16* rowp = O + (size_t)(row0 + ai * 128 + m * 16) * INC + col0;
#pragma unroll
                    for (int bj = 0; bj < 2; ++bj) { const f32x4 v0 = acc[ai][bj][m][0], v1 = acc[ai][bj][m][1];
                        u32x4 w; w.x = cvt_pk_bf16(v0[0], v0[1]); w.y = cvt_pk_bf16(v0[2], v0[3]); w.z = cvt_pk_bf16(v1[0], v1[1]); w.w = cvt_pk_bf16(v1[2], v1[3]);
                        *(u32x4*)(rowp + bj * 128) = w; } }
            return; }
        const int gcol0 = (u.pn - 8) * 256 + wc * 32 + 8 * fq;
        const SigC sk = sigc_make(254.0f); float k128 = 128.0f; asm volatile("" : "+s"(k128));
#pragma unroll
        for (int ai = 0; ai < 2; ++ai)
#pragma unroll
            for (int m = 0; m < 4; ++m) { unsigned char* rowp = (unsigned char*)(O + (size_t)(row0 + ai * 128 + m * 16) * INC + 4096) + gcol0;
#pragma unroll
                for (int bj = 0; bj < 2; ++bj) { const f32x4 q0 = sig_odd4(acc[ai][bj][m][0], sk) + k128, q1 = sig_odd4(acc[ai][bj][m][1], sk) + k128; unsigned w0 = 0u, w1 = 0u;
#pragma unroll
                    for (int e = 0; e < 4; ++e) { w0 = __builtin_amdgcn_cvt_pk_u8_f32(q0[e], e, w0); w1 = __builtin_amdgcn_cvt_pk_u8_f32(q1[e], e, w1); }
                    u32x2 w; w.x = w0; w.y = w1;
                    *(u32x2*)(rowp + bj * 128) = w; } }
    }
};
struct ProbG2 : DenseBase {
    static constexpr int NT = 32, LDA = 2048, LDB = 2048, MID0 = 8, MID1 = 24; static constexpr bool PERM = true, ALIGN = false, HAS_MID = true;
    const char* A; const char* B; const bf16* zh; bf16* O;
    __device__ __forceinline__ const char* a_base(const Unit& u) const { return A + (size_t)u.pm * 256 * LDA * 2; }
    __device__ __forceinline__ const char* b_base(const Unit& u) const { return B + (size_t)u.pn * 256 * LDB * 2; }
    __device__ __forceinline__ void mid(AccT& acc, const Unit& u, int t, int wr, int wc, int fr, int fq) const {
        const int gsel = (t == MID0) ? 0 : 1;
        int row0 = u.pm * 256 + wr * 64 + fr; const int col0 = u.pn * 256 + wc * 32 + 8 * fq; asm volatile("" : "+v"(row0));
        u32x2 va[2][4][2], vb[2][4][2];
#pragma unroll
        for (int ai = 0; ai < 2; ++ai)
#pragma unroll
            for (int m = 0; m < 4; ++m) { const unsigned char* zr = (const unsigned char*)(zh + (size_t)(row0 + ai * 128 + m * 16) * INC + 4096) + gsel * 1024 + col0;
#pragma unroll
                for (int bj = 0; bj < 2; ++bj) { va[ai][m][bj] = *(const u32x2*)(zr + bj * 128); vb[ai][m][bj] = *(const u32x2*)(zr + 1024 + bj * 128); } }
#pragma unroll
        for (int ai = 0; ai < 2; ++ai) {
#pragma unroll
            for (int m = 0; m < 4; ++m)
#pragma unroll
                for (int bj = 0; bj < 2; ++bj)
#pragma unroll
                    for (int e = 0; e < 8; ++e) { const unsigned wa = (e < 4) ? va[ai][m][bj].x : va[ai][m][bj].y, wb = (e < 4) ? vb[ai][m][bj].x : vb[ai][m][bj].y;
                        const float sa = (float)((wa >> (8 * (e & 3))) & 255u), sb = (float)((wb >> (8 * (e & 3))) & 255u);
                        acc[ai][bj][m][e >> 2][e & 3] *= sa * frcp(sb); }
            asm volatile("" ::: "memory"); }
    }
    __device__ __forceinline__ void epi(AccT& acc, const Unit& u, int wr, int wc, int fr, int fq) const {
        int row0 = u.pm * 256 + wr * 64 + fr; const int col0 = u.pn * 256 + wc * 32 + 8 * fq; asm volatile("" : "+v"(row0));
        u32x2 vc8[2][4][2];
#pragma unroll
        for (int ai = 0; ai < 2; ++ai)
#pragma unroll
            for (int m = 0; m < 4; ++m) { const unsigned char* zr = (const unsigned char*)(zh + (size_t)(row0 + ai * 128 + m * 16) * INC + 4096) + 2048 + col0;
#pragma unroll
                for (int bj = 0; bj < 2; ++bj) vc8[ai][m][bj] = *(const u32x2*)(zr + bj * 128); }
#pragma unroll
        for (int ai = 0; ai < 2; ++ai) {
            u32x2 vc[4][2];
#pragma unroll
            for (int m = 0; m < 4; ++m)
#pragma unroll
                for (int bj = 0; bj < 2; ++bj) vc[m][bj] = vc8[ai][m][bj];
#pragma unroll
            for (int m = 0; m < 4; ++m) { bf16* rowp = O + (size_t)(row0 + ai * 128 + m * 16) * D + col0;
#pragma unroll
                for (int bj = 0; bj < 2; ++bj) { float sc[8];
#pragma unroll
                    for (int e = 0; e < 8; ++e) { const unsigned wv = (e < 4) ? vc[m][bj].x : vc[m][bj].y; sc[e] = (float)((wv >> (8 * (e & 3))) & 255u) * (1.0f / 255.0f); }
                    u32x4 w;
#pragma unroll
                    for (int e = 0; e < 4; ++e) w[e] = cvt_pk_bf16(acc[ai][bj][m][e >> 1][(e & 1) * 2] * sc[2 * e], acc[ai][bj][m][e >> 1][(e & 1) * 2 + 1] * sc[2 * e + 1]);
                    *(u32x4*)(rowp + bj * 128) = w; } }
            asm volatile("" ::: "memory"); }
    }
};
struct ProbG3 : DenseBase {
    static constexpr int NT = 16, LDA = 1024, LDB = 1024; static constexpr bool PERM = true, ALIGN = true;
    const char* A; const char* B; const float* xin32; bf16* xs;
    __device__ __forceinline__ bool next(int i, Unit& u) const {
        if (S.G != 256) return S.next(i, u);
        if (i >= 2) return false;
        const int off = S.c >> 3; u.rep = 0; u.pm = (1 - i) * 64 + 8 * (S.c & 7) + (off & 7); u.pn = off >> 3; return true; }
    __device__ __forceinline__ const char* a_base(const Unit& u) const { return A + (size_t)u.pm * 256 * LDA * 2; }
    __device__ __forceinline__ const char* b_base(const Unit& u) const { return B + (size_t)u.pn * 256 * LDB * 2; }
    __device__ __forceinline__ void epi(AccT& acc, const Unit& u, int wr, int wc, int fr, int fq) const {
        int row0 = u.pm * 256 + wr * 64 + fr; const int col0 = u.pn * 256 + wc * 32 + 8 * fq; asm volatile("" : "+v"(row0));
        u32x4 xd[2][4][2];
#pragma unroll
        for (int ai = 0; ai < 2; ++ai)
#pragma unroll
            for (int m = 0; m < 4; ++m) { const bf16* xr = xs + (size_t)(row0 + ai * 128 + m * 16) * D + col0;
#pragma unroll
                for (int bj = 0; bj < 2; ++bj) xd[ai][m][bj] = *(const u32x4*)(xr + bj * 128); }
#pragma unroll
        for (int ai = 0; ai < 2; ++ai)
#pragma unroll
            for (int m = 0; m < 4; ++m) { bf16* xo = xs + (size_t)(row0 + ai * 128 + m * 16) * D + col0;
#pragma unroll
                for (int bj = 0; bj < 2; ++bj) { const u32x4 d = xd[ai][m][bj];
                    const f32x4 v0 = (f32x4){bflo(d.x), bfhi(d.x), bflo(d.y), bfhi(d.y)} + acc[ai][bj][m][0], v1 = (f32x4){bflo(d.z), bfhi(d.z), bflo(d.w), bfhi(d.w)} + acc[ai][bj][m][1];
                    u32x4 w; w.x = cvt_pk_bf16(v0[0], v0[1]); w.y = cvt_pk_bf16(v0[2], v0[3]); w.z = cvt_pk_bf16(v1[0], v1[1]); w.w = cvt_pk_bf16(v1[2], v1[3]);
                    *(u32x4*)(xo + bj * 128) = w; } }
    }
};
struct MoeBase {
    static constexpr bool HAS_MID = false, PRE = false; static constexpr int MID0 = -1, MID1 = -1;
    volatile LAS unsigned* MISC; const i32x4* rinfo; int G, c, nsh, dupm = 1;
    __device__ __forceinline__ bool next(int i, Unit& u) const { int L = i * G + c; const int np = (int)MISC[MW_NPAN]; const int tot = np << nsh; if (L >= tot * dupm) return false; if (dupm > 1) L %= tot; u.rep = 0; u.pm = L >> nsh; u.pn = L & ((1 << nsh) - 1); return true; }
    __device__ __forceinline__ void mid(AccT&, const Unit&, int, int, int, int, int) const {}
    __device__ __forceinline__ void pinfo(const Unit& u, int& cls, int& lp, int& cnt) const { const unsigned pt = MISC[MW_PT + u.pm]; cls = (int)(pt >> 8); lp = (int)(pt & 255u); cnt = (int)MISC[MW_CNT + cls]; }
    static __device__ __forceinline__ int e_lo(int cls) { const int g = cls / 6, pi = cls - g * 6; return g * 4 + ((0x940 >> (2 * pi)) & 3); }
    static __device__ __forceinline__ int e_hi(int cls) { const int g = cls / 6, pi = cls - g * 6; return g * 4 + ((0xFB9 >> (2 * pi)) & 3); }
};
struct ProbMA : MoeBase {
    static constexpr int NT = 8, LDA = 512, LDB = 512, BSEG = 1 << 20, SCALE_A = 0x7C7C7C7C, SCALE_B = 0x7C7C7C7C; static constexpr bool PERM = true, ALIGN = true, GATHER = true, F8 = true, PRE = true;
    const char* A; const char* B; unsigned char* hid;
    __device__ __forceinline__ void pre_next(const Unit& u, LAS unsigned char* scr, int wid, int lane) const {
        if (wid < 4) { int cls, lp, cnt; pinfo(u, cls, lp, cnt);
            __builtin_amdgcn_global_load_lds((const unsigned*)(rinfo + (size_t)cls * CAP + lp * 256 + wid * 64 + lane), (LAS unsigned*)(scr + wid * 1024), 16, 0, 0); } }
    __device__ __forceinline__ void a_rows_lds(const Unit& u, const int (&R)[2], const int (&C)[2], unsigned (&ro)[2][2], LAS unsigned char* scr) const {
        int cls, lp, cnt; pinfo(u, cls, lp, cnt);
#pragma unroll
        for (int h = 0; h < 2; ++h)
#pragma unroll
            for (int i = 0; i < 2; ++i) { const int idx = h * 128 + R[i]; const int tk = *(const LAS int*)(scr + idx * 16); const int tok = (lp * 256 + idx < cnt) ? tk : 0; ro[h][i] = (unsigned)(tok * LDA + C[i]) * 2u; }
    }
    __device__ __forceinline__ const char* a_gbase() const { return A; }
    __device__ __forceinline__ const char* a_base(const Unit&) const { return A; }
    __device__ __forceinline__ long b_delta(const Unit&) const { return 0l; }
    __device__ __forceinline__ void a_rows(const Unit& u, const int (&R)[2], const int (&C)[2], unsigned (&ro)[2][2]) const {
        int cls, lp, cnt; pinfo(u, cls, lp, cnt);
#pragma unroll
        for (int h = 0; h < 2; ++h)
#pragma unroll
            for (int i = 0; i < 2; ++i) ro[h][i] = (unsigned)rinfo[(size_t)cls * CAP + lp * 256 + h * 128 + R[i]].x;
        asm volatile("" : "+v"(ro[0][0]), "+v"(ro[0][1]), "+v"(ro[1][0]), "+v"(ro[1][1]));
#pragma unroll
        for (int h = 0; h < 2; ++h)
#pragma unroll
            for (int i = 0; i < 2; ++i) { const int slot = lp * 256 + h * 128 + R[i]; const int tok = (slot < cnt) ? (int)ro[h][i] : 0; ro[h][i] = (unsigned)(tok * LDA + C[i]) * 2u; }
    }
    __device__ __forceinline__ const char* b_base(const Unit& u) const { int cls, lp, cnt; pinfo(u, cls, lp, cnt); const int e = (u.pn < 4) ? e_lo(cls) : e_hi(cls); return B + ((size_t)e * 1024 + (u.pn & 3) * 256) * LDB * 2; }
    __device__ __forceinline__ void epi_lds(AccT& acc, const Unit& u, int wr, int wc, int fr, int fq, LAS unsigned char* scr) const {
        int cls, lp, cnt; pinfo(u, cls, lp, cnt);
        int r0 = wr * 64 + fr; const int colb = (u.pn >> 2) * 512 + (u.pn & 3) * 128 + wc * 32 + 8 * fq; asm volatile("" : "+v"(r0));
        const SigC sk = sigc_make(1.0f); float k448 = 448.f; asm volatile("" : "+s"(k448));
        float gv[2][4], rv[2][4];
        { const LAS int* ri = (const LAS int*)(scr + r0 * 16) + (u.pn < 4 ? 1 : 2);
#pragma unroll
          for (int ai = 0; ai < 2; ++ai)
#pragma unroll
              for (int m = 0; m < 4; ++m) { gv[ai][m] = __int_as_float(ri[(ai * 128 + m * 16) * 4]); rv[ai][m] = __int_as_float(((const LAS int*)(scr + r0 * 16))[(ai * 128 + m * 16) * 4 + 3]); } }
#pragma unroll
        for (int ai = 0; ai < 2; ++ai)
#pragma unroll
            for (int m = 0; m < 4; ++m) { const int rr = r0 + ai * 128 + m * 16, slot = lp * 256 + rr; const bool live = slot < cnt;
                float gate = live ? gv[ai][m] : 0.f, rs = live ? rv[ai][m] : 0.f;
                gate *= rs;
                { float k16 = 16.0f; asm volatile("" : "+v"(k16)); gate *= k16; }
                f32x4 hq[2];
#pragma unroll
                for (int n = 0; n < 2; ++n) { const f32x4 a = acc[ai][0][m][n] * rs; const f32x4 sg = sig_odd4(a, sk) + 0.5f; f32x4 h = ((a * gate) * sg) * acc[ai][1][m][n];
#pragma unroll
                    for (int e = 0; e < 4; ++e) h[e] = __builtin_amdgcn_fmed3f(h[e], -k448, k448);
                    hq[n] = h; }
                u32x2 w; int t0 = __builtin_amdgcn_cvt_pk_fp8_f32(hq[0][0], hq[0][1], 0, false); t0 = __builtin_amdgcn_cvt_pk_fp8_f32(hq[0][2], hq[0][3], t0, true);
                int t1 = __builtin_amdgcn_cvt_pk_fp8_f32(hq[1][0], hq[1][1], 0, false); t1 = __builtin_amdgcn_cvt_pk_fp8_f32(hq[1][2], hq[1][3], t1, true); w.x = (unsigned)t0; w.y = (unsigned)t1;
                *(u32x2*)(hid + (size_t)(u.pm * 256 + rr) * 1024 + colb) = w; }
    }
};
struct ProbMB : MoeBase {
    static constexpr int NT = 8, LDA = 512, LDB = 256, BSEG = 4, SCALE_A = 0x7B7B7B7B, SCALE_B = 0x7B7B7B7B; static constexpr bool PERM = true, ALIGN = true, GATHER = true, F8 = true, PRE = true;
    const char* A; const char* B; bf16* xs;
    __device__ __forceinline__ void pre_next(const Unit& u, LAS unsigned char* scr, int wid, int lane) const {
        if (wid < 4) { int cls, lp, cnt; pinfo(u, cls, lp, cnt);
            __builtin_amdgcn_global_load_lds((const unsigned*)(rinfo + (size_t)cls * CAP + lp * 256 + wid * 64 + lane), (LAS unsigned*)(scr + wid * 1024), 16, 0, 0); } }
    __device__ __forceinline__ void a_rows_lds(const Unit& u, const int (&R)[2], const int (&C)[2], unsigned (&ro)[2][2], LAS unsigned char*) const { a_rows(u, R, C, ro); }
    __device__ __forceinline__ const char* a_gbase() const { return A; }
    __device__ __forceinline__ void a_rows(const Unit& u, const int (&R)[2], const int (&C)[2], unsigned (&ro)[2][2]) const {
#pragma unroll
        for (int h = 0; h < 2; ++h)
#pragma unroll
            for (int i = 0; i < 2; ++i) ro[h][i] = (unsigned)((u.pm * 256 + h * 128 + R[i]) * LDA + C[i]) * 2u; }
    __device__ __forceinline__ const char* a_base(const Unit& u) const { return A + (size_t)u.pm * 256 * LDA * 2; }
    __device__ __forceinline__ const char* b_base(const Unit& u) const { int cls, lp, cnt; pinfo(u, cls, lp, cnt); return B + ((size_t)e_lo(cls) * 1024 + u.pn * 256) * LDB * 2; }
    __device__ __forceinline__ long b_delta(const Unit& u) const { int cls, lp, cnt; pinfo(u, cls, lp, cnt); return (long)(e_hi(cls) - e_lo(cls)) * 1024 * LDB * 2 - 4 * 128; }
    __device__ __forceinline__ void epi_lds(AccT& acc, const Unit& u, int wr, int wc, int fr, int fq, LAS unsigned char* scr) const {
        int cls, lp, cnt; pinfo(u, cls, lp, cnt);
        int r0 = wr * 64 + fr; const int col0 = u.pn * 256 + wc * 32 + 8 * fq; asm volatile("" : "+v"(r0));
        int tk8[2][4];
#pragma unroll
        for (int ai = 0; ai < 2; ++ai)
#pragma unroll
            for (int m = 0; m < 4; ++m) tk8[ai][m] = *(const LAS int*)(scr + (r0 + ai * 128 + m * 16) * 16);
        int tok[2][4]; u32x4 xv[2][4][2];
#pragma unroll
        for (int ai = 0; ai < 2; ++ai)
#pragma unroll
            for (int m = 0; m < 4; ++m) { const int slot = lp * 256 + r0 + ai * 128 + m * 16; tok[ai][m] = (slot < cnt) ? tk8[ai][m] : -1; const bf16* xr = xs + (size_t)(tok[ai][m] < 0 ? 0 : tok[ai][m]) * D + col0;
#pragma unroll
                for (int bj = 0; bj < 2; ++bj) xv[ai][m][bj] = *(const u32x4*)(xr + bj * 128); }
#pragma unroll
        for (int ai = 0; ai < 2; ++ai) {
#pragma unroll
            for (int m = 0; m < 4; ++m) if (tok[ai][m] >= 0) { bf16* xr = xs + (size_t)tok[ai][m] * D + col0;
#pragma unroll
                for (int bj = 0; bj < 2; ++bj) { const u32x4 d = xv[ai][m][bj]; const f32x4 a0 = acc[ai][bj][m][0], a1 = acc[ai][bj][m][1];
                    u32x4 w; w.x = cvt_pk_bf16(bflo(d.x) + a0[0], bfhi(d.x) + a0[1]); w.y = cvt_pk_bf16(bflo(d.y) + a0[2], bfhi(d.y) + a0[3]);
                    w.z = cvt_pk_bf16(bflo(d.z) + a1[0], bfhi(d.z) + a1[1]); w.w = cvt_pk_bf16(bflo(d.w) + a1[2], bfhi(d.w) + a1[3]);
                    *(u32x4*)(xr + bj * 128) = w; } }
            asm volatile("" ::: "memory"); }
    }
};
__device__ __forceinline__ void moe_panel_table(const Frame& F, int l) {
    __syncthreads();
    if (F.tid < NCLS) { const int cls = F.tid; const unsigned* gc = F.ctl + CW_CNT + 64 * l;
        const unsigned cnt = __hip_atomic_load(gc + cls, __ATOMIC_RELAXED, __HIP_MEMORY_SCOPE_AGENT); const int k = (int)((cnt + 255u) >> 8);
        F.MISC[MW_CNT + cls] = cnt; F.MISC[MW_SCR + 8 + cls] = (unsigned)k;
        LDS_WAIT();
        int base = 0;
        for (int j = 0; j < NCLS; ++j) { const int kj = (int)F.MISC[MW_SCR + 8 + j]; base += (j < cls) ? kj : 0; }
        for (int j = 0; j < k; ++j) F.MISC[MW_PT + base + j] = ((unsigned)cls << 8) | (unsigned)j;
        if (cls == NCLS - 1) F.MISC[MW_NPAN] = (unsigned)(base + k); }
    __syncthreads();
}

__device__ __forceinline__ void tr_item(const float* W, int N, int k0, int n0, const float* gain, bf16* dst, int ldd, int drow0, int kofs, LAS float* scr, int lane) {
    float tv[32];
#pragma unroll
    for (int i = 0; i < 32; ++i) { const int kk = 2 * i + (lane >> 5); tv[i] = W[(size_t)(k0 + kk) * N + n0 + (lane & 31)]; }
    if (gain) {
#pragma unroll
        for (int i = 0; i < 32; ++i) tv[i] *= gain[k0 + 2 * i + (lane >> 5)]; }
#pragma unroll
    for (int i = 0; i < 32; ++i) { const int kk = 2 * i + (lane >> 5); scr[kk * 33 + (lane & 31)] = tv[i]; }
    LDS_WAIT();
    const int c = lane & 7;
#pragma unroll
    for (int j = 0; j < 4; ++j) { const int n = (lane >> 3) + 8 * j; const LAS float* s = scr + (8 * c) * 33 + n;
        u32x4 o; o.x = cvt_pk_bf16(s[0 * 33], s[1 * 33]); o.y = cvt_pk_bf16(s[2 * 33], s[3 * 33]); o.z = cvt_pk_bf16(s[4 * 33], s[5 * 33]); o.w = cvt_pk_bf16(s[6 * 33], s[7 * 33]);
        *(u32x4*)(dst + (size_t)(drow0 + n) * ldd + kofs + k0 + 8 * c) = o; }
    LDS_WAIT();
}
__device__ __forceinline__ void tr_item_f8(const float* W, int N, int k0, int n0, const float* gain, float scale, unsigned char* dst, int ldd, int drow0, LAS float* scr, int lane) {
    float tv[32];
#pragma unroll
    for (int i = 0; i < 32; ++i) { const int kk = 2 * i + (lane >> 5); tv[i] = W[(size_t)(k0 + kk) * N + n0 + (lane & 31)] * scale; }
    if (gain) {
#pragma unroll
        for (int i = 0; i < 32; ++i) tv[i] *= gain[k0 + 2 * i + (lane >> 5)]; }
    float k448 = 448.f; asm volatile("" : "+v"(k448));
#pragma unroll
    for (int i = 0; i < 32; ++i) { const int kk = 2 * i + (lane >> 5); scr[kk * 33 + (lane & 31)] = fminf(fmaxf(tv[i], -k448), k448); }
    LDS_WAIT();
    const int c = lane & 7;
#pragma unroll
    for (int j = 0; j < 4; ++j) { const int n = (lane >> 3) + 8 * j; const LAS float* s = scr + (8 * c) * 33 + n;
        int t0 = __builtin_amdgcn_cvt_pk_fp8_f32(s[0 * 33], s[1 * 33], 0, false); t0 = __builtin_amdgcn_cvt_pk_fp8_f32(s[2 * 33], s[3 * 33], t0, true);
        int t1 = __builtin_amdgcn_cvt_pk_fp8_f32(s[4 * 33], s[5 * 33], 0, false); t1 = __builtin_amdgcn_cvt_pk_fp8_f32(s[6 * 33], s[7 * 33], t1, true);
        u32x2 o; o.x = (unsigned)t0; o.y = (unsigned)t1;
        *(u32x2*)(dst + (size_t)(drow0 + n) * ldd + k0 + 8 * c) = o; }
    LDS_WAIT();
}
constexpr int CV_IN = 16 * 224, CV_A = 8 * 32, CV_B = 16 * 32, CV_O = 16 * 32, CV_W1 = 16 * 16 * 16, CV_W2 = 16 * 8 * 32, CV_PL = 4 * 2 * 4;
constexpr int CV_N0 = CV_PL, CV_N1 = CV_IN + 2 * CV_A + CV_B + CV_O, CV_N2 = 2 * CV_W1, CV_N3 = CV_W2;
__device__ __forceinline__ int conv_count(int grp) { return grp == 0 ? CV_N0 : grp == 1 ? CV_N1 : grp == 2 ? CV_N2 : CV_N3; }
__device__ __forceinline__ void conv_item(const Frame& F, int l, int grp, int r, LAS float* scr) {
    const float* const* in = F.in; unsigned char* ws = F.ws;
    if (grp == 0) { const int g = r >> 3, q = r & 7, kb = q >> 2, nb = q & 3;
        tr_item(in[13] + ((size_t)l * 4 + g) * 128 * 128, 128, kb * 64, nb * 32, nullptr, (bf16*)(ws + WS_PLT) + (size_t)g * 128 * 128, 128, nb * 32, 0, scr, F.lane); return; }
    if (grp == 1) {
        if (r < CV_IN) { const int kb = r / 224, nb = r % 224;
            const int n0 = nb * 32;
            if (n0 < 1536 || (n0 >= 3584 && n0 < 4096)) tr_item(in[2] + (size_t)l * D * INC, INC, kb * 64, n0, in[1] + (size_t)l * D, (bf16*)(ws + WS_WINT), 1024, n0, 0, scr, F.lane);
            else tr_item_f8(in[2] + (size_t)l * D * INC, INC, kb * 64, n0, in[1] + (size_t)l * D, 32.0f, ws + WS_WING8, 1024, n0 < 3584 ? n0 - 1536 : n0 - 2048, scr, F.lane);
            return; } r -= CV_IN;
        if (r < CV_A) { const int kb = r / 32, nb = r % 32; tr_item(in[4] + (size_t)l * W_A * D, D, kb * 64, nb * 32, nullptr, (bf16*)(ws + WS_WCAT), 2048, nb * 32, 0, scr, F.lane); return; } r -= CV_A;
        if (r < CV_B) { const int kb = r / 32, nb = r % 32; tr_item(in[12] + (size_t)l * W_B * D, D, kb * 64, nb * 32, nullptr, (bf16*)(ws + WS_WCAT), 2048, nb * 32, 512, scr, F.lane); return; } r -= CV_B;
        if (r < CV_A) { const int kb = r / 32, nb = r % 32; tr_item(in[15] + (size_t)l * W_C * D, D, kb * 64, nb * 32, nullptr, (bf16*)(ws + WS_WCAT), 2048, nb * 32, 1536, scr, F.lane); return; } r -= CV_A;
        { const int kb = r / 32, nb = r % 32; tr_item(in[16] + (size_t)l * D * D, D, kb * 64, nb * 32, nullptr, (bf16*)(ws + WS_WOT), 1024, nb * 32, 0, scr, F.lane); } return; }
    if (grp == 2) { const int sel = r / CV_W1; r -= sel * CV_W1; const int e = r >> 8, q = r & 255, kb = q >> 4, nb = q & 15, n0 = nb * 32;
        tr_item_f8(in[sel ? 23 : 22] + ((size_t)l * NE + e) * D * DE, DE, kb * 64, n0, in[17] + (size_t)l * D, 64.0f, ws + WS_BAT + (size_t)e * 1024 * 1024, 1024, 256 * (n0 >> 7) + 128 * sel + (n0 & 127), scr, F.lane); return; }
    { const int e = r >> 8, q = r & 255, kb = q >> 5, nb = q & 31;
        tr_item_f8(in[24] + ((size_t)l * NE + e) * DE * D, D, kb * 64, nb * 32, nullptr, 16.0f, ws + WS_W2T + (size_t)e * 1024 * 512, 512, nb * 32, scr, F.lane); }
}
__device__ __forceinline__ void convert_weights(const Frame& F, int l, int mask) {
    LAS float* scr = (LAS float*)(F.lds + F.wave * 8448);
    const int gw = F.c * NWAVES + F.wave, NGW = F.G * NWAVES;
#pragma unroll 1
    for (int grp = 0; grp < 4; ++grp) if (mask & (1 << grp)) { const int n = conv_count(grp); for (int it = gw; it < n; it += NGW) conv_item(F, l, grp, it, scr); }
}
__device__ __forceinline__ void convert_queue(const Frame& F, int l, int grp, unsigned* counter) {
    LAS float* scr = (LAS float*)(F.lds + F.wave * 8448); const int n = conv_count(grp);
    for (;;) {
        __syncthreads();
        if (F.tid == 0) F.MISC[MW_SCR] = __hip_atomic_fetch_add(counter, 8u, __ATOMIC_RELAXED, __HIP_MEMORY_SCOPE_AGENT);
        __syncthreads();
        const int base = (int)F.MISC[MW_SCR];
        if (base >= n) break;
        const int it = base + F.wave; if (it < n) conv_item(F, l, grp, it, scr);
    }
}
__device__ __forceinline__ void norm_row_prep(const float* xrow32, bf16* xsrow, unsigned char* orow8, float* rstd_out, int lane) {
    f32x4 v[4]; float s = 0.f;
    if (xrow32) { const f32x4* xr = (const f32x4*)xrow32 + lane;
#pragma unroll
        for (int j = 0; j < 4; ++j) v[j] = xr[64 * j];
        u32x2* o8 = (u32x2*)xsrow + lane;
#pragma unroll
        for (int j = 0; j < 4; ++j) { u32x2 w; w.x = cvt_pk_bf16(v[j].x, v[j].y); w.y = cvt_pk_bf16(v[j].z, v[j].w); o8[64 * j] = w; v[j] = (f32x4){bflo(w.x), bfhi(w.x), bflo(w.y), bfhi(w.y)}; } }
    else { const u32x2* xr = (const u32x2*)xsrow + lane;
#pragma unroll
        for (int j = 0; j < 4; ++j) { const u32x2 d = xr[64 * j]; v[j] = (f32x4){bflo(d.x), bfhi(d.x), bflo(d.y), bfhi(d.y)}; } }
#pragma unroll
    for (int j = 0; j < 4; ++j) s += (v[j].x * v[j].x + v[j].y * v[j].y) + (v[j].z * v[j].z + v[j].w * v[j].w);
    const float rstd = rsqrtf(wave_sum(s) * (1.f / D) + EPS);
    if (lane == 0) *rstd_out = rstd;
    unsigned* q8 = (unsigned*)orow8 + lane;
    const float r2 = 2.0f * rstd;
#pragma unroll
    for (int j = 0; j < 4; ++j) { int p = __builtin_amdgcn_cvt_pk_fp8_f32(r2 * v[j].x, r2 * v[j].y, 0, false); p = __builtin_amdgcn_cvt_pk_fp8_f32(r2 * v[j].z, r2 * v[j].w, p, true); q8[64 * j] = (unsigned)p; }
}
__device__ __forceinline__ void phase_n1(const Frame& F, int l) {
    convert_weights(F, l, l == 0 ? 15 : 8);
    { const float* g2 = F.in[17] + (size_t)l * D; const float* wg = F.in[18] + (size_t)l * D * NG; const float* we = F.in[20] + (size_t)l * D * NE; bf16* gwp = (bf16*)(F.ws + WS_GW);
      for (int idx = F.c * NTHR + F.tid; idx < 20 * 1024; idx += F.G * NTHR) { const int j = idx >> 10, k = idx & 1023; const float v = g2[k] * (j < 4 ? wg[k * NG + j] : we[k * NE + (j - 4)]);
          const bf16 hi = f2bf(v); gwp[idx] = hi; gwp[20 * 1024 + idx] = f2bf(v - bf2f(hi)); } }
    const float* x32 = (l == 0) ? F.in[0] : nullptr; bf16* xs = (bf16*)(F.ws + WS_XS); float* rs = (float*)(F.ws + WS_RSTD);
    const int gw = F.c * NWAVES + F.wave, NGW = F.G * NWAVES;
    for (int m = gw; m < T; m += NGW) norm_row_prep(x32 ? x32 + (size_t)m * D : nullptr, xs + (size_t)m * D, F.ws + (m < TH ? WS_XB8A : WS_XB8B) + (size_t)(m < TH ? m : m - TH) * D, rs + m, F.lane);
}
__device__ __forceinline__ void phase_final(const Frame& F) {
    const float* g = F.in[25]; const int gw = F.c * NWAVES + F.wave, NGW = F.G * NWAVES;
    f32x4 gv[4];
#pragma unroll
    for (int j = 0; j < 4; ++j) gv[j] = ((const f32x4*)g)[F.lane + 64 * j];
    const bf16* xs = (const bf16*)(F.ws + WS_XS);
    for (int m = gw; m < T; m += NGW) { const u32x2* xi = (const u32x2*)(xs + (size_t)m * D) + F.lane; f32x4* xr = (f32x4*)(F.out + (size_t)m * D) + F.lane; f32x4 v[4]; float s = 0.f;
#pragma unroll
        for (int j = 0; j < 4; ++j) { const u32x2 d = xi[64 * j]; v[j] = (f32x4){bflo(d.x), bfhi(d.x), bflo(d.y), bfhi(d.y)}; s += (v[j].x * v[j].x + v[j].y * v[j].y) + (v[j].z * v[j].z + v[j].w * v[j].w); }
        const float rstd = rsqrtf(wave_sum(s) * (1.f / D) + EPS);
#pragma unroll
        for (int j = 0; j < 4; ++j) xr[64 * j] = v[j] * rstd * gv[j]; }
}
constexpr int RT_ROWB = 2064;
constexpr int RT_HI = 0, RT_LO = 20 * RT_ROWB, RT_HIST = 2 * 20 * RT_ROWB, RT_GBASE = RT_HIST + 128, RT_RTMP = RT_HIST + 256, RT_LG = RT_RTMP + 2048, RT_RS = RT_LG + 8 * 16 * 32 * 4;
__device__ __forceinline__ void phase_router(const Frame& F, int l, int rep = 0) {
    LAS unsigned char* lds = F.lds;
    LAS unsigned* hist = (LAS unsigned*)(lds + RT_HIST); LAS unsigned* gbase = (LAS unsigned*)(lds + RT_GBASE); LAS i32x4* rtmp = (LAS i32x4*)(lds + RT_RTMP);
    LAS float* LG = (LAS float*)(lds + RT_LG) + F.wave * 16 * 32; LAS float* RS = (LAS float*)(lds + RT_RS) + F.wave * 16;
    const float* g2 = F.in[17] + (size_t)l * D; const float* wg = F.in[18] + (size_t)l * D * NG; const float* we = F.in[20] + (size_t)l * D * NE;
    const float* bg = F.in[19] + (size_t)l * NG; const float* be = F.in[21] + (size_t)l * NE;
    __syncthreads();
    { const bf16* gwp = (const bf16*)(F.ws + WS_GW);
      for (int p = F.tid; p < 2 * 20 * 128; p += NTHR) { const int hl = p / 2560, r = p - hl * 2560, j = r >> 7, c16 = r & 127;
          *(LAS u32x4*)(lds + (hl ? RT_LO : RT_HI) + j * RT_ROWB + c16 * 16) = *(const u32x4*)(gwp + (size_t)hl * 20480 + j * 1024 + c16 * 8); } }
    const bf16* x = (const bf16*)(F.ws + WS_XS); bf16* h2 = (bf16*)(F.ws + WS_XB); i32x4* rinfo = (i32x4*)(F.ws + (rep ? WS_ZH + 112 * MiB : WS_RINFO)); unsigned* gcnt = F.ctl + CW_CNT + 64 * (l + 2 * rep);
    const int lane = F.lane, fr = lane & 15, fq = lane >> 4;
    for (int blk = F.c; blk < T / 128; blk += F.G) {
        if (F.tid < 32) hist[F.tid] = 0u;
        __syncthreads();
        const int row = blk * 128 + F.wave * 16 + fr;
        const bf16* xr = x + (size_t)row * D + 16 * fq; unsigned char* hr = (unsigned char*)h2 + (size_t)row * D + 16 * fq;
        f32x4 d0 = (f32x4){0.f, 0.f, 0.f, 0.f}, d1 = d0; float ss = 0.f;
        const bool n1ok = fr < 4;
#pragma unroll 1
        for (int kh = 0; kh < 2; ++kh) {
        u32x4 hv[16];
#pragma unroll
        for (int i = 0; i < 16; ++i) hv[i] = *(const u32x4*)(xr + 64 * (8 * kh + (i >> 1)) + 8 * (i & 1));
#pragma unroll
        for (int kq = 0; kq < 8; ++kq) { const int kp = 8 * kh + kq;
            const u32x4 hA = hv[2 * kq], hB = hv[2 * kq + 1];
            u32x4 q;
#pragma unroll
            for (int sst = 0; sst < 2; ++sst) { const u32x4 hi = sst ? hB : hA;
                const f32x4 v0 = (f32x4){bflo(hi.x), bfhi(hi.x), bflo(hi.y), bfhi(hi.y)}, v1 = (f32x4){bflo(hi.z), bfhi(hi.z), bflo(hi.w), bfhi(hi.w)};
                ss += (v0.x * v0.x + v0.y * v0.y) + (v0.z * v0.z + v0.w * v0.w) + (v1.x * v1.x + v1.y * v1.y) + (v1.z * v1.z + v1.w * v1.w);
                int t0 = __builtin_amdgcn_cvt_pk_fp8_f32(v0.x, v0.y, 0, false); t0 = __builtin_amdgcn_cvt_pk_fp8_f32(v0.z, v0.w, t0, true);
                int t1 = __builtin_amdgcn_cvt_pk_fp8_f32(v1.x, v1.y, 0, false); t1 = __builtin_amdgcn_cvt_pk_fp8_f32(v1.z, v1.w, t1, true);
                if (sst) { q.z = (unsigned)t0; q.w = (unsigned)t1; } else { q.x = (unsigned)t0; q.y = (unsigned)t1; }
                const bf16x8 ah = __builtin_bit_cast(bf16x8, hi);
                const int bo = (64 * kp + 16 * fq + 8 * sst) * 2;
                const bf16x8 bh0 = *(const LAS bf16x8*)(lds + RT_HI + fr * RT_ROWB + bo), bl0 = *(const LAS bf16x8*)(lds + RT_LO + fr * RT_ROWB + bo);
                bf16x8 bh1 = (bf16x8){0, 0, 0, 0, 0, 0, 0, 0}, bl1 = bh1;
                if (n1ok) { bh1 = *(const LAS bf16x8*)(lds + RT_HI + (16 + fr) * RT_ROWB + bo); bl1 = *(const LAS bf16x8*)(lds + RT_LO + (16 + fr) * RT_ROWB + bo); }
                d0 = __builtin_amdgcn_mfma_f32_16x16x32_bf16(ah, bh0, d0, 0, 0, 0); d0 = __builtin_amdgcn_mfma_f32_16x16x32_bf16(ah, bl0, d0, 0, 0, 0);
                d1 = __builtin_amdgcn_mfma_f32_16x16x32_bf16(ah, bh1, d1, 0, 0, 0); d1 = __builtin_amdgcn_mfma_f32_16x16x32_bf16(ah, bl1, d1, 0, 0, 0); }
            *(u32x4*)(hr + 64 * kp) = q;
        } }
        ss += __builtin_bit_cast(float, __builtin_amdgcn_ds_bpermute((lane ^ 16) << 2, __builtin_bit_cast(int, ss))); ss += __builtin_bit_cast(float, __builtin_amdgcn_ds_bpermute((lane ^ 32) << 2, __builtin_bit_cast(int, ss)));
        const float rstd = rsqrtf(ss * (1.f / D) + EPS);
        if (fq == 0) RS[fr] = rstd;
#pragma unroll
        for (int r = 0; r < 4; ++r) { LG[(4 * fq + r) * 32 + fr] = d0[r]; LG[(4 * fq + r) * 32 + 16 + fr] = d1[r]; }
        LDS_WAIT();
        if (lane < 16) {
            const float rs = RS[lane]; float lg[20];
#pragma unroll
            for (int q = 0; q < 20; ++q) lg[q] = LG[lane * 32 + q] * rs + (q < 4 ? bg[q] : be[q - 4]);
#pragma unroll
            for (int q = 0; q < 20; ++q) asm volatile("" : "+v"(lg[q]));
            int gi = 0; float mx = lg[0];
#pragma unroll
            for (int j = 1; j < 4; ++j) if (lg[j] > mx) { mx = lg[j]; gi = j; }
            float den = 0.f;
#pragma unroll
            for (int j = 0; j < 4; ++j) den += __expf(lg[j] - mx);
            const float gp = 1.0f / den;
            float el[4];
#pragma unroll
            for (int j = 0; j < 4; ++j) el[j] = (gi == 0) ? lg[4 + j] : (gi == 1) ? lg[8 + j] : (gi == 2) ? lg[12 + j] : lg[16 + j];
            int i1 = 0; float v1 = el[0];
#pragma unroll
            for (int j = 1; j < 4; ++j) if (el[j] > v1) { v1 = el[j]; i1 = j; }
            int i2 = -1; float v2 = 0.f;
#pragma unroll
            for (int j = 0; j < 4; ++j) if (j != i1 && (i2 < 0 || el[j] > v2)) { i2 = j; v2 = el[j]; }
            const float e2 = __expf(v2 - v1); const float p1 = gp / (1.0f + e2), p2 = gp * e2 / (1.0f + e2);
            const int lo_ = i1 < i2 ? i1 : i2, hi_ = i1 < i2 ? i2 : i1; const float glo = i1 < i2 ? p1 : p2, ghi = i1 < i2 ? p2 : p1;
            const int pidx = (lo_ == 0) ? hi_ - 1 : (lo_ == 1 ? hi_ + 1 : 5); const int cls = gi * 6 + pidx;
            const unsigned ls = atomicAdd((unsigned*)(hist + cls), 1u);
            rtmp[F.wave * 16 + lane] = (i32x4){cls | ((int)ls << 8), __float_as_int(glo), __float_as_int(ghi), __float_as_int(rs)};
        }
        __syncthreads();
        if (F.tid < NCLS) gbase[F.tid] = __hip_atomic_fetch_add(gcnt + F.tid, hist[F.tid], __ATOMIC_RELAXED, __HIP_MEMORY_SCOPE_AGENT);
        __syncthreads();
        if (F.tid < 128) { const i32x4 r = rtmp[F.tid]; const int cls = r.x & 255; const unsigned slot = gbase[cls] + (unsigned)(r.x >> 8); rinfo[(size_t)cls * CAP + slot] = (i32x4){blk * 128 + F.tid, r.y, r.z, r.w}; }
        __syncthreads();
    }
}

constexpr int L_CU = 0, L_PW = 38912, L_PC = 73728;
__device__ __forceinline__ void stage_pad128(const bf16* src, LAS unsigned char* dst, int tid) {
    u32x4 v[4];
#pragma unroll
    for (int i = 0; i < 4; ++i) { const int p = tid + i * NTHR; v[i] = *(const u32x4*)(src + (p >> 4) * 128 + (p & 15) * 8); }
#pragma unroll
    for (int i = 0; i < 4; ++i) { const int p = tid + i * NTHR; *(LAS u32x4*)(dst + (p >> 4) * 272 + (p & 15) * 16) = v[i]; }
}
constexpr int L2_RS = 288;
constexpr int L2_WI = 0, L2_WR = 18432, L2_WAGG = 36864, L2_OT = 38912, L2_CST = 40960, L2_XT = 41984, L2_XTB = 37888;
struct LruCtx { int w, fr, fq; bf16* yrow; };
__device__ __forceinline__ float dpp_shr(float oldv, float v, int d) {
    int r;
    switch (d) { case 1: r = __builtin_amdgcn_update_dpp(__builtin_bit_cast(int, oldv), __builtin_bit_cast(int, v), 0x111, 0xf, 0xf, false); break;
                 case 2: r = __builtin_amdgcn_update_dpp(__builtin_bit_cast(int, oldv), __builtin_bit_cast(int, v), 0x112, 0xf, 0xf, false); break;
                 case 4: r = __builtin_amdgcn_update_dpp(__builtin_bit_cast(int, oldv), __builtin_bit_cast(int, v), 0x114, 0xf, 0xf, false); break;
                 default: r = __builtin_amdgcn_update_dpp(__builtin_bit_cast(int, oldv), __builtin_bit_cast(int, v), 0x118, 0xf, 0xf, false); break; }
    return __builtin_bit_cast(float, r);
}
#define LRU_RD12(F, G, WADDR, XADDR, KK) asm volatile("ds_read_b128 %0, %12 offset:%14\n\tds_read_b128 %1, %12 offset:%15\n\tds_read_b128 %2, %12 offset:%16\n\tds_read_b128 %3, %12 offset:%17\n\t" \
        "ds_read_b128 %4, %12 offset:%18\n\tds_read_b128 %5, %12 offset:%19\n\tds_read_b128 %6, %12 offset:%20\n\tds_read_b128 %7, %12 offset:%21\n\t" \
        "ds_read_b128 %8, %13 offset:%22\n\tds_read_b128 %9, %13 offset:%23\n\tds_read_b128 %10, %13 offset:%24\n\tds_read_b128 %11, %13 offset:%25\n\ts_waitcnt lgkmcnt(0)" \
        : "=&v"(F[0]), "=&v"(F[1]), "=&v"(F[2]), "=&v"(F[3]), "=&v"(F[4]), "=&v"(F[5]), "=&v"(F[6]), "=&v"(F[7]), "=&v"(G[0]), "=&v"(G[1]), "=&v"(G[2]), "=&v"(G[3]) : "v"(WADDR), "v"(XADDR), \
          "n"(L2_WR + (KK) * 4352), "n"(L2_WR + (KK) * 4352 + 64), "n"(L2_WR + (KK) * 4352 + 128), "n"(L2_WR + (KK) * 4352 + 192), \
          "n"(L2_WI + (KK) * 4608), "n"(L2_WI + (KK) * 4608 + 64), "n"(L2_WI + (KK) * 4608 + 128), "n"(L2_WI + (KK) * 4608 + 192), \
          "n"((KK) * 288), "n"((KK) * 288 + 64), "n"((KK) * 288 + 128), "n"((KK) * 288 + 192) : "memory")
struct LruSt { float A[4], H[4]; u32x2 by; };
__device__ __forceinline__ void lru_out(const LruCtx& X, LAS unsigned char* lds, const LruSt& S, int ch, int bprev, int bcur, float (&Hs)[4]) {
    const int fr = X.fr, fq = X.fq, w = X.w;
#pragma unroll
    for (int j = 0; j < 8; ++j) { const int q = w + j; const int slot = (q < 8) ? bprev * 8 + q : bcur * 8 + q - 8;
        const LAS float* p = (const LAS float*)(lds + L2_WAGG) + slot * 32 + 8 * fq; const f32x4 v0 = *(const LAS f32x4*)p, v1 = *(const LAS f32x4*)(p + 4);
        Hs[0] = v0.x * Hs[0] + v1.x; Hs[1] = v0.y * Hs[1] + v1.y; Hs[2] = v0.z * Hs[2] + v1.z; Hs[3] = v0.w * Hs[3] + v1.w; }
    float y[4]; const float g0 = bflo(S.by.x), g1 = bfhi(S.by.x), g2 = bflo(S.by.y), g3 = bfhi(S.by.y);
#pragma unroll
    for (int r = 0; r < 4; ++r) { const float h = S.H[r] + S.A[r] * Hs[r];
        y[r] = h * fgelu(r == 0 ? g0 : r == 1 ? g1 : r == 2 ? g2 : g3); }
    u32x2 o; o.x = cvt_pk_bf16(y[0], y[1]); o.y = cvt_pk_bf16(y[2], y[3]);
    *(u32x2*)(X.yrow + ((size_t)ch * 128 + fr) * 2048 + 4 * fq) = o;
}
__device__ __forceinline__ void lru_taps(const LruCtx& X, int tbx, f32x4& ar, f32x4& ai, const bf16x8 (&wk)[8]) {
    const f32x4 z4 = (f32x4){0.f, 0.f, 0.f, 0.f}; ar = z4; ai = z4;
    const unsigned xaddr = (unsigned)(L2_XT + tbx * L2_XTB + (16 * X.w + X.fr) * L2_RS + 16 * X.fq);
    const unsigned waddr = (unsigned)(X.fr * L2_RS + 16 * X.fq);
#define LRU_RD12(F, G, WADDR, XADDR, KK) asm volatile("ds_read_b128 %0, %12 offset:%14\n\tds_read_b128 %1, %12 offset:%15\n\tds_read_b128 %2, %12 offset:%16\n\tds_read_b128 %3, %12 offset:%17\n\t" \
        "ds_read_b128 %4, %12 offset:%18\n\tds_read_b128 %5, %12 offset:%19\n\tds_read_b128 %6, %12 offset:%20\n\tds_read_b128 %7, %12 offset:%21\n\t" \
        "ds_read_b128 %8, %13 offset:%22\n\tds_read_b128 %9, %13 offset:%23\n\tds_read_b128 %10, %13 offset:%24\n\tds_read_b128 %11, %13 offset:%25\n\ts_waitcnt lgkmcnt(0)" \
        : "=&v"(F[0]), "=&v"(F[1]), "=&v"(F[2]), "=&v"(F[3]), "=&v"(F[4]), "=&v"(F[5]), "=&v"(F[6]), "=&v"(F[7]), "=&v"(G[0]), "=&v"(G[1]), "=&v"(G[2]), "=&v"(G[3]) : "v"(WADDR), "v"(XADDR), \
          "n"(L2_WR + (KK) * 4608), "n"(L2_WR + (KK) * 4608 + 64), "n"(L2_WR + (KK) * 4608 + 128), "n"(L2_WR + (KK) * 4608 + 192), \
          "n"(L2_WI + (KK) * 4608), "n"(L2_WI + (KK) * 4608 + 64), "n"(L2_WI + (KK) * 4608 + 128), "n"(L2_WI + (KK) * 4608 + 192), \
          "n"((KK) * 288), "n"((KK) * 288 + 64), "n"((KK) * 288 + 128), "n"((KK) * 288 + 192))
#define LRU_TAPR(KK) do { bf16x8 f_[8], g_[4]; LRU_RD12(f_, g_, waddr, xaddr, KK); \
        _Pragma("unroll") for (int i = 0; i < 4; ++i) { ar = __builtin_amdgcn_mfma_f32_16x16x32_bf16(f_[i], g_[i], ar, 0, 0, 0); ai = __builtin_amdgcn_mfma_f32_16x16x32_bf16(f_[4 + i], g_[i], ai, 0, 0, 0); } } while (0)
    LRU_TAPR(0); LRU_TAPR(1); LRU_TAPR(2);
    { bf16x8 g_[4];
      asm volatile("ds_read_b128 %0, %4 offset:%5\n\tds_read_b128 %1, %4 offset:%6\n\tds_read_b128 %2, %4 offset:%7\n\tds_read_b128 %3, %4 offset:%8\n\ts_waitcnt lgkmcnt(0)"
                   : "=&v"(g_[0]), "=&v"(g_[1]), "=&v"(g_[2]), "=&v"(g_[3]) : "v"(xaddr), "n"(3 * 288), "n"(3 * 288 + 64), "n"(3 * 288 + 128), "n"(3 * 288 + 192));
#pragma unroll
      for (int i = 0; i < 4; ++i) { ar = __builtin_amdgcn_mfma_f32_16x16x32_bf16(wk[i], g_[i], ar, 0, 0, 0); ai = __builtin_amdgcn_mfma_f32_16x16x32_bf16(wk[4 + i], g_[i], ai, 0, 0, 0); } }
#undef LRU_TAPR
#undef LRU_RD12
}
__device__ __forceinline__ void lru_chunk(const LruCtx& X, LAS unsigned char* lds, u32x2& byraw, LruSt& S, f32x4& arN, f32x4& aiN, int ch, int tb, int tb1, int tb2, float (&Hc)[4],
                                          const char* zdma, const unsigned (&doff)[5], const char* byn, unsigned loff8, unsigned xsub, const bf16x8 (&wk)[8]) {
    const int fr = X.fr, fq = X.fq, w = X.w;
    if (ch > 0) lru_out(X, lds, S, ch - 1, tb1, tb2, Hc);
    { LAS unsigned char* dst = lds + L2_XT + (tb2 * L2_XTB) + w * 1024;
#pragma unroll
      for (int j = 0; j < 5; ++j) { const int jj = (w + 8 * j < 37) ? j : 3; __builtin_amdgcn_global_load_lds((const unsigned*)(zdma + doff[jj]), (LAS unsigned*)(dst + jj * 8192), 16, 0, 0); } }
    const u32x2 bynext = *(const u32x2*)(byn + loff8);
    u32x2 xv[4];
#pragma unroll
    for (int kk = 0; kk < 4; ++kk) xv[kk] = *(const LAS u32x2*)(lds + L2_XT + tb * L2_XTB + (16 * w + fr + kk) * L2_RS + xsub);
    f32x4 arX, aiX; lru_taps(X, tb1, arX, aiX, wk);
    float A[4], H[4];
#pragma unroll
    for (int r = 0; r < 4; ++r) { const LAS float* cs = (const LAS float*)(lds + L2_CST) + (4 * fq + r) * 8; const f32x4 c0 = *(const LAS f32x4*)cs, c1 = *(const LAS f32x4*)(cs + 4);
        const float x0 = (r & 1) ? bfhi(r < 2 ? xv[0].x : xv[0].y) : bflo(r < 2 ? xv[0].x : xv[0].y), x1 = (r & 1) ? bfhi(r < 2 ? xv[1].x : xv[1].y) : bflo(r < 2 ? xv[1].x : xv[1].y);
        const float x2 = (r & 1) ? bfhi(r < 2 ? xv[2].x : xv[2].y) : bflo(r < 2 ? xv[2].x : xv[2].y), x3 = (r & 1) ? bfhi(r < 2 ? xv[3].x : xv[3].y) : bflo(r < 2 ? xv[3].x : xv[3].y);
        const float xbr = c0.z + c1.x * x0 + c1.y * x1 + c1.z * x2 + c1.w * x3;
        const float rr = fsig(arN[r] + c0.x), ii = fsig(aiN[r] + c0.y); const float a = __builtin_amdgcn_exp2f(rr * c0.w);
        A[r] = a; H[r] = __builtin_amdgcn_sqrtf(fmaxf(1.0f - a * a, 0.f)) * (ii * xbr); }
#define LRU_STEP(D) "v_fmac_f32_dpp %4, %4, %0 row_shr:" #D " row_mask:0xf bank_mask:0xf\n\tv_fmac_f32_dpp %5, %5, %1 row_shr:" #D " row_mask:0xf bank_mask:0xf\n\t" \
                    "v_fmac_f32_dpp %6, %6, %2 row_shr:" #D " row_mask:0xf bank_mask:0xf\n\tv_fmac_f32_dpp %7, %7, %3 row_shr:" #D " row_mask:0xf bank_mask:0xf\n\t" \
                    "v_mul_f32_dpp %0, %0, %0 row_shr:" #D " row_mask:0xf bank_mask:0xf\n\tv_mul_f32_dpp %1, %1, %1 row_shr:" #D " row_mask:0xf bank_mask:0xf\n\t" \
                    "v_mul_f32_dpp %2, %2, %2 row_shr:" #D " row_mask:0xf bank_mask:0xf\n\tv_mul_f32_dpp %3, %3, %3 row_shr:" #D " row_mask:0xf bank_mask:0xf\n\t"
    asm volatile("s_nop 1\n\t" LRU_STEP(1) LRU_STEP(2) LRU_STEP(4) LRU_STEP(8)
                 : "+v"(A[0]), "+v"(A[1]), "+v"(A[2]), "+v"(A[3]), "+v"(H[0]), "+v"(H[1]), "+v"(H[2]), "+v"(H[3]));
#undef LRU_STEP
    LAS float* WAGG = (LAS float*)(lds + L2_WAGG) + tb * 256;
    if (fr == 15 && ch >= 0) { *(LAS f32x4*)(WAGG + w * 32 + 8 * fq) = (f32x4){A[0], A[1], A[2], A[3]}; *(LAS f32x4*)(WAGG + w * 32 + 8 * fq + 4) = (f32x4){H[0], H[1], H[2], H[3]}; }
    asm volatile("s_waitcnt vmcnt(0) lgkmcnt(0)" ::: "memory");
    __builtin_amdgcn_s_barrier(); asm volatile("" ::: "memory");
#pragma unroll
    for (int r = 0; r < 4; ++r) { S.A[r] = A[r]; S.H[r] = H[r]; }
    S.by = byraw; byraw = bynext; arN = arX; aiN = aiX;
}
__device__ __forceinline__ void lru_seq_unit(const Frame& F, int l, int bl, int hd, int ct, const bf16* zh, bf16* yh) {
    int lane0_; asm volatile("v_mbcnt_lo_u32_b32 %0, -1, 0\n\tv_mbcnt_hi_u32_b32 %0, -1, %0" : "=v"(lane0_));
    LAS unsigned char* lds = F.lds; const int lane = lane0_, w = F.wave, tid = w * 64 + lane, fr = lane & 15, fq = lane >> 4;
    const float* cw = F.in[5] + (size_t)l * 4 * W_B + hd * 128; const float* cb = F.in[6] + (size_t)l * W_B + hd * 128;
    const float* wa = F.in[7] + ((size_t)l * 8 + hd) * 128 * 128 + 16 * ct; const float* wx = F.in[9] + ((size_t)l * 8 + hd) * 128 * 128 + 16 * ct;
    LAS float* CST = (LAS float*)(lds + L2_CST);
    const int ks0 = ct >> 1;
    const size_t tl0 = (size_t)bl * SEQ;
    const char* zt = (const char*)(zh + tl0 * INC + C_BX + hd * 128) - (size_t)3 * INC * 2;
    {
    __syncthreads();
    { const int k = tid >> 2, n4 = (tid & 3) * 4; const f32x4 wa4 = *(const f32x4*)(wa + k * 128 + n4), wx4 = *(const f32x4*)(wx + k * 128 + n4);
      float c4[4];
#pragma unroll
      for (int kk = 0; kk < 4; ++kk) c4[kk] = cw[kk * W_B + k];
      const int slot = ((k >> 5) - ks0) & 3; LAS unsigned char* wbase = lds + n4 * L2_RS + (32 * slot + (k & 31)) * 2;
#pragma unroll
      for (int kk = 0; kk < 4; ++kk)
#pragma unroll
          for (int j = 0; j < 4; ++j) { *(LAS bf16*)(wbase + L2_WR + (kk * 16 + j) * L2_RS) = f2bf(c4[kk] * wa4[j]); *(LAS bf16*)(wbase + L2_WI + (kk * 16 + j) * L2_RS) = f2bf(c4[kk] * wx4[j]); } }
    { LAS float* PART = (LAS float*)(lds + L2_OT);
      const int o = tid & 31, part = tid >> 5, g = o >> 4, n = o & 15; const float* W = g ? wx : wa; float cbv[8], wv[8];
#pragma unroll
      for (int i = 0; i < 8; ++i) { cbv[i] = cb[8 * part + i]; wv[i] = W[(8 * part + i) * 128 + n]; }
      float a = 0.f;
#pragma unroll
      for (int i = 0; i < 8; ++i) a += cbv[i] * wv[i];
      PART[part * 32 + o] = a; }
    { LAS unsigned char* dst = lds + L2_XT + w * 1024;
      int lane3; asm volatile("v_mbcnt_lo_u32_b32 %0, -1, 0\n\tv_mbcnt_hi_u32_b32 %0, -1, %0" : "=v"(lane3));
#pragma unroll 1
      for (int j = 0; j < 5; ++j) if (w + 8 * j < 37) { int p = 64 * (w + 8 * j) + lane3; if (p > 131 * 18 - 1) p = 131 * 18 - 1; const int row = p / 18; int c = p - row * 18; if (c > 15) c = 15; c = (c + 4 * ks0) & 15;
          __builtin_amdgcn_global_load_lds((const unsigned*)(zt + (unsigned)((row < 3 ? 3 : row) * INC + c * 8) * 2u), (LAS unsigned*)(dst + j * 8192), 16, 0, 0); } }
    asm volatile("s_waitcnt vmcnt(0)" ::: "memory");
    { int lz; asm volatile("v_mbcnt_lo_u32_b32 %0, -1, 0\n\tv_mbcnt_hi_u32_b32 %0, -1, %0" : "=v"(lz));
      if (w == 0 && lz < 54) { const unsigned zz = (unsigned)lz >> 31; *(LAS u32x4*)(lds + L2_XT + lz * 16) = (u32x4){zz, zz, zz, zz}; } }
    __syncthreads();
    if (tid < 32) { const int g = tid >> 4, n = tid & 15; float a = (g ? F.in[10] : F.in[8])[(size_t)l * W_B + hd * 128 + 16 * ct + n];
        const LAS float* PART = (const LAS float*)(lds + L2_OT);
#pragma unroll
        for (int q = 0; q < 16; ++q) a += PART[q * 32 + tid];
        CST[n * 8 + g] = a; }
    else if (tid < 48) { const int n = tid - 32, c = 16 * ct + n; CST[n * 8 + 2] = cb[c];
#pragma unroll
        for (int kk = 0; kk < 4; ++kk) CST[n * 8 + 4 + kk] = cw[kk * W_B + c];
        const float lam = F.in[11][(size_t)l * W_B + hd * 128 + c]; const float ex = __expf(-lam); const float sp = (-lam > 20.f) ? -lam : (ex < 0.05f ? ex * (1.0f - ex * (0.5f - ex * (0.33333333f - 0.25f * ex))) : __logf(1.0f + ex)); CST[n * 8 + 3] = -8.0f * sp * 1.4426950408889634f; }
    __syncthreads();
    }
    int lane2; asm volatile("v_mbcnt_lo_u32_b32 %0, -1, 0\n\tv_mbcnt_hi_u32_b32 %0, -1, %0" : "=v"(lane2));
    const int fr2 = lane2 & 15, fq2 = lane2 >> 4;
    LruCtx X; X.w = w; X.fr = fr2; X.fq = fq2;
    X.yrow = yh + (tl0 + 16 * w) * 2048 + 512 + hd * 128 + 16 * ct;
    const char* zby = (const char*)(zh + (tl0 + 16 * w) * INC + C_BY + hd * 128);
    const unsigned loff8 = (unsigned)(fr2 * INC + 16 * ct + 4 * fq2) * 2u;
    const unsigned xsub = (unsigned)(16 * (ct & 1) + 4 * fq2) * 2u;
    unsigned doff[5];
#pragma unroll
    for (int j = 0; j < 5; ++j) { int p = 64 * (w + 8 * j) + lane2; if (p > 131 * 18 - 1) p = 131 * 18 - 1; const int row = p / 18; int c = p - row * 18; if (c > 15) c = 15; c = (c + 4 * ks0) & 15; doff[j] = (unsigned)(row * INC + c * 8) * 2u; }
    u32x2 by = (u32x2){0u, 0u}; float Hc[4] = {0.f, 0.f, 0.f, 0.f};
    if (w < 2) { const unsigned zz = (unsigned)lane2 >> 31; const float one = __uint_as_float(0x3f800000u | zz), zero = __uint_as_float(zz);
        *(LAS f32x2*)(lds + L2_WAGG + 2 * 1024 + (w * 64 + lane2) * 8) = (lane2 & 2) ? (f32x2){zero, zero} : (f32x2){one, one}; }
    asm volatile("s_waitcnt vmcnt(0) lgkmcnt(0)" ::: "memory"); __syncthreads();
    LruSt S;
#pragma unroll
    for (int r = 0; r < 4; ++r) { S.A[r] = 1.f; S.H[r] = 0.f; } S.by = by;
    f32x4 arN = (f32x4){0.f, 0.f, 0.f, 0.f}, aiN = arN;
    int tb = 2;
    bf16x8 wk[8];
#pragma unroll
    for (int i = 0; i < 4; ++i) { wk[i] = *(const LAS bf16x8*)(lds + L2_WR + 3 * 4608 + fr2 * L2_RS + 16 * fq2 + 64 * i); wk[4 + i] = *(const LAS bf16x8*)(lds + L2_WI + 3 * 4608 + fr2 * L2_RS + 16 * fq2 + 64 * i); }
    if (w >= 4) __builtin_amdgcn_s_setprio(2);
#pragma unroll 1
    for (int ch = -1; ch < 32; ++ch) { const int c2 = ch + 2 < 32 ? ch + 2 : 31, cn = ch + 1 < 32 ? ch + 1 : 31; const int tb1 = tb == 2 ? 0 : tb + 1, tb2 = tb >= 1 ? tb - 1 : 2;
        lru_chunk(X, lds, by, S, arN, aiN, ch, tb, tb1, tb2, Hc, zt + (size_t)c2 * 128 * INC * 2, doff, zby + (size_t)cn * 128 * INC * 2, loff8, xsub, wk);
        tb = tb1; }
    __builtin_amdgcn_s_setprio(0);
    lru_out(X, lds, S, 31, tb == 2 ? 0 : tb + 1, tb >= 1 ? tb - 1 : 2, Hc);
    asm volatile("s_waitcnt vmcnt(0)" ::: "memory");
    __syncthreads();
}
__device__ __forceinline__ void pool_item(const Frame& F, int l, int bl, int ch, int g, const bf16* zh, bf16* yh) {
    LAS unsigned char* lds = F.lds; const int tid = F.tid, lane = F.lane, w = F.wave, fr = lane & 15, fq = lane >> 4;
    const int s0 = ch * 128, W = 2 << g;
    { u32x4 v[5];
#pragma unroll
      for (int i = 0; i < 5; ++i) { int p = tid + i * NTHR; if (p > 143 * 16 - 1) p = 143 * 16 - 1; const int r = p >> 4, c16 = p & 15, s = s0 - 15 + r;
          v[i] = *(const u32x4*)(zh + ((size_t)bl * SEQ + (s < 0 ? 0 : s)) * INC + C_CU + g * 128 + c16 * 8); }
#pragma unroll
      for (int i = 0; i < 5; ++i) { const int p = tid + i * NTHR; const int r = p >> 4, c16 = p & 15, s = s0 - 15 + r; u32x4 o = v[i]; if (s < 0) { const unsigned zz = (unsigned)p >> 31; o = (u32x4){zz, zz, zz, zz}; }
          if (p < 143 * 16) *(LAS u32x4*)(lds + L_CU + r * 272 + c16 * 16) = o; } }
    __syncthreads();
    LAS unsigned char* pc = lds + L_PC + w * 4352;
    { const int cg = lane & 15, tq = lane >> 4, t0 = 16 * w + 4 * tq;
        float sum[8];
#pragma unroll
        for (int j = 0; j < 8; ++j) sum[j] = 0.f;
        for (int d = 0; d < W; ++d) { const u32x4 v = *(const LAS u32x4*)(lds + L_CU + (15 + t0 - d) * 272 + cg * 16);
            sum[0] += bflo(v.x); sum[1] += bfhi(v.x); sum[2] += bflo(v.y); sum[3] += bfhi(v.y); sum[4] += bflo(v.z); sum[5] += bfhi(v.z); sum[6] += bflo(v.w); sum[7] += bfhi(v.w); }
#pragma unroll
        for (int i = 0; i < 4; ++i) { const int tr = 15 + t0 + i; const u32x4 cur = *(const LAS u32x4*)(lds + L_CU + tr * 272 + cg * 16);
            if (i > 0) { const u32x4 old = *(const LAS u32x4*)(lds + L_CU + (tr - W) * 272 + cg * 16);
                sum[0] += bflo(cur.x) - bflo(old.x); sum[1] += bfhi(cur.x) - bfhi(old.x); sum[2] += bflo(cur.y) - bflo(old.y); sum[3] += bfhi(cur.y) - bfhi(old.y);
                sum[4] += bflo(cur.z) - bflo(old.z); sum[5] += bfhi(cur.z) - bfhi(old.z); sum[6] += bflo(cur.w) - bflo(old.w); sum[7] += bfhi(cur.w) - bfhi(old.w); }
            const int sp1 = s0 + t0 + i + 1; const float inv = 1.0f / (float)(sp1 < W ? sp1 : W);
            u32x4 o; o.x = cvt_pk_bf16(sum[0] * inv - bflo(cur.x), sum[1] * inv - bfhi(cur.x)); o.y = cvt_pk_bf16(sum[2] * inv - bflo(cur.y), sum[3] * inv - bfhi(cur.y));
            o.z = cvt_pk_bf16(sum[4] * inv - bflo(cur.z), sum[5] * inv - bfhi(cur.z)); o.w = cvt_pk_bf16(sum[6] * inv - bflo(cur.w), sum[7] * inv - bfhi(cur.w));
            *(LAS u32x4*)(pc + (4 * tq + i) * 272 + cg * 16) = o; } }
    LDS_WAIT();
    bf16x8 Af[4];
#pragma unroll
    for (int ks = 0; ks < 4; ++ks) Af[ks] = *(const LAS bf16x8*)(pc + fr * 272 + (32 * ks + 8 * fq) * 2);
    LDS_WAIT();
    const float* psc = F.in[14] + (size_t)l * W_C + g * 128;
    float scv[8];
#pragma unroll
    for (int ct = 0; ct < 8; ++ct) scv[ct] = psc[16 * ct + fr];
#pragma unroll
    for (int ct = 0; ct < 8; ++ct) { f32x4 a = (f32x4){0.f, 0.f, 0.f, 0.f};
#pragma unroll
        for (int ks = 0; ks < 4; ++ks) a = __builtin_amdgcn_mfma_f32_16x16x32_bf16(Af[ks], *(const LAS bf16x8*)(lds + L_PW + (16 * ct + fr) * 272 + (32 * ks + 8 * fq) * 2), a, 0, 0, 0);
        const float sc = scv[ct];
#pragma unroll
        for (int r = 0; r < 4; ++r) *(LAS bf16*)(pc + (4 * fq + r) * 272 + (16 * ct + fr) * 2) = f2bf(a[r] * sc); }
    LDS_WAIT();
    const size_t tlw = (size_t)bl * SEQ + s0 + 16 * w;
#pragma unroll
    for (int i = 0; i < 4; ++i) { const int p = lane + 64 * i, tk = p >> 4, c16 = p & 15;
        *(u32x4*)(yh + (tlw + tk) * 2048 + 1536 + g * 128 + c16 * 8) = *(const LAS u32x4*)(pc + tk * 272 + c16 * 16); }
    __syncthreads();
}
__device__ __forceinline__ void conva_item(const Frame& F, int l, int bl, int ch, int part, const bf16* zh, bf16* yh) {
    const int cg = F.tid & 31, strip = F.tid >> 5, c0 = part * 256 + cg * 8, s0 = ch * 128 + strip * 8;
    const float* cw = F.in[3] + (size_t)l * 3 * W_A + c0;
    float w0[8], w1[8], w2[8];
#pragma unroll
    for (int j = 0; j < 8; ++j) { w0[j] = cw[j]; w1[j] = cw[W_A + j]; w2[j] = cw[2 * W_A + j]; }
    const bf16* zb = zh + (size_t)bl * SEQ * INC;
    u32x4 av[10], bv[10], gv[8];
#pragma unroll
    for (int q = 0; q < 10; ++q) { const int s = s0 - 2 + q; const bf16* zr = zb + (size_t)(s < 0 ? 0 : s) * INC; av[q] = *(const u32x4*)(zr + C_AC + c0); bv[q] = *(const u32x4*)(zr + C_AX + c0); }
#pragma unroll
    for (int i = 0; i < 8; ++i) gv[i] = *(const u32x4*)(zb + (size_t)(s0 + i) * INC + C_AB + c0);
    float u2[8], u1[8];
#pragma unroll
    for (int q = 0; q < 2; ++q) { const int s = s0 - 2 + q; float* dst = q ? u1 : u2; const u32x4 a = av[q], b = bv[q]; const float live = (s >= 0) ? 1.0f : 0.0f;
        dst[0] = live * bflo(a.x) * bflo(b.x); dst[1] = live * bfhi(a.x) * bfhi(b.x); dst[2] = live * bflo(a.y) * bflo(b.y); dst[3] = live * bfhi(a.y) * bfhi(b.y);
        dst[4] = live * bflo(a.z) * bflo(b.z); dst[5] = live * bfhi(a.z) * bfhi(b.z); dst[6] = live * bflo(a.w) * bflo(b.w); dst[7] = live * bfhi(a.w) * bfhi(b.w); }
#pragma unroll
    for (int i = 0; i < 8; ++i) { const int s = s0 + i;
        const u32x4 a = av[i + 2], b = bv[i + 2], g = gv[i];
        float u0[8]; u0[0] = bflo(a.x) * bflo(b.x); u0[1] = bfhi(a.x) * bfhi(b.x); u0[2] = bflo(a.y) * bflo(b.y); u0[3] = bfhi(a.y) * bfhi(b.y);
        u0[4] = bflo(a.z) * bflo(b.z); u0[5] = bfhi(a.z) * bfhi(b.z); u0[6] = bflo(a.w) * bflo(b.w); u0[7] = bfhi(a.w) * bfhi(b.w);
        float gb[8]; gb[0] = bflo(g.x); gb[1] = bfhi(g.x); gb[2] = bflo(g.y); gb[3] = bfhi(g.y); gb[4] = bflo(g.z); gb[5] = bfhi(g.z); gb[6] = bflo(g.w); gb[7] = bfhi(g.w);
        float y[8];
#pragma unroll
        for (int j = 0; j < 8; ++j) { y[j] = gb[j] * (w0[j] * u2[j] + w1[j] * u1[j] + w2[j] * u0[j]); u2[j] = u1[j]; u1[j] = u0[j]; }
        u32x4 o; o.x = cvt_pk_bf16(y[0], y[1]); o.y = cvt_pk_bf16(y[2], y[3]); o.z = cvt_pk_bf16(y[4], y[5]); o.w = cvt_pk_bf16(y[6], y[7]);
        *(u32x4*)(yh + ((size_t)bl * SEQ + s) * 2048 + c0) = o; }
}
__device__ __forceinline__ void phase_p2(const Frame& F0, int l, const bf16* zh, bf16* yh) {
    Frame F = F0;
#define REFRESH_LANE() do { int l_; asm volatile("v_mbcnt_lo_u32_b32 %0, -1, 0\n\tv_mbcnt_hi_u32_b32 %0, -1, %0" : "=v"(l_)); F.lane = l_; F.tid = F.wave * 64 + l_; } while (0)
    for (int it0 = F.c; it0 < ((DUP_MASK & 2048) ? 1024 : 256); it0 += F.G) { const int it = it0 & 255; const int hd = it & 7, ct = (it >> 3) & 7, bl = it >> 6; lru_seq_unit(F, l, bl, hd, ct, zh, yh); }
    REFRESH_LANE();
    { int cur_g = -1;
    for (int it = F.c; it < 512; it += F.G) { const int g = it & 3, rest = it >> 2, bl = rest >> 5, ch = rest & 31;
        if (g != cur_g) { __syncthreads(); stage_pad128((const bf16*)(F.ws + WS_PLT) + (size_t)g * 128 * 128, F.lds + L_PW, F.tid); cur_g = g; }
        pool_item(F, l, bl, ch, g, zh, yh); } }
    REFRESH_LANE();
    { for (int it = F.c; it < 256; it += F.G) { const int part = it & 1, rest = it >> 1, bl = rest >> 5, ch = rest & 31; conva_item(F, l, bl, ch, part, zh, yh); } }
}

constexpr int NPHASE = 23;
__global__ void __launch_bounds__(NTHR, 2) mega_fwd(Args args) {
    extern __shared__ __attribute__((aligned(16))) unsigned char lds_raw[];
    Frame F; F.lds = (LAS unsigned char*)lds_raw; F.MISC = (volatile LAS unsigned*)(F.lds + MISC_OFF);
    const int wave_s = __builtin_amdgcn_readfirstlane((int)threadIdx.x >> 6);
    F.wave = wave_s; F.lane = (int)__builtin_amdgcn_mbcnt_hi(~0u, __builtin_amdgcn_mbcnt_lo(~0u, 0u)); F.tid = wave_s * 64 + F.lane; F.G = gridDim.x; F.c = blockIdx.x;
    F.in = args.in; F.out = args.out; F.ws = args.ws; F.ctl = (unsigned*)(args.ws + WS_CTL);
    for (int u = F.tid; u < (LDS_BYTES - MISC_OFF) / 4; u += NTHR) F.MISC[u] = 0u;
    __syncthreads();
    const int lo = args.ph_lo, hi = args.ph_hi;
    XcdBarrier bar; bar.bar = F.ctl + CW_BAR; bar.x = 0; bar.st = nullptr;
    if (hi - lo > 1) bar = xcd_barrier_post(F.ctl + CW_BAR, F.MISC + MW_BAR, F.tid == 0);
    int pid = 0;
#define PH_BEGIN if (pid >= lo && pid < hi) { { int c_ = (int)blockIdx.x; asm volatile("" : "+s"(c_)); F.c = c_; int l_; asm volatile("v_mbcnt_lo_u32_b32 %0, -1, 0\n\tv_mbcnt_hi_u32_b32 %0, -1, %0" : "=v"(l_)); F.lane = l_; F.wave = wave_s; F.tid = wave_s * 64 + l_; }
#define PH_END if (pid + 1 < hi) xcd_barrier(bar, F.tid == 0); } ++pid;
    bf16* zh = (bf16*)(F.ws + WS_ZH); bf16* yh = (bf16*)F.out; bf16* xb = (bf16*)(F.ws + WS_XB); bf16* mb = (bf16*)((unsigned char*)F.out + 64 * MiB); bf16* xs = (bf16*)(F.ws + WS_XS);
    for (int l = 0; l < DEPTH; ++l) {
        PH_BEGIN REP(1) { phase_n1(F, l); __syncthreads(); } if ((DUP_MASK & 16384) && l == 0) { for (int xb_ = 0; xb_ < 20; ++xb_) xcd_barrier(bar, F.tid == 0); } PH_END
        for (int hf = 0; hf < 2; ++hf) {
            PH_BEGIN { { ProbG1 p; p.S.init(TH, 2048, F.G, F.c, (DUP_MASK & 2) ? 2 : 1); p.A = (const char*)(xs + (size_t)hf * TH * D); p.B = (const char*)(F.ws + WS_WINT); p.O = zh; p.dummy = yh; p.rstd = (const float*)(F.ws + WS_RSTD) + (size_t)hf * TH; pg8::gemm_phase(F.lds, p, F.tid); }
                       { ProbG1g p; p.S.init(TH, 5120, F.G, F.c, (DUP_MASK & 2) ? 2 : 1); p.A = (const char*)(F.ws + (hf ? WS_XB8B : WS_XB8A)); p.B = (const char*)(F.ws + WS_WING8); p.O = zh; p.rstd = (const float*)(F.ws + WS_RSTD) + (size_t)hf * TH; pg8::gemm_phase(F.lds, p, F.tid); } } PH_END
            PH_BEGIN { phase_p2(F, l, zh, yh); __syncthreads(); } PH_END
            PH_BEGIN { ProbG2 p; p.S.init(TH, D, F.G, F.c, (DUP_MASK & 16) ? 2 : 1); p.A = (const char*)yh; p.B = (const char*)(F.ws + WS_WCAT); p.zh = zh; p.O = mb + (size_t)hf * TH * D; pg8::gemm_phase(F.lds, p, F.tid); } PH_END
        }
        PH_BEGIN { ProbG3 p; p.S.init(T, D, F.G, F.c, 1); p.A = (const char*)mb; p.B = (const char*)(F.ws + WS_WOT); p.xin32 = nullptr; p.xs = xs; pg8::gemm_phase(F.lds, p, F.tid); } PH_END
        PH_BEGIN REP(64) { phase_router(F, l, rep_); __syncthreads(); } PH_END
        PH_BEGIN { moe_panel_table(F, l); ProbMA p; p.MISC = F.MISC; p.rinfo = (const i32x4*)(F.ws + WS_RINFO); p.G = F.G; p.c = F.c; p.nsh = 3; p.dupm = (DUP_MASK & 32768) ? 3 : 1;
                   p.A = (const char*)xb; p.B = (const char*)(F.ws + WS_BAT); p.hid = (unsigned char*)(F.ws + WS_HID); pg8::gemm_phase(F.lds, p, F.tid);
                   if (l + 1 < DEPTH) { convert_queue(F, l + 1, 0, F.ctl + CW_WQ + 128); convert_queue(F, l + 1, 1, F.ctl + CW_WQ); } } PH_END
        PH_BEGIN { moe_panel_table(F, l); ProbMB p; p.MISC = F.MISC; p.rinfo = (const i32x4*)(F.ws + WS_RINFO); p.G = F.G; p.c = F.c; p.nsh = 2;
                   p.A = (const char*)(F.ws + WS_HID); p.B = (const char*)(F.ws + WS_W2T); p.xs = xs; pg8::gemm_phase(F.lds, p, F.tid);
                   if (l + 1 < DEPTH) convert_queue(F, l + 1, 2, F.ctl + CW_WQ + 64); } PH_END
    }
    PH_BEGIN phase_final(F); PH_END
#undef PH_BEGIN
#undef PH_END
}
static void launch_mega(const Args& base, int lo, int hi, int grid, hipStream_t stream) {
    Args a = base; a.ph_lo = lo; a.ph_hi = hi;
    hipLaunchKernelGGL(mega_fwd, dim3(grid), dim3(NTHR), LDS_BYTES, stream, a);
}
extern "C" void kernel_launch(void* const* d_in, const int* in_sizes, int n_in, void* d_out, int out_size, void* d_ws, size_t ws_size, hipStream_t stream) {
    static int grid = 0;
    if (grid == 0) {
        if (n_in != 26 || out_size != T * D || ws_size < WS_END) { fprintf(stderr, "kernel_launch: unexpected shapes (n_in %d out %d ws %zu)\n", n_in, out_size, ws_size); grid = -1; return; }
        int dev = 0, cus = 0;
        if (hipGetDevice(&dev) != hipSuccess || hipDeviceGetAttribute(&cus, hipDeviceAttributeMultiprocessorCount, dev) != hipSuccess) { grid = -1; return; }
        if (hipFuncSetAttribute((const void*)mega_fwd, hipFuncAttributeMaxDynamicSharedMemorySize, LDS_BYTES) != hipSuccess) { fprintf(stderr, "kernel_launch: hipFuncSetAttribute failed\n"); grid = -1; return; }
        int per_cu = 0; (void)hipOccupancyMaxActiveBlocksPerMultiprocessor(&per_cu, (const void*)mega_fwd, NTHR, LDS_BYTES); (void)hipGetLastError();
        if (per_cu < 1) fprintf(stderr, "kernel_launch: occupancy query says %d blocks per CU\n", per_cu);
        grid = cus;
    }
    if (grid < 0) return;
    (void)hipMemsetAsync((char*)d_ws + WS_CTL, 0, CTL_BYTES, stream);
    Args a{};
    for (int i = 0; i < 26; ++i) a.in[i] = (const float*)d_in[i];
    a.out = (float*)d_out; a.ws = (unsigned char*)d_ws; a.ph_lo = 0; a.ph_hi = 0;
#if ONE_LAUNCH
    launch_mega(a, 0, NPHASE, grid, stream);
#else
    for (int ph = 0; ph < NPHASE; ++ph) launch_mega(a, ph, ph + 1, grid, stream);
#endif
}
```
